# Optimizing an MI355X kernel written in HIP

```python
import math, functools
import jax, jax.numpy as jnp
from jax import lax
import numpy as np

D_MODEL = 1024
BATCH = 1
SEQ = 16384
DEPTH = 1
DEC_BATCH = 32
DEC_SEQ = 1
PAST_LEN = 16384
PAGE_SIZE = 128

HEAD_DIM = 64
N_NSA_HEADS = 8
N_KV = 2
N_RET_HEADS = 8
RET_DK = 64
RET_DV = 64
D_NSA = N_NSA_HEADS * HEAD_DIM
D_RET = N_RET_HEADS * RET_DV
D_MIX = D_NSA + D_RET
CMP_BLOCK = 32
CMP_STRIDE = 16
CMP_HID = 128
SLC_BLOCK = 64
N_SEL = 16
WINDOW = 512
Q_BLOCK = 128
RET_CHUNK = 128
N_BUCKETS = 32
REL_MAX_DIST = 1024
D_FF = 2816
CONV_W = 3
RMS_EPS = 1e-6
GN_EPS = 1e-5
ROPE_BASE = 10000.0
NEG_INF = -1e30
FORCE_SCORE = 1e4
SPLITS = (D_NSA, 2 * N_KV * HEAD_DIM, 2 * N_KV * HEAD_DIM, 2 * N_KV * HEAD_DIM, 3 * N_NSA_HEADS, N_RET_HEADS * RET_DK, N_RET_HEADS * RET_DK, D_RET, D_RET)
D_IN = D_NSA + 6 * N_KV * HEAD_DIM + 3 * N_NSA_HEADS + 2 * N_RET_HEADS * RET_DK + 2 * D_RET

kernel_name = 'hymba_nsa_retention_convffn_step'


def rmsnorm(x, g):
    xf = x.astype(jnp.float32)
    y = xf * lax.rsqrt(jnp.mean(xf * xf, axis=-1, keepdims=True) + RMS_EPS)
    return (y * g).astype(x.dtype)


def adaln(c, w, b):
    mod = jax.nn.silu(c) @ w + b
    return [m[:, None, :] for m in jnp.split(mod, 6, axis=-1)]


def rel_bucket(dist):
    n = jnp.maximum(dist, 0)
    max_exact = N_BUCKETS // 2
    nf = jnp.maximum(n, 1).astype(jnp.float32)
    large = max_exact + (jnp.log(nf / max_exact) / math.log(REL_MAX_DIST / max_exact) * (N_BUCKETS - max_exact)).astype(jnp.int32)
    return jnp.where(n < max_exact, n, jnp.minimum(large, N_BUCKETS - 1))


def head_bias(dist, table):
    tq, n = dist.shape
    b = jnp.take(table, rel_bucket(dist), axis=0)
    return b.reshape(tq, n, N_KV, N_NSA_HEADS // N_KV).transpose(2, 3, 0, 1)


def masked_softmax(s, mask):
    s = jnp.where(mask, s.astype(jnp.float32), NEG_INF)
    return jax.nn.softmax(s, axis=-1) * mask


def rope(x, pos):
    half = x.shape[-1] // 2
    inv = ROPE_BASE ** (-jnp.arange(half, dtype=jnp.float32) / half)
    ang = pos.astype(jnp.float32)[:, None] * inv[None, :]
    cos, sin = jnp.cos(ang)[None, :, None, :], jnp.sin(ang)[None, :, None, :]
    x1, x2 = x[..., :half].astype(jnp.float32), x[..., half:].astype(jnp.float32)
    return jnp.concatenate([x1 * cos - x2 * sin, x1 * sin + x2 * cos], axis=-1).astype(x.dtype)


def split_projection(hn, w_in):
    B, T = hn.shape[:2]
    cuts = [int(v) for v in np.cumsum(SPLITS)[:-1]]
    q_a, kv_c, kv_s, kv_w, gt, q_r, k_r, v_r, g_r = jnp.split(hn @ w_in, cuts, axis=-1)
    kvs = lambda a: a.reshape(B, T, 2, N_KV, HEAD_DIM)
    gates = jax.nn.sigmoid(gt.astype(jnp.float32)).reshape(B, T, 3, N_NSA_HEADS).astype(hn.dtype)
    return (q_a.reshape(B, T, N_NSA_HEADS, HEAD_DIM), kvs(kv_c), kvs(kv_s), kvs(kv_w), gates,
            q_r.reshape(B, T, N_RET_HEADS, RET_DK), k_r.reshape(B, T, N_RET_HEADS, RET_DK),
            v_r.reshape(B, T, N_RET_HEADS, RET_DV), g_r)


def compress(k, pe, w1, w2):
    B, L, G, dh = k.shape
    kc = k.reshape(B, L // CMP_STRIDE, CMP_STRIDE, G, dh)
    lo = jnp.einsum('bnlgd,ldh->bngh', kc, w1[:CMP_STRIDE])
    hi = jnp.einsum('bnlgd,ldh->bngh', kc, w1[CMP_STRIDE:])
    pe_term = jnp.einsum('ld,ldh->h', pe, w1)
    hid = jax.nn.gelu(lo[:, :-1] + hi[:, 1:] + pe_term)
    return jnp.einsum('bngh,he->bnge', hid, w2)


def cmp_to_slc(imp, ns):
    nc = imp.shape[-1]
    r = SLC_BLOCK // CMP_STRIDE
    pad = [(0, 0)] * (imp.ndim - 1) + [(1, r * ns - nc)]
    pp = jnp.pad(imp, pad)
    return pp[..., :r * ns].reshape(*imp.shape[:-1], ns, r).sum(-1) + pp[..., r::r]


def nsa_attend(q, t_pos, kcmp, vcmp, ks_blk, vs_blk, kw, vw, w_pos, gates, table):
    B, Tq = q.shape[:2]
    G, R = N_KV, N_NSA_HEADS // N_KV
    qg = q.reshape(B, Tq, G, R, HEAD_DIM) * (HEAD_DIM ** -0.5)
    nc = kcmp.shape[1]
    c_end = CMP_STRIDE * jnp.arange(nc) + (CMP_BLOCK - 1)
    d_c = t_pos[:, None] - c_end[None, :]
    s_c = jnp.einsum('btgrd,bngd->bgrtn', qg, kcmp) + head_bias(d_c, table)
    p_c = masked_softmax(s_c, d_c >= 0)
    o_c = jnp.einsum('bgrtn,bngd->btgrd', p_c.astype(vcmp.dtype), vcmp)
    ns = ks_blk.shape[1]
    n_sel = min(N_SEL, ns)
    imp = cmp_to_slc(p_c.sum(axis=2), ns)
    blk = jnp.arange(ns)
    cur = t_pos // SLC_BLOCK
    valid = blk[None, :] * SLC_BLOCK <= t_pos[:, None]
    forced = (blk[None, :] == 0) | (blk[None, :] == cur[:, None]) | (blk[None, :] == cur[:, None] - 1)
    score = jnp.where(valid, jnp.where(forced, FORCE_SCORE, imp), NEG_INF)
    _, idx = lax.top_k(score, n_sel)
    b_i = jnp.arange(B)[:, None, None, None]
    g_i = jnp.arange(G)[None, :, None, None]
    k_sel = ks_blk[b_i, idx, :, g_i]
    v_sel = vs_blk[b_i, idx, :, g_i]
    s_pos = idx[..., None] * SLC_BLOCK + jnp.arange(SLC_BLOCK)
    d_s = t_pos[None, None, :, None, None] - s_pos
    bias_s = jnp.moveaxis(table.reshape(N_BUCKETS, G, R)[rel_bucket(d_s), g_i[..., None]], -1, 2)
    s_s = jnp.einsum('btgrd,bgtkld->bgrtkl', qg, k_sel) + bias_s
    p_s = masked_softmax(s_s.reshape(B, G, R, Tq, -1), (d_s >= 0).reshape(B, G, 1, Tq, -1)).reshape(s_s.shape)
    o_s = jnp.einsum('bgrtkl,bgtkld->btgrd', p_s.astype(v_sel.dtype), v_sel)
    d_w = t_pos[:, None] - w_pos[None, :]
    s_w = jnp.einsum('btgrd,bsgd->bgrts', qg, kw) + head_bias(d_w, table)
    p_w = masked_softmax(s_w, (d_w >= 0) & (d_w <= WINDOW) & (w_pos >= 0)[None, :])
    o_w = jnp.einsum('bgrts,bsgd->btgrd', p_w.astype(vw.dtype), vw)
    g = gates.reshape(B, Tq, 3, G, R, 1)
    o = g[:, :, 0] * o_c + g[:, :, 1] * o_s + g[:, :, 2] * o_w
    return o.reshape(B, Tq, D_NSA)


def nsa_prompt(q_a, kv_c, kv_s, kv_w, gates, lp, table):
    B, S = q_a.shape[:2]
    kcmp = compress(kv_c[:, :, 0], lp['cmp_pe_k'], lp['w_cmp1_k'], lp['w_cmp2_k'])
    vcmp = compress(kv_c[:, :, 1], lp['cmp_pe_v'], lp['w_cmp1_v'], lp['w_cmp2_v'])
    ks_blk = kv_s[:, :, 0].reshape(B, S // SLC_BLOCK, SLC_BLOCK, N_KV, HEAD_DIM)
    vs_blk = kv_s[:, :, 1].reshape(B, S // SLC_BLOCK, SLC_BLOCK, N_KV, HEAD_DIM)
    kw_pad = jnp.pad(kv_w, ((0, 0), (WINDOW, 0), (0, 0), (0, 0), (0, 0)))

    def one_block(i):
        start = i * Q_BLOCK
        qb = lax.dynamic_slice_in_dim(q_a, start, Q_BLOCK, axis=1)
        gb = lax.dynamic_slice_in_dim(gates, start, Q_BLOCK, axis=1)
        kwb = lax.dynamic_slice_in_dim(kw_pad, start, Q_BLOCK + WINDOW, axis=1)
        t_pos = start + jnp.arange(Q_BLOCK)
        w_pos = start - WINDOW + jnp.arange(Q_BLOCK + WINDOW)
        return nsa_attend(qb, t_pos, kcmp, vcmp, ks_blk, vs_blk, kwb[:, :, 0], kwb[:, :, 1], w_pos, gb, table)

    o = lax.map(one_block, jnp.arange(S // Q_BLOCK))
    return jnp.moveaxis(o, 0, 1).reshape(B, S, D_NSA), kv_w[:, -WINDOW:]


def nsa_sample(q_a, kv_c, kv_s, kv_w, gates, lp, table, cache_c, cache_s, win_buf, page_table):
    B, T = q_a.shape[:2]
    P = page_table.shape[1] * PAGE_SIZE
    L = P + T
    Lp = -(-L // SLC_BLOCK) * SLC_BLOCK
    t_pos = P + jnp.arange(T)

    def full_rows(cache, new):
        past = cache[page_table].reshape(B, P, 2, N_KV, HEAD_DIM)
        rows = jnp.concatenate([past, new.astype(past.dtype)], axis=1)
        return jnp.pad(rows, ((0, 0), (0, Lp - L), (0, 0), (0, 0), (0, 0)))

    c_rows = full_rows(cache_c, kv_c)
    s_rows = full_rows(cache_s, kv_s)
    kcmp = compress(c_rows[:, :, 0], lp['cmp_pe_k'], lp['w_cmp1_k'], lp['w_cmp2_k'])
    vcmp = compress(c_rows[:, :, 1], lp['cmp_pe_v'], lp['w_cmp1_v'], lp['w_cmp2_v'])
    ks_blk = s_rows[:, :, 0].reshape(B, Lp // SLC_BLOCK, SLC_BLOCK, N_KV, HEAD_DIM)
    vs_blk = s_rows[:, :, 1].reshape(B, Lp // SLC_BLOCK, SLC_BLOCK, N_KV, HEAD_DIM)
    win = jnp.concatenate([win_buf.astype(kv_w.dtype), kv_w], axis=1)
    w_pos = P - win_buf.shape[1] + jnp.arange(win.shape[1])
    o = nsa_attend(q_a, t_pos, kcmp, vcmp, ks_blk, vs_blk, win[:, :, 0], win[:, :, 1], w_pos, gates, table)
    return o, win[:, -WINDOW:]


def retention_scan(q, k, v, s0, chunk):
    B, T, H, dk = q.shape
    dv = v.shape[-1]
    n_ch = T // chunk
    log_g = jnp.log1p(-jnp.exp2(-5.0 - jnp.arange(H, dtype=jnp.float32)))
    n = jnp.arange(chunk, dtype=jnp.float32)
    diff = n[:, None] - n[None, :]
    decay_in = jnp.where(diff >= 0, jnp.exp(jnp.maximum(diff, 0.0)[None] * log_g[:, None, None]), 0.0)
    decay_q = jnp.exp((n[None, :] + 1.0) * log_g[:, None]).T[None, :, :, None]
    decay_k = jnp.exp((chunk - 1.0 - n)[None, :] * log_g[:, None]).T[None, :, :, None]
    decay_c = jnp.exp(chunk * log_g)[None, :, None, None]

    def to_chunks(a):
        return jnp.moveaxis(a.astype(jnp.float32).reshape(B, n_ch, chunk, H, a.shape[-1]), 1, 0)

    def step(s, inp):
        qc, kc, vc = inp
        att = jnp.einsum('bnhd,bmhd->bhnm', qc, kc) * decay_in
        o = jnp.einsum('bhnm,bmhe->bnhe', att, vc) + jnp.einsum('bnhd,bhde->bnhe', qc, s) * decay_q
        s = s * decay_c + jnp.einsum('bmhd,bmhe->bhde', kc * decay_k, vc)
        return s, o

    s, o = lax.scan(step, s0.astype(jnp.float32), (to_chunks(q), to_chunks(k), to_chunks(v)))
    return jnp.moveaxis(o, 0, 1).reshape(B, T, H, dv), s


def retention_group(q, k, v, g, pos, s0, chunk, gn_g):
    B, T = q.shape[:2]
    q = rope(q, pos)
    k = rope(k, pos) * (RET_DK ** -0.5)
    o, s = retention_scan(q, k, v, s0, chunk)
    mu = jnp.mean(o, axis=-1, keepdims=True)
    var = jnp.mean(jnp.square(o - mu), axis=-1, keepdims=True)
    o = ((o - mu) * lax.rsqrt(var + GN_EPS)).reshape(B, T, D_RET) * gn_g
    return (jax.nn.silu(g.astype(jnp.float32)) * o).astype(g.dtype), s


def conv_ffn(hn, buf, w_up, conv_w, conv_b, w_down):
    T = hn.shape[1]
    a_g, a_v = jnp.split(hn @ w_up, 2, axis=-1)
    ext = jnp.concatenate([buf.astype(a_g.dtype), a_g], axis=1)
    conv = conv_b
    for j in range(CONV_W):
        conv = conv + conv_w[j] * ext[:, j:j + T]
    h = jax.nn.silu(conv) * a_v
    return h @ w_down, ext[:, T:]


def decoder_layer(x, c, lp, table, pos, nsa_mixer, ret_state, ret_chunk, conv_buf):
    sh1, sc1, gt1, sh2, sc2, gt2 = adaln(c, lp['w_ada'], lp['b_ada'])
    hn = rmsnorm(x, lp['norm_mix_g']) * (1 + sc1) + sh1
    q_a, kv_c, kv_s, kv_w, gates, q_r, k_r, v_r, g_r = split_projection(hn, lp['w_in'])
    o_a, win_new = nsa_mixer(q_a, kv_c, kv_s, kv_w, gates)
    o_r, ret_new = retention_group(q_r, k_r, v_r, g_r, pos, ret_state, ret_chunk, lp['ret_gn_g'])
    x = x + gt1 * (jnp.concatenate([o_a, o_r.astype(o_a.dtype)], axis=-1) @ lp['w_out'])
    hn2 = rmsnorm(x, lp['norm_ffn_g']) * (1 + sc2) + sh2
    f, conv_new = conv_ffn(hn2, conv_buf, lp['w_up'], lp['conv_w'], lp['conv_b'], lp['w_down'])
    x = x + gt2 * f
    return x, kv_c, kv_s, win_new, ret_new, conv_new


def setup_inputs(seed: int = 0) -> dict:
    key = jax.random.key(seed)
    ks = jax.random.split(key, 32)
    n_pages = PAST_LEN // PAGE_SIZE
    n_pool = (5 * DEC_BATCH * n_pages + 3) // 4
    win_buf = min(WINDOW, PAST_LEN)
    nrm = lambda k, shape, s: jax.random.normal(k, shape, jnp.float32) * s
    page_table = jax.random.permutation(ks[7], n_pool)[:DEC_BATCH * n_pages].reshape(DEC_BATCH, n_pages).astype(jnp.int32)
    return {
        'x_prompt': nrm(ks[0], (BATCH, SEQ, D_MODEL), 1.0),
        'x_sample': nrm(ks[1], (DEC_BATCH, DEC_SEQ, D_MODEL), 1.0),
        'cache_cmp_kv': nrm(ks[2], (DEPTH, n_pool, PAGE_SIZE, 2, N_KV, HEAD_DIM), 1.0),
        'cache_slc_kv': nrm(ks[3], (DEPTH, n_pool, PAGE_SIZE, 2, N_KV, HEAD_DIM), 1.0),
        'state_win_kv': nrm(ks[4], (DEPTH, DEC_BATCH, win_buf, 2, N_KV, HEAD_DIM), 1.0),
        'state_ret': nrm(ks[5], (DEPTH, DEC_BATCH, N_RET_HEADS, RET_DK, RET_DV), 0.5),
        'state_conv': nrm(ks[6], (DEPTH, DEC_BATCH, CONV_W - 1, D_FF), 1.0),
        'page_table': page_table,
        'c_prompt': nrm(ks[8], (BATCH, D_MODEL), 1.0),
        'c_sample': nrm(ks[9], (DEC_BATCH, D_MODEL), 1.0),
        'w_ada': nrm(ks[10], (DEPTH, D_MODEL, 6 * D_MODEL), 0.5 * D_MODEL ** -0.5),
        'b_ada': nrm(ks[11], (DEPTH, 6 * D_MODEL), 0.02),
        'norm_mix_g': 1.0 + nrm(ks[12], (DEPTH, D_MODEL), 0.05),
        'w_in': nrm(ks[13], (DEPTH, D_MODEL, D_IN), D_MODEL ** -0.5),
        'cmp_pe_k': nrm(ks[14], (DEPTH, CMP_BLOCK, HEAD_DIM), 0.5),
        'cmp_pe_v': nrm(ks[15], (DEPTH, CMP_BLOCK, HEAD_DIM), 0.5),
        'w_cmp1_k': nrm(ks[16], (DEPTH, CMP_BLOCK, HEAD_DIM, CMP_HID), (CMP_BLOCK * HEAD_DIM) ** -0.5),
        'w_cmp1_v': nrm(ks[17], (DEPTH, CMP_BLOCK, HEAD_DIM, CMP_HID), (CMP_BLOCK * HEAD_DIM) ** -0.5),
        'w_cmp2_k': nrm(ks[18], (DEPTH, CMP_HID, HEAD_DIM), CMP_HID ** -0.5),
        'w_cmp2_v': nrm(ks[19], (DEPTH, CMP_HID, HEAD_DIM), CMP_HID ** -0.5),
        'rel_bias_table': nrm(ks[20], (N_BUCKETS, N_NSA_HEADS), 0.5),
        'ret_gn_g': 1.0 + nrm(ks[21], (DEPTH, D_RET), 0.05),
        'w_out': nrm(ks[22], (DEPTH, D_MIX, D_MODEL), D_MIX ** -0.5),
        'norm_ffn_g': 1.0 + nrm(ks[23], (DEPTH, D_MODEL), 0.05),
        'w_up': nrm(ks[24], (DEPTH, D_MODEL, 2 * D_FF), D_MODEL ** -0.5),
        'conv_w': nrm(ks[25], (DEPTH, CONV_W, D_FF), CONV_W ** -0.5),
        'conv_b': nrm(ks[26], (DEPTH, D_FF), 0.02),
        'w_down': nrm(ks[27], (DEPTH, D_FF, D_MODEL), D_FF ** -0.5),
        'final_g': 1.0 + nrm(ks[28], (D_MODEL,), 0.05),
    }


def reference(x_prompt, x_sample, cache_cmp_kv, cache_slc_kv, state_win_kv, state_ret, state_conv, page_table,
              c_prompt, c_sample, w_ada, b_ada, norm_mix_g, w_in, cmp_pe_k, cmp_pe_v, w_cmp1_k, w_cmp1_v,
              w_cmp2_k, w_cmp2_v, rel_bias_table, ret_gn_g, w_out, norm_ffn_g, w_up, conv_w, conv_b, w_down, final_g):
    B, S = x_prompt.shape[:2]
    T = x_sample.shape[1]
    P = page_table.shape[1] * PAGE_SIZE
    xp, xs = x_prompt, x_sample
    cmp_p, cmp_s, slc_p, slc_s, win_p, win_s, ret_p, ret_s, conv_p, conv_s = [], [], [], [], [], [], [], [], [], []
    for l in range(DEPTH):
        lp = {'w_ada': w_ada[l], 'b_ada': b_ada[l], 'norm_mix_g': norm_mix_g[l], 'w_in': w_in[l],
              'cmp_pe_k': cmp_pe_k[l], 'cmp_pe_v': cmp_pe_v[l], 'w_cmp1_k': w_cmp1_k[l], 'w_cmp1_v': w_cmp1_v[l],
              'w_cmp2_k': w_cmp2_k[l], 'w_cmp2_v': w_cmp2_v[l], 'ret_gn_g': ret_gn_g[l], 'w_out': w_out[l],
              'norm_ffn_g': norm_ffn_g[l], 'w_up': w_up[l], 'conv_w': conv_w[l], 'conv_b': conv_b[l], 'w_down': w_down[l]}
        xp, a0, a1, a2, a3, a4 = decoder_layer(
            xp, c_prompt, lp, rel_bias_table, jnp.arange(S),
            functools.partial(nsa_prompt, lp=lp, table=rel_bias_table),
            jnp.zeros((B, N_RET_HEADS, RET_DK, RET_DV), jnp.float32), min(RET_CHUNK, S),
            jnp.zeros((B, CONV_W - 1, D_FF), xp.dtype))
        xs, b0, b1, b2, b3, b4 = decoder_layer(
            xs, c_sample, lp, rel_bias_table, P + jnp.arange(T),
            functools.partial(nsa_sample, lp=lp, table=rel_bias_table, cache_c=cache_cmp_kv[l],
                              cache_s=cache_slc_kv[l], win_buf=state_win_kv[l], page_table=page_table),
            state_ret[l], T, state_conv[l])
        cmp_p.append(a0); slc_p.append(a1); win_p.append(a2); ret_p.append(a3); conv_p.append(a4)
        cmp_s.append(b0); slc_s.append(b1); win_s.append(b2); ret_s.append(b3); conv_s.append(b4)
    y_prompt = rmsnorm(xp, final_g)
    y_sample = rmsnorm(xs, final_g)
    return (y_prompt, y_sample, jnp.stack(cmp_p), jnp.stack(cmp_s), jnp.stack(slc_p), jnp.stack(slc_s),
            jnp.stack(win_p), jnp.stack(win_s), jnp.stack(ret_p), jnp.stack(ret_s), jnp.stack(conv_p), jnp.stack(conv_s))
```

```cpp
#include <hip/hip_runtime.h>
#include <cstdio>
#include <cstdint>

#ifndef DBG_SKIP_MIX
#define DBG_SKIP_MIX 0
#endif
#ifndef DBG_NO_NSA
#define DBG_NO_NSA 0
#endif
#ifndef PROBE_DUP
#define PROBE_DUP -1
#endif
#ifndef MK_ONE_LAUNCH
#define MK_ONE_LAUNCH 1
#endif

#define LAS __attribute__((address_space(3)))
typedef unsigned short bf16_t;
typedef short bf16x8 __attribute__((ext_vector_type(8)));
typedef float f32x4 __attribute__((ext_vector_type(4)));
typedef float f32x2 __attribute__((ext_vector_type(2)));
typedef float f32x16 __attribute__((ext_vector_type(16)));
typedef unsigned u32x4 __attribute__((ext_vector_type(4)));
typedef unsigned u32x2 __attribute__((ext_vector_type(2)));

constexpr int SEQ = 16384, DM = 1024, NB = 32, DFF = 2816, NZ = 3584  , PAST = 16384;
constexpr int MROWS = SEQ + NB;
constexpr size_t O_YP = 0, O_YS = 16777216, O_CMP_P = 16809984, O_CMP_S = 21004288, O_SLC_P = 21012480, O_SLC_S = 25206784,
                 O_WIN_P = 25214976, O_WIN_S = 25346048, O_RET_P = 29540352, O_RET_S = 29573120, O_CONV_P = 30621696, O_CONV_S = 30627328, O_END = 30807552;
constexpr int ZC_QA = 0, ZC_KVC = 512, ZC_KVS = 768, ZC_KVW = 1024, ZC_QR = 1280, ZC_KR = 1792, ZC_VR = 2304, ZC_GR = 2816, ZC_GT = 3328;

constexpr size_t al256(size_t x) { return (x + 255) & ~(size_t)255; }
constexpr size_t WS_BAR = 0;
constexpr size_t WS_MODP = 16384;
constexpr size_t WS_MOD = WS_MODP + al256((size_t)8 * 33 * 6144 * 4);
constexpr size_t WS_ROPE = WS_MOD + al256((size_t)33 * 6144 * 4);
constexpr size_t WS_BIAS = WS_ROPE + al256((size_t)2 * 16385 * 32 * 4);
constexpr size_t WS_WIN_T = WS_BIAS + al256((size_t)8 * 1032 * 4);
constexpr size_t WS_WOUT_T = WS_WIN_T + (size_t)NZ * 1024 * 2;
constexpr size_t WS_WUP_T = WS_WOUT_T + (size_t)1024 * 1024 * 2;
constexpr size_t WS_WDN_T = WS_WUP_T + (size_t)5632 * 1024 * 2;
constexpr size_t WS_W1T = WS_WDN_T + (size_t)1024 * 2816 * 2;
constexpr size_t WS_W2T = WS_W1T + (size_t)2 * 128 * 2048 * 2;
constexpr size_t WS_PET = WS_W2T + (size_t)2 * 64 * 128 * 2;
constexpr size_t WS_HN = WS_PET + 8192;
constexpr size_t WS_QA = WS_HN + (size_t)(SEQ + 256) * 1024 * 2;
constexpr size_t WS_KVC = WS_QA + (size_t)SEQ * 512 * 2;
constexpr size_t WS_KVS = WS_KVC + (size_t)SEQ * 256 * 2;
constexpr size_t WS_KVW = WS_KVS + (size_t)SEQ * 256 * 2;
constexpr size_t WS_QR = WS_KVW + (size_t)SEQ * 256 * 2;
constexpr size_t WS_KR = WS_QR + (size_t)SEQ * 512 * 2;
constexpr size_t WS_VR = WS_KR + (size_t)SEQ * 512 * 2;
constexpr size_t WS_GR = WS_VR + (size_t)SEQ * 512 * 2;
constexpr size_t WS_GATES = WS_GR + (size_t)SEQ * 512 * 2;
constexpr size_t WS_ZS = WS_GATES + (size_t)SEQ * 24 * 4;
constexpr size_t WS_UC = WS_ZS + (size_t)NB * NZ * 4;
constexpr size_t WS_SC = WS_UC + (size_t)128 * 8 * 4096 * 4;
constexpr size_t WS_MIX = WS_SC + (size_t)128 * 8 * 4096 * 4;
constexpr size_t WS_X1 = WS_MIX + (size_t)(SEQ + 256) * 1024 * 2;
constexpr size_t WS_HN2 = WS_X1 + (size_t)(SEQ + 32) * 1024 * 4;
constexpr size_t WS_AG = WS_HN2 + (size_t)(SEQ + 256) * 1024 * 2;
constexpr size_t WS_AV = WS_AG + (size_t)SEQ * DFF * 2;
constexpr size_t WS_H = WS_AV + (size_t)SEQ * DFF * 2;
constexpr size_t WS_AGS = WS_H + (size_t)SEQ * DFF * 2;
constexpr size_t WS_AVS = WS_AGS + (size_t)NB * DFF * 4;
constexpr size_t WS_HS = WS_AVS + (size_t)NB * DFF * 4;
constexpr size_t WS_KCMP = WS_HS + (size_t)NB * DFF * 2;
constexpr size_t WS_VST = WS_KCMP + (size_t)2 * 1024 * 128 * 2;
constexpr size_t WS_OW = WS_VST + (size_t)2 * 64 * SEQ * 2;
constexpr size_t WS_KCMPS = WS_OW + (size_t)SEQ * 512 * 4;
constexpr size_t WS_KBM = WS_KCMPS + (size_t)NB * 2 * 1024 * 128 * 2;
constexpr size_t WS_KCM = WS_KBM + 2048;
constexpr size_t WS_OC = WS_KBM + 4096;
constexpr size_t WS_END = WS_OC + (size_t)SEQ * 512 * 4;

struct Params {
    const float *x_p, *x_s, *cache_c, *cache_s, *st_win, *st_ret, *st_conv; const int* page_tab;
    const float *c_p, *c_s, *w_ada, *b_ada, *g_mix, *w_in, *pe_k, *pe_v, *w1_k, *w1_v, *w2_k, *w2_v, *table, *gn_g, *w_out, *g_ffn, *w_up, *conv_w, *conv_b, *w_down, *g_fin;
    float* out; unsigned char* ws; long long ph_lo, ph_hi;
};

typedef __bf16 bf16v2_t __attribute__((ext_vector_type(2)));
__device__ __forceinline__ unsigned cvt_pk_bf16(float lo, float hi) { const f32x2 v = {lo, hi}; const bf16v2_t b = __builtin_convertvector(v, bf16v2_t); return __builtin_bit_cast(unsigned, b); }
__device__ __forceinline__ bf16_t f2bf(float f) { unsigned u = __float_as_uint(f); u += 0x7FFFu + ((u >> 16) & 1u); return (bf16_t)(u >> 16); }
__device__ __forceinline__ float bf2f(bf16_t b) { return __uint_as_float(((unsigned)b) << 16); }
__device__ __forceinline__ float wave_sum(float v) {
#pragma unroll
    for (int o = 32; o >= 1; o >>= 1) v += __shfl_xor(v, o);
    return v;
}
__device__ __forceinline__ float sigmoidf_(float x) { return 1.0f / (1.0f + __expf(-x)); }

#define XB_TMO      128
#define XB_XCNT(j)  (256  + 64 * (j))
#define XB_XSUB(j)  (1280 + 64 * (j))
#define XB_XGEN(j)  (2304 + 64 * (j))
#define XB_TOP      3328
#define XB_TOPGEN   3392
#define XCD_BAR_WORDS 3456
#define XB_SPIN_CAP (1u << 18)
__device__ __forceinline__ unsigned xb_ld(unsigned* p)              { return __hip_atomic_load(p, __ATOMIC_RELAXED, __HIP_MEMORY_SCOPE_AGENT); }
__device__ __forceinline__ unsigned xb_add(unsigned* p, unsigned v) { return __hip_atomic_fetch_add(p, v, __ATOMIC_RELAXED, __HIP_MEMORY_SCOPE_AGENT); }
__device__ __forceinline__ unsigned xb_xcc_id() { return (unsigned)__builtin_amdgcn_s_getreg((3 << 11) | 20) & 0xFu; }
#define XB_SPIN(cond, bar) do { unsigned _sp = 0; while (cond) { __builtin_amdgcn_s_sleep(1); \
    if ((++_sp & 255u) == 0u) { if (xb_ld(&(bar)[XB_TMO])) break; if (_sp > XB_SPIN_CAP) { atomicAdd(&(bar)[XB_TMO], 1u); break; } } } } while (0)
struct XcdBarrier { unsigned* bar; unsigned x; volatile LAS unsigned* st; };
__device__ __forceinline__ XcdBarrier xcd_barrier_post(unsigned* bar, volatile LAS unsigned* st) {
    XcdBarrier b; b.bar = bar; b.x = xb_xcc_id(); b.st = st;
    if (threadIdx.x == 0) (void)xb_add(&bar[XB_XCNT(b.x)], 1u);
    return b;
}
__device__ __forceinline__ void xcd_barrier_complete(unsigned* bar, unsigned x, unsigned& nloc, unsigned& nx) {
    const unsigned G = gridDim.x * gridDim.y * gridDim.z;
    unsigned sum, cnt, mine, sp = 0u;
    for (;;) {
        sum = 0u; cnt = 0u; mine = 0u;
#pragma unroll
        for (unsigned j = 0; j < 16; ++j) { const unsigned c = xb_ld(&bar[XB_XCNT(j)]); sum += c; cnt += (c > 0u) ? 1u : 0u; mine = (j == x) ? c : mine; }
        if (sum == G) break;
        __builtin_amdgcn_s_sleep(1);
        if ((++sp & 255u) == 0u) { if (xb_ld(&bar[XB_TMO])) break; if (sp > XB_SPIN_CAP) { atomicAdd(&bar[XB_TMO], 1u); break; } }
    }
    nloc = mine > 0u ? mine : 1u; nx = cnt > 0u ? cnt : 1u;
}
__device__ __forceinline__ void xcd_barrier(const XcdBarrier& b) {
    asm volatile("s_waitcnt vmcnt(0)" ::: "memory");
    __syncthreads();
    if (threadIdx.x == 0) {
        unsigned* bar = b.bar;
        __builtin_amdgcn_s_waitcnt(0);
        unsigned nloc = b.st[0], nx = b.st[1];
        if (nloc == 0u) { xcd_barrier_complete(bar, b.x, nloc, nx); b.st[0] = nloc; b.st[1] = nx; }
        const unsigned old = xb_add(&bar[XB_XSUB(b.x)], 1u);
        const unsigned gen = old / nloc;
        if (old + 1u == (gen + 1u) * nloc) {
            __builtin_amdgcn_fence(__ATOMIC_RELEASE, "agent");
            asm volatile("s_waitcnt vmcnt(0)" ::: "memory");
            const unsigned og = xb_add(&bar[XB_TOP], 1u);
            const unsigned tg = og / nx;
            if (og + 1u == (tg + 1u) * nx) xb_add(&bar[XB_TOPGEN], 1u);
            else XB_SPIN(xb_ld(&bar[XB_TOPGEN]) == tg, bar);
            __builtin_amdgcn_fence(__ATOMIC_ACQUIRE, "agent");
            xb_add(&bar[XB_XGEN(b.x)], 1u);
            asm volatile("s_waitcnt vmcnt(0)" ::: "memory");
        } else {
            XB_SPIN(xb_ld(&bar[XB_XGEN(b.x)]) == gen, bar);
            __builtin_amdgcn_fence(__ATOMIC_ACQUIRE, "agent");
            asm volatile("s_waitcnt vmcnt(0)" ::: "memory");
        }
    }
    __syncthreads();
}

namespace pg8 {
constexpr int BM = 256, BK = 64, HALF = 128, HTB = HALF * BK * 2, STAGE_BYTES = 8 * HTB, NXCD = 8, WGM = 8;
__host__ __device__ __forceinline__ int lds_byte(int r, int c) { const int st = (r >> 4) * 2 + (c >> 5), rr = r & 15, cc = c & 31, ob = rr * 64 + cc * 2; return st * 1024 + (ob ^ (((ob >> 9) & 1) << 5)); }
__host__ __device__ __forceinline__ void stage_rc(int b, int& R, int& C) { const int st = b / 1024, sb = b % 1024, swz = sb ^ (((sb >> 9) & 1) << 5); R = (st >> 1) * 16 + swz / 64; C = (st & 1) * 32 + (swz % 64) / 2; }
__host__ __device__ __forceinline__ int perm32(int rho) { const int n = rho >> 4, i = rho & 15; return 8 * (i >> 2) + 4 * n + (i & 3); }
struct Unit { int pm, pn; };
struct Gemm { const bf16_t* A; const bf16_t* Bt; int M, N, K; };
struct StaticOrder {
    int nM, nN, nwg, G, c;
    __host__ __device__ void init(int M, int N, int G_, int c_) { nM = M / BM; nN = N / BM; nwg = nM * nN; G = G_; c = c_; }
    __host__ __device__ bool next(int i, Unit& u) const {
        const long L = (long)i * G + c; if (L >= nwg) return false;
        int wgid = (int)L; { const int q = nwg / NXCD, r = nwg % NXCD, xcd = wgid % NXCD, off = wgid / NXCD; wgid = (xcd < r ? xcd * (q + 1) : r * (q + 1) + (xcd - r) * q) + off; }
        const int nig = WGM * nN, gid = wgid / nig, fm = gid * WGM, gsz = (nM - fm) < WGM ? (nM - fm) : WGM;
        u.pm = fm + ((wgid % nig) % gsz); u.pn = (wgid % nig) / gsz; return true;
    }
    __device__ __forceinline__ void a_ready(const Unit&) const {}
    __device__ __forceinline__ void done(const Unit&) const {}
};
template <class Epi, class Sched, bool ALIGN_EPI = false, bool SP2 = false>
__device__ __forceinline__ void gemm_phase(LAS unsigned char* lds, const Gemm g, const Sched& S, const Epi& E) {
    const int tid = threadIdx.x, wid = __builtin_amdgcn_readfirstlane(tid >> 6), lane = tid & 63, wr = wid >> 2, wc = wid & 3, fr = lane & 15, fq = lane >> 4;
    const int K = g.K, nt = K / BK;
    unsigned voffA[2], voffB[2];
#pragma unroll
    for (int i = 0; i < 2; ++i) { int R, C; stage_rc(tid * 16 + i * 8192, R, C); const int Rb = Epi::PERM ? ((R & ~31) + perm32(R & 31)) : R;
        voffA[i] = (unsigned)(R * K + C) * 2u; voffB[i] = (unsigned)(Rb * K + C) * 2u; }
    const size_t kstep = (size_t)(BK * 2);
    const size_t hstep = (size_t)HALF * K * 2;
    const size_t tstep = 2 * hstep;
    const unsigned ldsw = (unsigned)wid * 1024u;
    const int aoff = lds_byte(wr * 64 + fr, fq * 8), boff = lds_byte(wc * 32 + fr, fq * 8);
#define PG8_SA(b, h) (((b) * 2 + (h)) * HTB)
#define PG8_SB(b, h) ((4 + (b) * 2 + (h)) * HTB)
#define PG8_STAGE(bufoff, gbase, voff) do { _Pragma("unroll") for (int _i = 0; _i < 2; ++_i) \
        __builtin_amdgcn_global_load_lds((const unsigned*)((const char*)(gbase) + (voff)[_i]), (LAS unsigned*)(lds + (bufoff) + ldsw + _i * 8192), 16, 0, 0); } while (0)
#define PG8_LDA(dst, b, h) do { _Pragma("unroll") for (int m = 0; m < 4; ++m) _Pragma("unroll") for (int k = 0; k < 2; ++k) dst[m][k] = *(const LAS bf16x8*)(lds + PG8_SA(b, h) + aoff + m * 2048 + k * 1024); } while (0)
#define PG8_LDB(dst, b, h) do { _Pragma("unroll") for (int n = 0; n < 2; ++n) _Pragma("unroll") for (int k = 0; k < 2; ++k) dst[n][k] = *(const LAS bf16x8*)(lds + PG8_SB(b, h) + boff + n * 2048 + k * 1024); } while (0)
#define PG8_MMA(ai, bj, At, Bt) do { __builtin_amdgcn_s_setprio(1); _Pragma("unroll") for (int m = 0; m < 4; ++m) _Pragma("unroll") for (int n = 0; n < 2; ++n) _Pragma("unroll") for (int k = 0; k < 2; ++k) \
        acc[ai][bj][m][n] = __builtin_amdgcn_mfma_f32_16x16x32_bf16(Bt[n][k], At[m][k], acc[ai][bj][m][n], 0, 0, 0); __builtin_amdgcn_s_setprio(0); } while (0)
#define PG8_WAIT_V(n) asm volatile("s_waitcnt vmcnt(" #n ")" ::: "memory")
#define PG8_WAIT_L(n) asm volatile("s_waitcnt lgkmcnt(" #n ")" ::: "memory")
#define PG8_BAR __builtin_amdgcn_s_barrier()
#define PG8_SCHED __builtin_amdgcn_sched_barrier(0)
    Unit cur, nxt; int ui = 0;
    if (!S.next(0, cur)) return;
    f32x4 acc[2][2][4][2];
#pragma unroll
    for (int a = 0; a < 2; ++a)
#pragma unroll
        for (int b = 0; b < 2; ++b)
#pragma unroll
            for (int m = 0; m < 4; ++m)
#pragma unroll
                for (int n = 0; n < 2; ++n) acc[a][b][m][n] = (f32x4){0.f, 0.f, 0.f, 0.f};
    bf16x8 At[4][2], B0[2][2], B1[2][2];
    const char* cA = (const char*)g.A + (size_t)cur.pm * tstep; const char* cB = (const char*)g.Bt + (size_t)cur.pn * tstep;
    S.a_ready(cur);
    if constexpr (SP2) {
        PG8_STAGE(PG8_SB(0, 0), cB, voffB); PG8_STAGE(PG8_SB(0, 1), cB + hstep, voffB); PG8_STAGE(PG8_SA(0, 0), cA, voffA); PG8_STAGE(PG8_SA(0, 1), cA + hstep, voffA);
        if (wr == 1) PG8_BAR;
        PG8_WAIT_V(2); PG8_BAR;
        PG8_STAGE(PG8_SB(1, 0), cB + kstep, voffB); PG8_STAGE(PG8_SA(1, 0), cA + kstep, voffA); PG8_STAGE(PG8_SB(1, 1), cB + hstep + kstep, voffB);
        PG8_WAIT_V(6); PG8_BAR;
    } else {
        PG8_STAGE(PG8_SB(0, 0), cB, voffB); PG8_STAGE(PG8_SA(0, 0), cA, voffA); PG8_STAGE(PG8_SB(0, 1), cB + hstep, voffB); PG8_STAGE(PG8_SA(0, 1), cA + hstep, voffA);
        if (wr == 1) PG8_BAR;
        PG8_WAIT_V(4); PG8_BAR;
        PG8_STAGE(PG8_SB(1, 0), cB + kstep, voffB); PG8_STAGE(PG8_SA(1, 0), cA + kstep, voffA); PG8_STAGE(PG8_SB(1, 1), cB + hstep + kstep, voffB);
        PG8_WAIT_V(6); PG8_BAR;
    }
    for (;;) {
        const bool has_next = S.next(ui + 1, nxt);
        const char* nA = has_next ? (const char*)g.A + (size_t)nxt.pm * tstep : cA; const char* nB = has_next ? (const char*)g.Bt + (size_t)nxt.pn * tstep : cB;
        for (int t = 0; t < nt; t += 2) {
            const bool last = (t == nt - 2);
            const char* a1 = cA + (size_t)(t + 1) * kstep;
            const char* a2 = last ? nA : cA + (size_t)(t + 2) * kstep; const char* b2 = last ? nB : cB + (size_t)(t + 2) * kstep;
            const char* a3 = a2 + kstep; const char* b3 = b2 + kstep;
            if (last && has_next) S.a_ready(nxt);
            if constexpr (SP2) {
            PG8_LDB(B0, 0, 0); PG8_LDB(B1, 0, 1); PG8_SCHED; PG8_LDA(At, 0, 0); PG8_STAGE(PG8_SA(1, 1), a1 + hstep, voffA);
            PG8_WAIT_V(8); PG8_WAIT_L(0); PG8_BAR; PG8_MMA(0, 0, At, B0); PG8_MMA(0, 1, At, B1); PG8_BAR; PG8_SCHED;
            PG8_LDA(At, 0, 1); PG8_STAGE(PG8_SB(0, 0), b2, voffB); PG8_STAGE(PG8_SB(0, 1), b2 + hstep, voffB); PG8_STAGE(PG8_SA(0, 0), a2, voffA);
            PG8_WAIT_V(8); PG8_WAIT_L(0); PG8_BAR; PG8_MMA(1, 0, At, B0); PG8_MMA(1, 1, At, B1); PG8_BAR; PG8_SCHED;
            PG8_LDB(B0, 1, 0); PG8_LDB(B1, 1, 1); PG8_SCHED; PG8_LDA(At, 1, 0); PG8_STAGE(PG8_SA(0, 1), a2 + hstep, voffA);
            PG8_WAIT_V(8); PG8_WAIT_L(0); PG8_BAR; PG8_MMA(0, 0, At, B0); PG8_MMA(0, 1, At, B1); PG8_BAR; PG8_SCHED;
            PG8_LDA(At, 1, 1); PG8_STAGE(PG8_SB(1, 0), b3, voffB); PG8_STAGE(PG8_SB(1, 1), b3 + hstep, voffB); PG8_STAGE(PG8_SA(1, 0), a3, voffA);
            PG8_WAIT_V(8); PG8_WAIT_L(0); PG8_BAR; PG8_MMA(1, 0, At, B0); PG8_MMA(1, 1, At, B1); PG8_BAR; PG8_SCHED;
            } else {
            PG8_LDB(B0, 0, 0); PG8_SCHED; PG8_LDA(At, 0, 0); PG8_STAGE(PG8_SA(1, 1), a1 + hstep, voffA);
            PG8_WAIT_L(8); PG8_BAR; PG8_WAIT_L(0); PG8_MMA(0, 0, At, B0); PG8_BAR; PG8_SCHED;
            PG8_LDB(B1, 0, 1); PG8_STAGE(PG8_SB(0, 0), b2, voffB);
            PG8_BAR; PG8_WAIT_L(0); PG8_MMA(0, 1, At, B1); PG8_BAR;
            PG8_LDA(At, 0, 1); PG8_STAGE(PG8_SA(0, 0), a2, voffA);
            PG8_BAR; PG8_WAIT_L(0); PG8_MMA(1, 0, At, B0); PG8_BAR; PG8_SCHED;
            PG8_STAGE(PG8_SB(0, 1), b2 + hstep, voffB);
            PG8_WAIT_V(6); PG8_BAR; PG8_MMA(1, 1, At, B1); PG8_BAR;
            PG8_LDB(B0, 1, 0); PG8_SCHED; PG8_LDA(At, 1, 0); PG8_STAGE(PG8_SA(0, 1), a2 + hstep, voffA);
            PG8_WAIT_L(8); PG8_BAR; PG8_WAIT_L(0); PG8_MMA(0, 0, At, B0); PG8_BAR; PG8_SCHED;
            PG8_LDB(B1, 1, 1); PG8_STAGE(PG8_SB(1, 0), b3, voffB);
            PG8_BAR; PG8_WAIT_L(0); PG8_MMA(0, 1, At, B1); PG8_BAR;
            PG8_LDA(At, 1, 1); PG8_STAGE(PG8_SA(1, 0), a3, voffA);
            PG8_BAR; PG8_WAIT_L(0); PG8_MMA(1, 0, At, B0); PG8_BAR; PG8_SCHED;
            PG8_STAGE(PG8_SB(1, 1), b3 + hstep, voffB);
            PG8_WAIT_V(6); PG8_BAR; PG8_MMA(1, 1, At, B1); PG8_BAR;
            }
        }
        if constexpr (ALIGN_EPI) { if (wr == 0) PG8_BAR; }
        if constexpr (!Epi::AFTER_DRAIN) { E(acc, cur, wr, wc, fr, fq); S.done(cur); }
        if (!has_next) break;
#pragma unroll
        for (int a = 0; a < 2; ++a)
#pragma unroll
            for (int b = 0; b < 2; ++b)
#pragma unroll
                for (int m = 0; m < 4; ++m)
#pragma unroll
                    for (int n = 0; n < 2; ++n) acc[a][b][m][n] = (f32x4){0.f, 0.f, 0.f, 0.f};
        cur = nxt; cA = nA; cB = nB; ++ui;
        if constexpr (ALIGN_EPI) { if (wr == 1) PG8_BAR; }
    }
    PG8_WAIT_V(0);
    if constexpr (!ALIGN_EPI) { if (wr == 0) PG8_BAR; }
    PG8_BAR;
    if constexpr (Epi::AFTER_DRAIN) { E.fused(acc, cur, wr, wc, fr, fq, lds, wid, lane); S.done(cur); }
#undef PG8_SA
#undef PG8_SB
#undef PG8_STAGE
#undef PG8_LDA
#undef PG8_LDB
#undef PG8_MMA
#undef PG8_WAIT_V
#undef PG8_WAIT_L
#undef PG8_BAR
#undef PG8_SCHED
}
}

template <class F>
__device__ __forceinline__ void skinny32_unit(unsigned char* lds, const bf16_t* A, const bf16_t* Bt, int K, int n0, F&& f) {
    const int tid = threadIdx.x, wid = tid >> 6, lane = tid & 63, r = lane & 31, h = lane >> 5;
    const int kw = K >> 3, k0 = wid * kw;
    f32x16 acc;
#pragma unroll
    for (int i = 0; i < 16; ++i) acc[i] = 0.f;
    const bf16_t* ap = A + (size_t)r * K + k0 + 8 * h; const bf16_t* bp = Bt + (size_t)(n0 + r) * K + k0 + 8 * h;
    int ks = 0;
    for (; ks + 128 <= kw; ks += 128) {
        bf16x8 af[8], bf[8];
#pragma unroll
        for (int i = 0; i < 8; ++i) { af[i] = *(const bf16x8*)(ap + ks + 16 * i); bf[i] = *(const bf16x8*)(bp + ks + 16 * i); }
        __builtin_amdgcn_sched_barrier(0);
#pragma unroll
        for (int i = 0; i < 8; ++i) acc = __builtin_amdgcn_mfma_f32_32x32x16_bf16(af[i], bf[i], acc, 0, 0, 0);
    }
    if (ks < kw) {
        bf16x8 af[6], bf[6];
#pragma unroll
        for (int i = 0; i < 6; ++i) { const int kk = (ks + 16 * i < kw) ? ks + 16 * i : ks; af[i] = *(const bf16x8*)(ap + kk); bf[i] = *(const bf16x8*)(bp + kk); }
        __builtin_amdgcn_sched_barrier(0);
#pragma unroll
        for (int i = 0; i < 6; ++i) if (ks + 16 * i < kw) acc = __builtin_amdgcn_mfma_f32_32x32x16_bf16(af[i], bf[i], acc, 0, 0, 0);
    }
    float* red = (float*)lds;
#pragma unroll
    for (int i = 0; i < 16; ++i) { const int m = (i & 3) + 8 * (i >> 2) + 4 * h; red[wid * 1024 + m * 32 + r] = acc[i]; }
    __syncthreads();
    for (int e = tid; e < 1024; e += 512) { float s = 0.f;
#pragma unroll
        for (int w = 0; w < 8; ++w) s += red[w * 1024 + e];
        f(e >> 5, n0 + (e & 31), s); }
    __syncthreads();
}

__device__ __forceinline__ int map_win(int n) { return n < 1280 ? n : (n < 3328 ? n + 24 : (n < 3352 ? n - 2048 : -1)); }
struct TrDesc { const float* src; bf16_t* dst; int ldsrc, K, n0, k0, mode; };
__device__ __forceinline__ void tr_load(const TrDesc& d, float (&v)[8]) {
    const int tid = threadIdx.x, nn = tid & 63, kk0 = tid >> 6; const int n = d.n0 + nn; const int sc = (d.mode == 1) ? map_win(n) : n;
#pragma unroll
    for (int i = 0; i < 8; ++i) { const int kk = kk0 + 8 * i; v[i] = (sc >= 0) ? d.src[(size_t)(d.k0 + kk) * d.ldsrc + sc] : 0.f; }
}
__device__ __forceinline__ void tr_store(float* t, const TrDesc& d, const float (&v)[8]) {
    const int tid = threadIdx.x, nn = tid & 63, kk0 = tid >> 6;
#pragma unroll
    for (int i = 0; i < 8; ++i) t[nn * 65 + kk0 + 8 * i] = v[i];
    __syncthreads();
    const int r = tid >> 3, ks = (tid & 7) * 8; const float* row = t + r * 65 + ks;
    u32x4 w; w.x = cvt_pk_bf16(row[0], row[1]); w.y = cvt_pk_bf16(row[2], row[3]); w.z = cvt_pk_bf16(row[4], row[5]); w.w = cvt_pk_bf16(row[6], row[7]);
    *(u32x4*)(d.dst + (size_t)(d.n0 + r) * d.K + d.k0 + ks) = w;
    __syncthreads();
}
__device__ __forceinline__ void tr_unit(float* t, const float* src, int ldsrc, bf16_t* dst, int K, int n0, int k0, int mode) {
    const int tid = threadIdx.x, nn = tid & 63, kk0 = tid >> 6;
    const int n = n0 + nn; const int sc = (mode == 1) ? map_win(n) : n;
#pragma unroll
    for (int i = 0; i < 8; ++i) { const int kk = kk0 + 8 * i; t[nn * 65 + kk] = (sc >= 0) ? src[(size_t)(k0 + kk) * ldsrc + sc] : 0.f; }
    __syncthreads();
    const int r = tid >> 3, ks = (tid & 7) * 8; const float* row = t + r * 65 + ks;
    u32x4 w; w.x = cvt_pk_bf16(row[0], row[1]); w.y = cvt_pk_bf16(row[2], row[3]); w.z = cvt_pk_bf16(row[4], row[5]); w.w = cvt_pk_bf16(row[6], row[7]);
    *(u32x4*)(dst + (size_t)(n0 + r) * K + k0 + ks) = w;
    __syncthreads();
}

__device__ __forceinline__ void phase0(const Params& p, unsigned char* lds) {
    const int tid = threadIdx.x, G = gridDim.x, bid = blockIdx.x;
    unsigned char* ws = p.ws;
    bf16_t* WinT = (bf16_t*)(ws + WS_WIN_T); bf16_t* WoutT = (bf16_t*)(ws + WS_WOUT_T); bf16_t* WupT = (bf16_t*)(ws + WS_WUP_T); bf16_t* WdnT = (bf16_t*)(ws + WS_WDN_T);
    bf16_t* W1T = (bf16_t*)(ws + WS_W1T); bf16_t* W2T = (bf16_t*)(ws + WS_W2T);
    float* t = (float*)lds;
    constexpr int U_ADA = 96, U_WIN = 16 * 56, U_WOUT = 16 * 16, U_WUP = 16 * 88, U_WDN = 44 * 16, U_W1 = 2 * 32 * 2, U_W2 = 2 * 2, U_PE = 16;
    constexpr int B_ADA = 0, B_WIN = B_ADA + U_ADA, B_WOUT = B_WIN + U_WIN, B_WUP = B_WOUT + U_WOUT, B_WDN = B_WUP + U_WUP, B_W1 = B_WDN + U_WDN, B_W2 = B_W1 + U_W1, B_PE = B_W2 + U_W2, B_END = B_PE + U_PE;
    {
        auto desc = [&](int u) -> TrDesc { TrDesc d;
            if (u < B_WOUT) { const int v = u - B_WIN; d = TrDesc{p.w_in, WinT, 3352, 1024, (v % 56) * 64, (v / 56) * 64, 1}; }
            else if (u < B_WUP) { const int v = u - B_WOUT; d = TrDesc{p.w_out, WoutT, 1024, 1024, (v % 16) * 64, (v / 16) * 64, 0}; }
            else if (u < B_WDN) { const int v = u - B_WUP; d = TrDesc{p.w_up, WupT, 5632, 1024, (v % 88) * 64, (v / 88) * 64, 0}; }
            else if (u < B_W1) { const int v = u - B_WDN; d = TrDesc{p.w_down, WdnT, 1024, 2816, (v % 16) * 64, (v / 16) * 64, 0}; }
            else if (u < B_W2) { const int v = u - B_W1; const int kv = v >> 6, w = v & 63; d = TrDesc{kv ? p.w1_v : p.w1_k, W1T + (size_t)kv * 128 * 2048, 128, 2048, (w & 1) * 64, (w >> 1) * 64, 0}; }
            else { const int v = u - B_W2; const int kv = v >> 1, w = v & 1; d = TrDesc{kv ? p.w2_v : p.w2_k, W2T + (size_t)kv * 64 * 128, 64, 128, 0, w * 64, 0}; }
            return d; };
        int u = B_WIN + bid; float cur[8], nxt[8];
        if (u < B_PE) { TrDesc dc = desc(u); tr_load(dc, cur);
            for (;;) { const int un = u + G; const bool more = un < B_PE; TrDesc dn = dc; if (more) { dn = desc(un); tr_load(dn, nxt); }
                tr_store(t, dc, cur);
                if (!more) break;
#pragma unroll
                for (int i = 0; i < 8; ++i) cur[i] = nxt[i];
                dc = dn; u = un; } }
    }
    for (int u = bid; u < B_END; u += G) {
        if (u >= B_WIN && u < B_PE) continue;
        if (u < B_WIN) {
            const int ks = u / 12, cc = u % 12; float* st = t;
            for (int i = tid; i < 33 * 128; i += 512) { const int row = i >> 7, k = i & 127; const float c = (row == 0) ? p.c_p[ks * 128 + k] : p.c_s[(size_t)(row - 1) * 1024 + ks * 128 + k]; st[i] = c / (1.0f + __expf(-c)); }
            __syncthreads();
            const int col = cc * 512 + tid; float acc[33];
#pragma unroll
            for (int r = 0; r < 33; ++r) acc[r] = 0.f;
            const float* wp = p.w_ada + (size_t)(ks * 128) * 6144 + col;
            for (int k0 = 0; k0 < 128; k0 += 8) { float wv[8];
#pragma unroll
                for (int u8 = 0; u8 < 8; ++u8) wv[u8] = wp[(size_t)(k0 + u8) * 6144];
                __builtin_amdgcn_sched_barrier(0);
#pragma unroll
                for (int u8 = 0; u8 < 8; ++u8)
#pragma unroll
                    for (int r = 0; r < 33; ++r) acc[r] += st[r * 128 + k0 + u8] * wv[u8]; }
            float* mp = (float*)(ws + WS_MODP) + (size_t)ks * 33 * 6144 + col;
#pragma unroll
            for (int r = 0; r < 33; ++r) mp[(size_t)r * 6144] = acc[r];
            __syncthreads();
        } else if (u < B_WOUT) { const int v = u - B_WIN; tr_unit(t, p.w_in, 3352, WinT, 1024, (v % 56) * 64, (v / 56) * 64, 1); }
        else if (u < B_WUP) { const int v = u - B_WOUT; tr_unit(t, p.w_out, 1024, WoutT, 1024, (v % 16) * 64, (v / 16) * 64, 0); }
        else if (u < B_WDN) { const int v = u - B_WUP; tr_unit(t, p.w_up, 5632, WupT, 1024, (v % 88) * 64, (v / 88) * 64, 0); }
        else if (u < B_W1) { const int v = u - B_WDN; tr_unit(t, p.w_down, 1024, WdnT, 2816, (v % 16) * 64, (v / 16) * 64, 0); }
        else if (u < B_W2) { const int v = u - B_W1; const int kv = v >> 6, w = v & 63; tr_unit(t, kv ? p.w1_v : p.w1_k, 128, W1T + (size_t)kv * 128 * 2048, 2048, (w & 1) * 64, (w >> 1) * 64, 0); }
        else if (u < B_PE) { const int v = u - B_W2; const int kv = v >> 1, w = v & 1; tr_unit(t, kv ? p.w2_v : p.w2_k, 64, W2T + (size_t)kv * 64 * 128, 128, 0, w * 64, 0); }
        else {
            const int kv = (u - B_PE) >> 3, sl = (u - B_PE) & 7; const float* pe = kv ? p.pe_v : p.pe_k; const float* w1 = kv ? p.w1_v : p.w1_k;
            const int hh = tid & 127, q = tid >> 7; float s = 0.f; const int kb = sl * 256 + q * 64;
            for (int k0 = kb; k0 < kb + 64; k0 += 16) { float wv[16], pv[16];
#pragma unroll
                for (int i = 0; i < 16; ++i) { wv[i] = w1[(size_t)(k0 + i) * 128 + hh]; pv[i] = pe[k0 + i]; }
#pragma unroll
                for (int i = 0; i < 16; ++i) s += pv[i] * wv[i]; }
            t[tid] = s; __syncthreads();
            if (tid < 128) ((float*)(ws + WS_PET))[(kv * 8 + sl) * 128 + tid] = t[tid] + t[tid + 128] + t[tid + 256] + t[tid + 384];
            __syncthreads();
        }
    }
    const int gt = bid * 512 + tid, GT = G * 512;
    if (gt < 2) ((unsigned*)(ws + WS_KCM))[gt] = 0u;
    {
        float* rc = (float*)(ws + WS_ROPE); float* rs = rc + (size_t)16385 * 32;
        for (int i = gt; i < 16385 * 32; i += GT) { const int pos = i >> 5, j = i & 31;
            const float inv = powf(10000.0f, -(float)j / 32.0f); const float ang = (float)pos * inv;
            const double a = (double)ang; const double k = rint(a * 0.15915494309189535); const double rr = a - k * 6.283185307179586;
            const float r = (float)rr; rc[i] = cosf(r); rs[i] = sinf(r); }
    }
    {
        float* bl = (float*)(ws + WS_BIAS);
        for (int i = gt; i < 8 * 1025; i += GT) { const int hh = i / 1025, n = i % 1025; int b;
            if (n < 16) b = n; else { const float v = logf((float)n / 16.0f) / 4.1588830833596715f * 16.0f; b = 16 + (int)v; if (b > 31) b = 31; }
            bl[hh * 1032 + n] = p.table[b * 8 + hh]; }
        if (gt < 8) { float m = -1e30f; for (int b = 0; b < 32; ++b) m = fmaxf(m, p.table[b * 8 + gt]); bl[gt * 1032 + 1025] = m; }
    }
    {
        bf16_t* mix = (bf16_t*)(ws + WS_MIX);
#if DBG_SKIP_MIX
        for (int i = gt; i < SEQ * 128; i += GT) { const int row = i >> 7, c8 = i & 127; unsigned hsh = (unsigned)(row * 2654435761u) ^ (unsigned)(c8 * 40503u); hsh ^= hsh >> 13; hsh *= 0x5bd1e995u; hsh ^= hsh >> 15; const unsigned v = 0x3e803e80u + (hsh & 0xffu) * 0x00010001u + ((hsh & 0x100u) << 7) + ((hsh & 0x200u) << 22); *(u32x4*)(mix + (size_t)row * 1024 + c8 * 8) = (u32x4){v, v ^ 0x80000000u, v + 0x00100010u, v ^ 0x00008000u}; }
#endif
        if (DBG_NO_NSA) for (int i = gt; i < (SEQ + NB) * 64; i += GT) { const int row = i >> 6, c8 = i & 63; *(u32x4*)(mix + (size_t)row * 1024 + c8 * 8) = (u32x4){0u, 0u, 0u, 0u}; }
    }
    {
        for (int i = gt; i < NB * DFF; i += GT) { const int b = i / DFF, c = i % DFF; p.out[O_CONV_S + (size_t)b * 2 * DFF + c] = p.st_conv[(size_t)b * 2 * DFF + DFF + c]; }
    }
    {
        const f32x4* src = (const f32x4*)p.st_win; f32x4* dst = (f32x4*)(p.out + O_WIN_S);
        for (int i = gt; i < NB * 511 * 64; i += GT) { const int b = i / (511 * 64), rem = i % (511 * 64); dst[(size_t)b * 512 * 64 + rem] = src[(size_t)b * 512 * 64 + 64 + rem]; }
    }
}

__device__ __forceinline__ void norm_row_store(const float* xr, const float* sA, const float* sB, bf16_t* dst, int lane) {
    f32x4 v[4]; float ss = 0.f;
#pragma unroll
    for (int j = 0; j < 4; ++j) { v[j] = *(const f32x4*)(xr + lane * 4 + 256 * j); ss += v[j][0] * v[j][0] + v[j][1] * v[j][1] + v[j][2] * v[j][2] + v[j][3] * v[j][3]; }
    ss = wave_sum(ss); const float rstd = rsqrtf(ss * (1.0f / 1024.0f) + 1e-6f);
#pragma unroll
    for (int j = 0; j < 4; ++j) { const int c = lane * 4 + 256 * j; const f32x4 a = *(const f32x4*)(sA + c), b = *(const f32x4*)(sB + c);
        u32x2 w; w.x = cvt_pk_bf16(v[j][0] * rstd * a[0] + b[0], v[j][1] * rstd * a[1] + b[1]); w.y = cvt_pk_bf16(v[j][2] * rstd * a[2] + b[2], v[j][3] * rstd * a[3] + b[3]);
        *(u32x2*)(dst + c) = w; }
}
__device__ __forceinline__ void build_mod_partial(const Params& p, float* sA, float* sB, int modrow, const float* gvec) {
    const float* mp = (const float*)(p.ws + WS_MODP);
    for (int c = threadIdx.x; c < 1024; c += 512) { float sc = p.b_ada[1024 + c], sh = p.b_ada[c];
#pragma unroll
        for (int ks = 0; ks < 8; ++ks) { const float* q = mp + ((size_t)ks * 33 + modrow) * 6144; sc += q[1024 + c]; sh += q[c]; }
        sA[c] = gvec[c] * (1.0f + sc); sB[c] = sh; }
}
__device__ __forceinline__ void phase1(const Params& p, unsigned char* lds) {
    const int tid = threadIdx.x, wid = tid >> 6, lane = tid & 63, G = gridDim.x, bid = blockIdx.x;
    float* sA = (float*)lds; float* sB = sA + 1024;
    bf16_t* HN = (bf16_t*)(p.ws + WS_HN);
    bool built = false;
    for (int u = bid; u < 256 + NB; u += G) {
        if (u < 256) {
            if (!built) { build_mod_partial(p, sA, sB, 0, p.g_mix); __syncthreads(); built = true; }
            for (int i = 0; i < 8; ++i) { const int row = u * 64 + wid * 8 + i; norm_row_store(p.x_p + (size_t)row * 1024, sA, sB, HN + (size_t)row * 1024, lane); }
        } else {
            __syncthreads(); const int b = u - 256; build_mod_partial(p, sA, sB, 1 + b, p.g_mix); __syncthreads(); built = false;
            if (wid == 0) norm_row_store(p.x_s + (size_t)b * 1024, sA, sB, HN + (size_t)(SEQ + b) * 1024, lane);
            __syncthreads();
        }
    }
    const float* mp = (const float*)(p.ws + WS_MODP); float* mod = (float*)(p.ws + WS_MOD);
    for (int i = bid * 512 + tid; i < 33 * 6144; i += G * 512) { float s = p.b_ada[i % 6144];
#pragma unroll
        for (int ks = 0; ks < 8; ++ks) s += mp[(size_t)ks * 33 * 6144 + i];
        mod[i] = s; }
}

struct EpiWin {
    static constexpr bool PERM = false, AFTER_DRAIN = false;
    unsigned char* ws; float* out;
    __device__ __forceinline__ void operator()(const f32x4 (&acc)[2][2][4][2], const pg8::Unit& u, int wr, int wc, int fr, int fq) const {
        const int pn = u.pn; const int row0 = u.pm * 256 + wr * 64 + fr; const int cb = wc * 32 + 4 * fq;
        if (pn == 13) {
            if (wc == 0) { float* gts = (float*)(ws + WS_GATES);
#pragma unroll
                for (int ai = 0; ai < 2; ++ai)
#pragma unroll
                    for (int m = 0; m < 4; ++m) { const int row = row0 + ai * 128 + m * 16;
#pragma unroll
                        for (int n = 0; n < 2; ++n) { const int c = n * 16 + 4 * fq; if (c < 24) { const f32x4 v = acc[ai][0][m][n];
                            *(f32x4*)(gts + (size_t)row * 24 + c) = (f32x4){sigmoidf_(v[0]), sigmoidf_(v[1]), sigmoidf_(v[2]), sigmoidf_(v[3])}; } } } }
            return;
        }
        bf16_t* bdst; int ld; float sc = 1.f; float* fdst = nullptr; int rmin = 0;
        if (pn < 2) { bdst = (bf16_t*)(ws + WS_QA) + pn * 256; ld = 512; sc = 0.125f; }
        else if (pn == 2) { bdst = (bf16_t*)(ws + WS_KVC); ld = 256; fdst = out + O_CMP_P; }
        else if (pn == 3) { bdst = (bf16_t*)(ws + WS_KVS); ld = 256; fdst = out + O_SLC_P; }
        else if (pn == 4) { bdst = (bf16_t*)(ws + WS_KVW); ld = 256; fdst = out + O_WIN_P - (size_t)15872 * 256; rmin = 15872; }
        else if (pn < 7) { bdst = (bf16_t*)(ws + WS_QR) + (pn - 5) * 256; ld = 512; }
        else if (pn < 9) { bdst = (bf16_t*)(ws + WS_KR) + (pn - 7) * 256; ld = 512; }
        else if (pn < 11) { bdst = (bf16_t*)(ws + WS_VR) + (pn - 9) * 256; ld = 512; }
        else { bdst = (bf16_t*)(ws + WS_GR) + (pn - 11) * 256; ld = 512; }
#pragma unroll
        for (int ai = 0; ai < 2; ++ai)
#pragma unroll
            for (int m = 0; m < 4; ++m) { const int row = row0 + ai * 128 + m * 16;
#pragma unroll
                for (int bj = 0; bj < 2; ++bj)
#pragma unroll
                    for (int n = 0; n < 2; ++n) { const int c = cb + bj * 128 + n * 16; const f32x4 v = acc[ai][bj][m][n];
                        u32x2 w; w.x = cvt_pk_bf16(v[0] * sc, v[1] * sc); w.y = cvt_pk_bf16(v[2] * sc, v[3] * sc);
                        *(u32x2*)(bdst + (size_t)row * ld + c) = w;
                        if (fdst != nullptr && row >= rmin) *(f32x4*)(fdst + (size_t)row * 256 + c) = v; } }
    }
};
__device__ __forceinline__ void phase2(const Params& p, unsigned char* lds) {
    const int G = gridDim.x, bid = blockIdx.x;
    const bf16_t* HN = (const bf16_t*)(p.ws + WS_HN); const bf16_t* WinT = (const bf16_t*)(p.ws + WS_WIN_T);
    {
        pg8::Gemm g{HN, WinT, SEQ, NZ, 1024}; pg8::StaticOrder S; S.init(SEQ, NZ, G, bid);
        EpiWin E{p.ws, p.out};
        pg8::gemm_phase<EpiWin, pg8::StaticOrder, true, true>((LAS unsigned char*)lds, g, S, E);
    }
    __syncthreads();
    float* zs = (float*)(p.ws + WS_ZS); float* out = p.out;
    for (int u = G - 1 - bid; u < NZ / 32; u += G) {
        skinny32_unit(lds, HN + (size_t)SEQ * 1024, WinT, 1024, u * 32, [&](int m, int n, float v) {
            zs[(size_t)m * NZ + n] = v;
            if (n >= ZC_KVC && n < ZC_KVS) out[O_CMP_S + (size_t)m * 256 + (n - ZC_KVC)] = v;
            else if (n >= ZC_KVS && n < ZC_KVW) out[O_SLC_S + (size_t)m * 256 + (n - ZC_KVS)] = v;
            else if (n >= ZC_KVW && n < ZC_QR) out[O_WIN_S + ((size_t)m * 512 + 511) * 256 + (n - ZC_KVW)] = v;
        });
    }
}


__device__ __forceinline__ float log2_gamma(int h) { return log1pf(-exp2f(-5.0f - (float)h)) * 1.4426950408889634f; }

__device__ __forceinline__ void ret_uc_unit(const Params& p, unsigned char* lds, int c, int h) {
    int tid_op = threadIdx.x; asm volatile("" : "+v"(tid_op));
    const int tid = tid_op, wid = tid >> 6, lane = tid & 63;
    bf16_t* KT = (bf16_t*)lds;
    bf16_t* VT = KT + 64 * 136;
    const bf16_t* KR = (const bf16_t*)(p.ws + WS_KR); const bf16_t* VR = (const bf16_t*)(p.ws + WS_VR);
    const float* rc = (const float*)(p.ws + WS_ROPE); const float* rs = rc + (size_t)16385 * 32;
    const float l2g = log2_gamma(h);
    {
        const int m = tid & 127, jq = tid >> 7; const int tok = c * 128 + m;
        const bf16x8 x1 = *(const bf16x8*)(KR + (size_t)tok * 512 + h * 64 + jq * 8), x2 = *(const bf16x8*)(KR + (size_t)tok * 512 + h * 64 + 32 + jq * 8);
        const float sc = 0.125f * exp2f(-(float)m * l2g);
#pragma unroll
        for (int e = 0; e < 8; ++e) { const int j = jq * 8 + e; const float cs = rc[(size_t)tok * 32 + j], sn = rs[(size_t)tok * 32 + j];
            const float a = bf2f((bf16_t)x1[e]), b = bf2f((bf16_t)x2[e]);
            KT[j * 136 + m] = f2bf((a * cs - b * sn) * sc); KT[(j + 32) * 136 + m] = f2bf((a * sn + b * cs) * sc); }
        const bf16x8 v0 = *(const bf16x8*)(VR + (size_t)tok * 512 + h * 64 + jq * 16), v1 = *(const bf16x8*)(VR + (size_t)tok * 512 + h * 64 + jq * 16 + 8);
#pragma unroll
        for (int e = 0; e < 8; ++e) { VT[(jq * 16 + e) * 136 + m] = (bf16_t)v0[e]; VT[(jq * 16 + 8 + e) * 136 + m] = (bf16_t)v1[e]; }
    }
    __syncthreads();
    if (wid < 4) {
        const int r = lane & 31, hh = lane >> 5, dk0 = (wid >> 1) * 32, dv0 = (wid & 1) * 32;
        f32x16 acc;
#pragma unroll
        for (int i = 0; i < 16; ++i) acc[i] = 0.f;
#pragma unroll
        for (int ks = 0; ks < 8; ++ks) { const bf16x8 a = *(const bf16x8*)(KT + (dk0 + r) * 136 + ks * 16 + 8 * hh), b = *(const bf16x8*)(VT + (dv0 + r) * 136 + ks * 16 + 8 * hh);
            acc = __builtin_amdgcn_mfma_f32_32x32x16_bf16(a, b, acc, 0, 0, 0); }
        const float g127 = exp2f(127.0f * l2g);
        float* uc = (float*)(p.ws + WS_UC) + ((size_t)c * 8 + h) * 4096;
#pragma unroll
        for (int i = 0; i < 16; ++i) { const int dk = dk0 + (i & 3) + 8 * (i >> 2) + 4 * hh; uc[dk * 64 + dv0 + r] = acc[i] * g127; }
    }
    __syncthreads();
}

__device__ __forceinline__ void ret_scan(const Params& p, int item  ) {
    const int h = item >> 10; const float dc = exp2f(128.0f * log2_gamma(h));
    const f32x4* uc = (const f32x4*)(p.ws + WS_UC) + item; f32x4* sc = (f32x4*)(p.ws + WS_SC) + item;
    f32x4 s = (f32x4){0.f, 0.f, 0.f, 0.f};
    for (int c0 = 0; c0 < 128; c0 += 8) { f32x4 u[8];
#pragma unroll
        for (int i = 0; i < 8; ++i) u[i] = uc[(size_t)(c0 + i) * 8192];
#pragma unroll
        for (int i = 0; i < 8; ++i) { sc[(size_t)(c0 + i) * 8192] = s; s = s * dc + u[i]; } }
    ((f32x4*)(p.out + O_RET_P))[item] = s;
}

__device__ __forceinline__ void ret_sample_wave(const Params& p, int b, int h, int lane) {
    const float* zs = (const float*)(p.ws + WS_ZS) + (size_t)b * NZ;
    const float* rc = (const float*)(p.ws + WS_ROPE) + (size_t)16384 * 32; const float* rs = rc + (size_t)16385 * 32;
    const float gam = exp2f(log2_gamma(h));
    const int j = lane & 31; const float cs = rc[j], sn = rs[j];
    const float q1 = zs[ZC_QR + h * 64 + j], q2 = zs[ZC_QR + h * 64 + 32 + j], k1 = zs[ZC_KR + h * 64 + j], k2 = zs[ZC_KR + h * 64 + 32 + j];
    const float qd = (lane < 32) ? (q1 * cs - q2 * sn) : (q1 * sn + q2 * cs);
    const float kd = ((lane < 32) ? (k1 * cs - k2 * sn) : (k1 * sn + k2 * cs)) * 0.125f;
    const float v = zs[ZC_VR + h * 64 + lane];
    const float* s0 = p.st_ret + ((size_t)b * 8 + h) * 4096; float* so = p.out + O_RET_S + ((size_t)b * 8 + h) * 4096;
    float o = 0.f;
    for (int dk = 0; dk < 64; ++dk) { const float kk = __shfl(kd, dk), qq = __shfl(qd, dk); const float s = gam * s0[dk * 64 + lane] + kk * v; so[dk * 64 + lane] = s; o += qq * s; }
    const float mu = wave_sum(o) * (1.0f / 64.0f); const float d = o - mu; const float var = wave_sum(d * d) * (1.0f / 64.0f);
    const float g = zs[ZC_GR + h * 64 + lane]; const float y = d * rsqrtf(var + 1e-5f) * p.gn_g[h * 64 + lane] * (g / (1.0f + __expf(-g)));
    ((bf16_t*)(p.ws + WS_MIX))[(size_t)(SEQ + b) * 1024 + 512 + h * 64 + lane] = f2bf(y);
}

__device__ __forceinline__ void ret_out_unit(const Params& p, unsigned char* lds, int c, int hp) {
    int tid_op = threadIdx.x; asm volatile("" : "+v"(tid_op));
    const int tid = tid_op, wid = tid >> 6, lane = tid & 63;
    constexpr int HB = 63488;
    const bf16_t* QR = (const bf16_t*)(p.ws + WS_QR); const bf16_t* KR = (const bf16_t*)(p.ws + WS_KR); const bf16_t* VR = (const bf16_t*)(p.ws + WS_VR);
    const float* rc = (const float*)(p.ws + WS_ROPE); const float* rs = rc + (size_t)16385 * 32;
    for (int hl = 0; hl < 2; ++hl) {
        const int h = hp * 2 + hl; const float l2g = log2_gamma(h);
        bf16_t* Qs = (bf16_t*)(lds + hl * HB); bf16_t* Ks = Qs + 128 * 72; bf16_t* VT = Ks + 128 * 72; bf16_t* ST = VT + 64 * 136;
        const int m = tid & 127, jq = tid >> 7; const int tok = c * 128 + m;
        const float qs = exp2f((float)m * l2g), ks_ = 0.125f * exp2f(-(float)m * l2g);
        float cs[8], sn[8];
#pragma unroll
        for (int e = 0; e < 8; ++e) { cs[e] = rc[(size_t)tok * 32 + jq * 8 + e]; sn[e] = rs[(size_t)tok * 32 + jq * 8 + e]; }
        {
            const bf16x8 x1 = *(const bf16x8*)(QR + (size_t)tok * 512 + h * 64 + jq * 8), x2 = *(const bf16x8*)(QR + (size_t)tok * 512 + h * 64 + 32 + jq * 8);
            u32x4 w1, w2; float o1[8], o2[8];
#pragma unroll
            for (int e = 0; e < 8; ++e) { const float a = bf2f((bf16_t)x1[e]), b = bf2f((bf16_t)x2[e]); o1[e] = (a * cs[e] - b * sn[e]) * qs; o2[e] = (a * sn[e] + b * cs[e]) * qs; }
            w1.x = cvt_pk_bf16(o1[0], o1[1]); w1.y = cvt_pk_bf16(o1[2], o1[3]); w1.z = cvt_pk_bf16(o1[4], o1[5]); w1.w = cvt_pk_bf16(o1[6], o1[7]);
            w2.x = cvt_pk_bf16(o2[0], o2[1]); w2.y = cvt_pk_bf16(o2[2], o2[3]); w2.z = cvt_pk_bf16(o2[4], o2[5]); w2.w = cvt_pk_bf16(o2[6], o2[7]);
            *(u32x4*)(Qs + m * 72 + jq * 8) = w1; *(u32x4*)(Qs + m * 72 + 32 + jq * 8) = w2;
        }
        {
            const bf16x8 x1 = *(const bf16x8*)(KR + (size_t)tok * 512 + h * 64 + jq * 8), x2 = *(const bf16x8*)(KR + (size_t)tok * 512 + h * 64 + 32 + jq * 8);
            u32x4 w1, w2; float o1[8], o2[8];
#pragma unroll
            for (int e = 0; e < 8; ++e) { const float a = bf2f((bf16_t)x1[e]), b = bf2f((bf16_t)x2[e]); o1[e] = (a * cs[e] - b * sn[e]) * ks_; o2[e] = (a * sn[e] + b * cs[e]) * ks_; }
            w1.x = cvt_pk_bf16(o1[0], o1[1]); w1.y = cvt_pk_bf16(o1[2], o1[3]); w1.z = cvt_pk_bf16(o1[4], o1[5]); w1.w = cvt_pk_bf16(o1[6], o1[7]);
            w2.x = cvt_pk_bf16(o2[0], o2[1]); w2.y = cvt_pk_bf16(o2[2], o2[3]); w2.z = cvt_pk_bf16(o2[4], o2[5]); w2.w = cvt_pk_bf16(o2[6], o2[7]);
            *(u32x4*)(Ks + m * 72 + jq * 8) = w1; *(u32x4*)(Ks + m * 72 + 32 + jq * 8) = w2;
        }
        {
            const bf16x8 v0 = *(const bf16x8*)(VR + (size_t)tok * 512 + h * 64 + jq * 16), v1 = *(const bf16x8*)(VR + (size_t)tok * 512 + h * 64 + jq * 16 + 8);
#pragma unroll
            for (int e = 0; e < 8; ++e) { VT[(jq * 16 + e) * 136 + m] = (bf16_t)v0[e]; VT[(jq * 16 + 8 + e) * 136 + m] = (bf16_t)v1[e]; }
        }
        {
            const float gam = exp2f(l2g); const float* sc = (const float*)(p.ws + WS_SC) + ((size_t)c * 8 + h) * 4096;
            const int dk = tid >> 3, dvq = tid & 7; const f32x4 a = *(const f32x4*)(sc + dk * 64 + dvq * 8), b = *(const f32x4*)(sc + dk * 64 + dvq * 8 + 4);
#pragma unroll
            for (int e = 0; e < 4; ++e) { ST[(dvq * 8 + e) * 72 + dk] = f2bf(a[e] * gam); ST[(dvq * 8 + 4 + e) * 72 + dk] = f2bf(b[e] * gam); }
        }
    }
    __syncthreads();
    {
        const int hl = wid >> 2, nt = wid & 3, h = hp * 2 + hl, r = lane & 31, hh = lane >> 5;
        const bf16_t* Qs = (const bf16_t*)(lds + hl * HB); const bf16_t* Ks = Qs + 128 * 72; const bf16_t* VT = Ks + 128 * 72; const bf16_t* ST = VT + 64 * 136;
        bf16x8 qf[4];
#pragma unroll
        for (int ks = 0; ks < 4; ++ks) qf[ks] = *(const bf16x8*)(Qs + (nt * 32 + r) * 72 + ks * 16 + 8 * hh);
        f32x16 o0, o1;
#pragma unroll
        for (int i = 0; i < 16; ++i) { o0[i] = 0.f; o1[i] = 0.f; }
#pragma unroll
        for (int ks = 0; ks < 4; ++ks) { const bf16x8 a0 = *(const bf16x8*)(ST + r * 72 + ks * 16 + 8 * hh), a1 = *(const bf16x8*)(ST + (32 + r) * 72 + ks * 16 + 8 * hh);
            o0 = __builtin_amdgcn_mfma_f32_32x32x16_bf16(a0, qf[ks], o0, 0, 0, 0); o1 = __builtin_amdgcn_mfma_f32_32x32x16_bf16(a1, qf[ks], o1, 0, 0, 0); }
        for (int mt = 0; mt <= nt; ++mt) {
            f32x16 at;
#pragma unroll
            for (int i = 0; i < 16; ++i) at[i] = 0.f;
#pragma unroll
            for (int ks = 0; ks < 4; ++ks) { const bf16x8 a = *(const bf16x8*)(Ks + (mt * 32 + r) * 72 + ks * 16 + 8 * hh); at = __builtin_amdgcn_mfma_f32_32x32x16_bf16(a, qf[ks], at, 0, 0, 0); }
            if (mt == nt) {
#pragma unroll
                for (int i = 0; i < 16; ++i) { const int mrow = (i & 3) + 8 * (i >> 2) + 4 * hh; if (mrow > r) at[i] = 0.f; }
            }
#pragma unroll
            for (int s = 0; s < 2; ++s) {
                bf16x8 pb; u32x4 pw;
                pw.x = cvt_pk_bf16(at[8 * s + 0], at[8 * s + 1]); pw.y = cvt_pk_bf16(at[8 * s + 2], at[8 * s + 3]); pw.z = cvt_pk_bf16(at[8 * s + 4], at[8 * s + 5]); pw.w = cvt_pk_bf16(at[8 * s + 6], at[8 * s + 7]);
                pb = __builtin_bit_cast(bf16x8, pw);
                const int mb = mt * 32 + 16 * s + 4 * hh;
                u32x2 l0 = *(const u32x2*)(VT + r * 136 + mb), l1 = *(const u32x2*)(VT + r * 136 + mb + 8), h0 = *(const u32x2*)(VT + (32 + r) * 136 + mb), h1 = *(const u32x2*)(VT + (32 + r) * 136 + mb + 8);
                const bf16x8 a0 = __builtin_bit_cast(bf16x8, (u32x4){l0.x, l0.y, l1.x, l1.y}), a1 = __builtin_bit_cast(bf16x8, (u32x4){h0.x, h0.y, h1.x, h1.y});
                o0 = __builtin_amdgcn_mfma_f32_32x32x16_bf16(a0, pb, o0, 0, 0, 0); o1 = __builtin_amdgcn_mfma_f32_32x32x16_bf16(a1, pb, o1, 0, 0, 0);
            }
        }
        float s = 0.f;
#pragma unroll
        for (int i = 0; i < 16; ++i) s += o0[i] + o1[i];
        s += __shfl_xor(s, 32); const float mu = s * (1.0f / 64.0f);
        float q = 0.f;
#pragma unroll
        for (int i = 0; i < 16; ++i) { const float d0 = o0[i] - mu, d1 = o1[i] - mu; q += d0 * d0 + d1 * d1; }
        q += __shfl_xor(q, 32); const float rstd = rsqrtf(q * (1.0f / 64.0f) + 1e-5f);
        const int tok = c * 128 + nt * 32 + r;
        const bf16_t* GR = (const bf16_t*)(p.ws + WS_GR) + (size_t)tok * 512 + h * 64; bf16_t* mix = (bf16_t*)(p.ws + WS_MIX) + (size_t)tok * 1024 + 512 + h * 64;
#pragma unroll
        for (int t2 = 0; t2 < 2; ++t2)
#pragma unroll
            for (int gq = 0; gq < 4; ++gq) { const int dv = t2 * 32 + 8 * gq + 4 * hh; const u32x2 gw = *(const u32x2*)(GR + dv); const f32x4 gn = *(const f32x4*)(p.gn_g + h * 64 + dv);
                float y[4];
#pragma unroll
                for (int e = 0; e < 4; ++e) { const float ov = t2 ? o1[gq * 4 + e] : o0[gq * 4 + e]; const unsigned gb = (e < 2) ? gw.x : gw.y; const float g = __uint_as_float((e & 1) ? (gb & 0xffff0000u) : (gb << 16));
                    y[e] = (ov - mu) * rstd * gn[e] * (g / (1.0f + __expf(-g))); }
                u32x2 w; w.x = cvt_pk_bf16(y[0], y[1]); w.y = cvt_pk_bf16(y[2], y[3]); *(u32x2*)(mix + dv) = w; }
    }
    __syncthreads();
}


__device__ __forceinline__ float gelu_tanh(float x) { const float u = 0.7978845608028654f * (x + 0.044715f * x * x * x); const float e = __expf(2.0f * u); const float th = 1.0f - 2.0f / (e + 1.0f); return 0.5f * x * (1.0f + th); }

__device__ __forceinline__ void cmp_prompt_unit(const Params& p, unsigned char* lds, int kv, int n0) {
    int tid_op = threadIdx.x; asm volatile("" : "+v"(tid_op));
    const int tid = tid_op, wid = tid >> 6, lane = tid & 63, r = lane & 31, hh = lane >> 5;
    const bf16_t* KVC = (const bf16_t*)(p.ws + WS_KVC); const bf16_t* W1T = (const bf16_t*)(p.ws + WS_W1T) + (size_t)kv * 128 * 2048; const bf16_t* W2T = (const bf16_t*)(p.ws + WS_W2T) + (size_t)kv * 64 * 128;
    float* red = (float*)lds;
    bf16_t* hid = (bf16_t*)(lds + 32768);
    const int ht = wid & 3, kh = wid >> 2;
    const int n = n0 + (r >> 1), g = r & 1;
    const int nn = n < 1023 ? n : 1022;
    f32x16 acc;
#pragma unroll
    for (int i = 0; i < 16; ++i) acc[i] = 0.f;
    const bf16_t* ap = KVC + (size_t)(16 * nn + 16 * kh) * 256 + kv * 128 + g * 64 + 8 * hh;
    const bf16_t* bp = W1T + (size_t)(ht * 32 + r) * 2048 + (16 * kh) * 64 + 8 * hh;
    for (int l0 = 0; l0 < 16; l0 += 4) {
        bf16x8 af[4][4], bfr[4][4];
#pragma unroll
        for (int li = 0; li < 4; ++li)
#pragma unroll
            for (int ks = 0; ks < 4; ++ks) { af[li][ks] = *(const bf16x8*)(ap + (size_t)(l0 + li) * 256 + ks * 16); bfr[li][ks] = *(const bf16x8*)(bp + (l0 + li) * 64 + ks * 16); }
        __builtin_amdgcn_sched_barrier(0);
#pragma unroll
        for (int li = 0; li < 4; ++li)
#pragma unroll
            for (int ks = 0; ks < 4; ++ks) acc = __builtin_amdgcn_mfma_f32_32x32x16_bf16(af[li][ks], bfr[li][ks], acc, 0, 0, 0);
    }
#pragma unroll
    for (int i = 0; i < 16; ++i) { const int m = (i & 3) + 8 * (i >> 2) + 4 * hh; red[wid * 1024 + m * 32 + r] = acc[i]; }
    __syncthreads();
    const float* pet = (const float*)(p.ws + WS_PET) + kv * 1024;
    float ptsum = 0.f;
#pragma unroll
    for (int s8 = 0; s8 < 8; ++s8) ptsum += pet[s8 * 128 + (tid & 127)];
    for (int e = tid; e < 4096; e += 512) { const int m = e >> 7, hc = e & 127; const int t4 = hc >> 5, c = hc & 31;
        const float v = red[t4 * 1024 + m * 32 + c] + red[(4 + t4) * 1024 + m * 32 + c] + ptsum; hid[m * 136 + hc] = f2bf(gelu_tanh(v)); }
    __syncthreads();
    if (wid < 2) {
        f32x16 o;
#pragma unroll
        for (int i = 0; i < 16; ++i) o[i] = 0.f;
        bf16x8 w2f[8];
#pragma unroll
        for (int ks = 0; ks < 8; ++ks) w2f[ks] = *(const bf16x8*)(W2T + (size_t)(wid * 32 + r) * 128 + ks * 16 + 8 * hh);
#pragma unroll
        for (int ks = 0; ks < 8; ++ks) { const bf16x8 a = *(const bf16x8*)(hid + r * 136 + ks * 16 + 8 * hh); o = __builtin_amdgcn_mfma_f32_32x32x16_bf16(a, w2f[ks], o, 0, 0, 0); }
        bf16_t* dst = (bf16_t*)(p.ws + WS_KCMP) + (size_t)kv * 1024 * 128;
#pragma unroll
        for (int i = 0; i < 16; ++i) { const int m = (i & 3) + 8 * (i >> 2) + 4 * hh; const int nb = n0 + (m >> 1), gg = m & 1;
            dst[((size_t)nb * 2 + gg) * 64 + wid * 32 + r] = (nb < 1023) ? f2bf(o[i]) : (bf16_t)0; }
    }
    __syncthreads();
    if (kv == 0 && tid < 32) {
        const int nb = n0 + (tid >> 1), gg = tid & 1; const bf16_t* row = (const bf16_t*)(p.ws + WS_KCMP) + ((size_t)nb * 2 + gg) * 64; float ss = 0.f;
#pragma unroll
        for (int d8 = 0; d8 < 8; ++d8) { const bf16x8 v = *(const volatile bf16x8*)(row + d8 * 8);
#pragma unroll
            for (int e = 0; e < 8; ++e) { const float f = bf2f((bf16_t)v[e]); ss += f * f; } }
        atomicMax((unsigned*)(p.ws + WS_KCM) + gg, __float_as_uint(sqrtf(ss))); }
    __syncthreads();
}

__device__ __forceinline__ void vst_unit(const Params& p, unsigned char* lds, int s0) {
    int tid_op = threadIdx.x; asm volatile("" : "+v"(tid_op));
    const int tid = tid_op; bf16_t* t = (bf16_t*)lds;
    const bf16_t* KVS = (const bf16_t*)(p.ws + WS_KVS); bf16_t* VST = (bf16_t*)(p.ws + WS_VST);
    for (int i = tid; i < 64 * 16; i += 512) { const int s = i >> 4, c8 = i & 15; const bf16x8 v = *(const bf16x8*)(KVS + (size_t)(s0 + s) * 256 + 128 + c8 * 8);
#pragma unroll
        for (int e = 0; e < 8; ++e) t[(c8 * 8 + e) * 72 + s] = (bf16_t)v[e]; }
    __syncthreads();
    for (int i = tid; i < 128 * 8; i += 512) { const int c = i >> 3, s8 = i & 7; *(u32x4*)(VST + (size_t)c * SEQ + s0 + s8 * 8) = *(const u32x4*)(t + c * 72 + s8 * 8); }
    float* nrm = (float*)(lds + 32768);
    if (tid < 128) { const int key = tid & 63, gg = tid >> 6; float ss = 0.f;
#pragma unroll
        for (int d8 = 0; d8 < 8; ++d8) { const bf16x8 v = *(const bf16x8*)(KVS + (size_t)(s0 + key) * 256 + gg * 64 + d8 * 8);
#pragma unroll
            for (int e = 0; e < 8; ++e) { const float f = bf2f((bf16_t)v[e]); ss += f * f; } }
        nrm[tid] = sqrtf(ss); }
    __syncthreads();
    if (tid < 2) { float m = 0.f; for (int k = 0; k < 64; ++k) m = fmaxf(m, nrm[tid * 64 + k]); ((float*)(p.ws + WS_KBM))[tid * 256 + (s0 >> 6)] = m; }
    __syncthreads();
}

__device__ __forceinline__ void win_unit(const Params& p, unsigned char* lds, int g, int qt) {
    int tid_op = threadIdx.x; asm volatile("" : "+v"(tid_op));
    const int tid = tid_op, wid = tid >> 6, lane = tid & 63, r = lane & 31, hh = lane >> 5;
    bf16_t* Ks = (bf16_t*)lds;
    bf16_t* VT = Ks + 128 * 72;
    float* lut = (float*)(lds + 36864);
    const bf16_t* QA = (const bf16_t*)(p.ws + WS_QA); const bf16_t* KVW = (const bf16_t*)(p.ws + WS_KVW);
    const float* bl = (const float*)(p.ws + WS_BIAS);
    const int t0 = qt * 128, hr = wid & 3, head = g * 4 + hr, q0 = t0 + (wid >> 2) * 64;
    for (int i = tid; i < 4 * 768; i += 512) { const int hd = i / 768, d = (i % 768) - 127; lut[i] = (d < 0 || d > 512) ? -1e30f : bl[(g * 4 + hd) * 1032 + d]; }
    bf16x8 qf[2][4];
#pragma unroll
    for (int cb = 0; cb < 2; ++cb)
#pragma unroll
        for (int ks = 0; ks < 4; ++ks) qf[cb][ks] = *(const bf16x8*)(QA + (size_t)(q0 + cb * 32 + r) * 512 + head * 64 + ks * 16 + 8 * hh);
    f32x16 o[2][2]; float mrun[2], lrun[2];
#pragma unroll
    for (int cb = 0; cb < 2; ++cb) { mrun[cb] = -1e30f; lrun[cb] = 0.f;
#pragma unroll
        for (int dt = 0; dt < 2; ++dt)
#pragma unroll
            for (int i = 0; i < 16; ++i) o[cb][dt][i] = 0.f; }
    const float* mylut = lut + hr * 768 + 127;
    const int kstart = (t0 >= 512) ? t0 - 512 : 0;
    for (int kt = kstart; kt < t0 + 128; kt += 128) {
        __syncthreads();
        { const int key = tid >> 2, seg = tid & 3; const bf16_t* src = KVW + (size_t)(kt + key) * 256 + g * 64 + seg * 16;
          *(u32x4*)(Ks + key * 72 + seg * 16) = *(const u32x4*)src; *(u32x4*)(Ks + key * 72 + seg * 16 + 8) = *(const u32x4*)(src + 8); }
        { const int key = tid & 127, dq = tid >> 7; const bf16_t* src = KVW + (size_t)(kt + key) * 256 + 128 + g * 64 + dq * 16; const bf16x8 v0 = *(const bf16x8*)src, v1 = *(const bf16x8*)(src + 8);
#pragma unroll
          for (int e = 0; e < 8; ++e) { VT[(dq * 16 + e) * 136 + key] = (bf16_t)v0[e]; VT[(dq * 16 + 8 + e) * 136 + key] = (bf16_t)v1[e]; } }
        __syncthreads();
        for (int sub = 0; sub < 4; ++sub) {
            const int k0 = kt + sub * 32;
            if (k0 > q0 + 63 || k0 + 31 < q0 - 512) continue;
            bf16x8 kf[4];
#pragma unroll
            for (int ks = 0; ks < 4; ++ks) kf[ks] = *(const bf16x8*)(Ks + (sub * 32 + r) * 72 + ks * 16 + 8 * hh);
#pragma unroll
            for (int cb = 0; cb < 2; ++cb) {
                f32x16 sc;
#pragma unroll
                for (int i = 0; i < 16; ++i) sc[i] = 0.f;
#pragma unroll
                for (int ks = 0; ks < 4; ++ks) sc = __builtin_amdgcn_mfma_f32_32x32x16_bf16(kf[ks], qf[cb][ks], sc, 0, 0, 0);
                const int tq = q0 + cb * 32 + r; float mx = -1e30f;
#pragma unroll
                for (int i = 0; i < 16; ++i) { const int s = k0 + (i & 3) + 8 * (i >> 2) + 4 * hh; sc[i] += mylut[tq - s]; mx = fmaxf(mx, sc[i]); }
                mx = fmaxf(mx, __shfl_xor(mx, 32));
                const float mnew = fmaxf(mrun[cb], mx), alpha = __expf(mrun[cb] - mnew); mrun[cb] = mnew;
                float ps = 0.f;
#pragma unroll
                for (int i = 0; i < 16; ++i) { sc[i] = __expf(sc[i] - mnew); ps += sc[i]; }
                ps += __shfl_xor(ps, 32); lrun[cb] = lrun[cb] * alpha + ps;
#pragma unroll
                for (int dt = 0; dt < 2; ++dt)
#pragma unroll
                    for (int i = 0; i < 16; ++i) o[cb][dt][i] *= alpha;
#pragma unroll
                for (int s2 = 0; s2 < 2; ++s2) {
                    u32x4 pw; pw.x = cvt_pk_bf16(sc[8 * s2 + 0], sc[8 * s2 + 1]); pw.y = cvt_pk_bf16(sc[8 * s2 + 2], sc[8 * s2 + 3]); pw.z = cvt_pk_bf16(sc[8 * s2 + 4], sc[8 * s2 + 5]); pw.w = cvt_pk_bf16(sc[8 * s2 + 6], sc[8 * s2 + 7]);
                    const bf16x8 pb = __builtin_bit_cast(bf16x8, pw); const int mb = sub * 32 + 16 * s2 + 4 * hh;
#pragma unroll
                    for (int dt = 0; dt < 2; ++dt) { const u32x2 l0 = *(const u32x2*)(VT + (dt * 32 + r) * 136 + mb), l1 = *(const u32x2*)(VT + (dt * 32 + r) * 136 + mb + 8);
                        const bf16x8 a = __builtin_bit_cast(bf16x8, (u32x4){l0.x, l0.y, l1.x, l1.y});
                        o[cb][dt] = __builtin_amdgcn_mfma_f32_32x32x16_bf16(a, pb, o[cb][dt], 0, 0, 0); }
                }
            }
        }
    }
    float* OW = (float*)(p.ws + WS_OW); const float* gts = (const float*)(p.ws + WS_GATES);
#pragma unroll
    for (int cb = 0; cb < 2; ++cb) { const int tq = q0 + cb * 32 + r; const float sc = gts[(size_t)tq * 24 + 16 + head] / lrun[cb];
#pragma unroll
        for (int dt = 0; dt < 2; ++dt)
#pragma unroll
            for (int gq = 0; gq < 4; ++gq) { const int d = dt * 32 + 8 * gq + 4 * hh;
                *(f32x4*)(OW + (size_t)tq * 512 + head * 64 + d) = (f32x4){o[cb][dt][gq * 4 + 0] * sc, o[cb][dt][gq * 4 + 1] * sc, o[cb][dt][gq * 4 + 2] * sc, o[cb][dt][gq * 4 + 3] * sc}; } }
    __syncthreads();
}


__device__ __forceinline__ unsigned wave_max_u32(unsigned x) {
    unsigned y;
    y = (unsigned)__builtin_amdgcn_update_dpp((int)x, (int)x, 0x111, 0xf, 0xf, false); x = x > y ? x : y;
    y = (unsigned)__builtin_amdgcn_update_dpp((int)x, (int)x, 0x112, 0xf, 0xf, false); x = x > y ? x : y;
    y = (unsigned)__builtin_amdgcn_update_dpp((int)x, (int)x, 0x114, 0xf, 0xf, false); x = x > y ? x : y;
    y = (unsigned)__builtin_amdgcn_update_dpp((int)x, (int)x, 0x118, 0xf, 0xf, false); x = x > y ? x : y;
    const unsigned a = (unsigned)__builtin_amdgcn_readlane((int)x, 15), b = (unsigned)__builtin_amdgcn_readlane((int)x, 31), c = (unsigned)__builtin_amdgcn_readlane((int)x, 47), d = (unsigned)__builtin_amdgcn_readlane((int)x, 63);
    const unsigned ab = a > b ? a : b, cd = c > d ? c : d; return ab > cd ? ab : cd;
}
__device__ __forceinline__ void nsa_unit(const Params& p, unsigned char* lds, int g, int tt) {
    int tid_op = threadIdx.x; asm volatile("" : "+v"(tid_op));
    const int tid = tid_op, wid = tid >> 6, lane = tid & 63, r = lane & 31, hh = lane >> 5;
    float* imp = (float*)lds;
    bf16_t* Ks = (bf16_t*)(lds + 65536);
    bf16_t* VT = (bf16_t*)(lds + 65536 + 18432);
    float* lut = (float*)(lds + 131072);
    int* idxs = (int*)(lds + 147584) + wid * 128;
    unsigned long long* masks = (unsigned long long*)(lds + 151680);
    unsigned short* act = (unsigned short*)(lds + 153728);
    int* nact_p = (int*)(lds + 154240);
    const bf16_t* QA = (const bf16_t*)(p.ws + WS_QA); const bf16_t* KCMP = (const bf16_t*)(p.ws + WS_KCMP);
    const bf16_t* KVS = (const bf16_t*)(p.ws + WS_KVS); const bf16_t* VST = (const bf16_t*)(p.ws + WS_VST) + (size_t)g * 64 * SEQ;
    const float* bl = (const float*)(p.ws + WS_BIAS); const float* gts = (const float*)(p.ws + WS_GATES);
    const int t0 = tt * 64, tw0 = t0 + wid * 8;
    const int hr = r >> 3, ti = r & 7, tq = tw0 + ti, head = g * 4 + hr;
    for (int i = tid; i < 64 * 256; i += 512) imp[i] = 0.f;
    for (int i = tid; i < 4 * 1025; i += 512) { const int hd = i / 1025, n = i % 1025; lut[hd * 1032 + n] = bl[(g * 4 + hd) * 1032 + n]; }
    bf16x8 qf[4];
#pragma unroll
    for (int ks = 0; ks < 4; ++ks) qf[ks] = *(const bf16x8*)(QA + (size_t)tq * 512 + head * 64 + ks * 16 + 8 * hh);
    const int nkeys = (t0 + 63 >= 31) ? ((t0 + 63 - 31) >> 4) + 1 : 0;
    const float* mylut = lut + hr * 1032;
    float mshc;
    { float ss = 0.f;
#pragma unroll
      for (int ks = 0; ks < 4; ++ks)
#pragma unroll
          for (int e = 0; e < 8; ++e) { const float f = bf2f((bf16_t)qf[ks][e]); ss += f * f; }
      ss += __shfl_xor(ss, 32);
      const float kcm = __uint_as_float(((const unsigned*)(p.ws + WS_KCM))[g]);
      mshc = sqrtf(ss) * kcm * 1.0001f + 1e-3f; }
    __syncthreads();
    mshc += bl[(g * 4 + hr) * 1032 + 1025];
    const float bfar = mylut[1024] - mshc;
    float lrun = 0.f;
    for (int rep1 = 0; rep1 < (PROBE_DUP == 42 ? 2 : 1); ++rep1) { lrun = 0.f;
    for (int kt = 0; kt < nkeys; kt += 128) {
        __syncthreads();
        { const int key = tid >> 2, seg = tid & 3; const bf16_t* src = KCMP + ((size_t)(kt + key) * 2 + g) * 64 + seg * 16;
          *(u32x4*)(Ks + key * 72 + seg * 16) = *(const u32x4*)src; *(u32x4*)(Ks + key * 72 + seg * 16 + 8) = *(const u32x4*)(src + 8); }
        __syncthreads();
        for (int sub = 0; sub < 4; ++sub) {
            const int nb = kt + sub * 32; if (nb >= nkeys) break;
            f32x16 sc;
#pragma unroll
            for (int i = 0; i < 16; ++i) sc[i] = 0.f;
#pragma unroll
            for (int ks = 0; ks < 4; ++ks) { const bf16x8 kf = *(const bf16x8*)(Ks + (sub * 32 + r) * 72 + ks * 16 + 8 * hh); sc = __builtin_amdgcn_mfma_f32_32x32x16_bf16(kf, qf[ks], sc, 0, 0, 0); }
            float ps = 0.f;
            if (tw0 - (16 * (nb + 31) + 31) >= 1024) {
#pragma unroll
                for (int i = 0; i < 16; ++i) ps += __expf(fmaxf(sc[i] + bfar, -80.f));
            } else {
#pragma unroll
                for (int i = 0; i < 16; ++i) { const int n = nb + (i & 3) + 8 * (i >> 2) + 4 * hh; const int dc = tq - (16 * n + 31); const int di = dc < 0 ? 0 : (dc < 1024 ? dc : 1024);
                    const float pe = __expf(fmaxf(sc[i] + mylut[di] - mshc, -80.f)); ps += (dc >= 0) ? pe : 0.f; }
            }
            lrun += ps;
        }
    }
    }
    lrun += __shfl_xor(lrun, 32);
    const float inv_l = (tq >= 31) ? 1.0f / lrun : 0.f;
    f32x16 oc0, oc1;
#pragma unroll
    for (int i = 0; i < 16; ++i) { oc0[i] = 0.f; oc1[i] = 0.f; }
    float carry = 0.f;
    for (int kt = 0; kt < nkeys; kt += 128) {
        __syncthreads();
        { const int key = tid >> 2, seg = tid & 3; const bf16_t* src = KCMP + ((size_t)(kt + key) * 2 + g) * 64 + seg * 16;
          *(u32x4*)(Ks + key * 72 + seg * 16) = *(const u32x4*)src; *(u32x4*)(Ks + key * 72 + seg * 16 + 8) = *(const u32x4*)(src + 8); }
        { const int key = tid & 127, dq = tid >> 7; const bf16_t* src = KCMP + (size_t)1024 * 128 + ((size_t)(kt + key) * 2 + g) * 64 + dq * 16; const bf16x8 v0 = *(const bf16x8*)src, v1 = *(const bf16x8*)(src + 8);
#pragma unroll
          for (int e = 0; e < 8; ++e) { VT[(dq * 16 + e) * 136 + key] = (bf16_t)v0[e]; VT[(dq * 16 + 8 + e) * 136 + key] = (bf16_t)v1[e]; } }
        __syncthreads();
        for (int sub = 0; sub < 4; ++sub) {
            const int nb = kt + sub * 32; if (nb >= nkeys) break;
            f32x16 sc;
#pragma unroll
            for (int i = 0; i < 16; ++i) sc[i] = 0.f;
#pragma unroll
            for (int ks = 0; ks < 4; ++ks) { const bf16x8 kf = *(const bf16x8*)(Ks + (sub * 32 + r) * 72 + ks * 16 + 8 * hh); sc = __builtin_amdgcn_mfma_f32_32x32x16_bf16(kf, qf[ks], sc, 0, 0, 0); }
            if (tw0 - (16 * (nb + 31) + 31) >= 1024) {
#pragma unroll
                for (int i = 0; i < 16; ++i) sc[i] = __expf(fmaxf(sc[i] + bfar, -80.f)) * inv_l;
            } else {
#pragma unroll
                for (int i = 0; i < 16; ++i) { const int n = nb + (i & 3) + 8 * (i >> 2) + 4 * hh; const int dc = tq - (16 * n + 31); const int di = dc < 0 ? 0 : (dc < 1024 ? dc : 1024);
                    const float pe = __expf(fmaxf(sc[i] + mylut[di] - mshc, -80.f)) * inv_l; sc[i] = (dc >= 0) ? pe : 0.f; }
            }
#pragma unroll
            for (int s2 = 0; s2 < 2; ++s2) {
                u32x4 pw; pw.x = cvt_pk_bf16(sc[8 * s2 + 0], sc[8 * s2 + 1]); pw.y = cvt_pk_bf16(sc[8 * s2 + 2], sc[8 * s2 + 3]); pw.z = cvt_pk_bf16(sc[8 * s2 + 4], sc[8 * s2 + 5]); pw.w = cvt_pk_bf16(sc[8 * s2 + 6], sc[8 * s2 + 7]);
                const bf16x8 pb = __builtin_bit_cast(bf16x8, pw); const int mb = sub * 32 + 16 * s2 + 4 * hh;
                { const u32x2 l0 = *(const u32x2*)(VT + r * 136 + mb), l1 = *(const u32x2*)(VT + r * 136 + mb + 8); const bf16x8 a = __builtin_bit_cast(bf16x8, (u32x4){l0.x, l0.y, l1.x, l1.y}); oc0 = __builtin_amdgcn_mfma_f32_32x32x16_bf16(a, pb, oc0, 0, 0, 0); }
                { const u32x2 l0 = *(const u32x2*)(VT + (32 + r) * 136 + mb), l1 = *(const u32x2*)(VT + (32 + r) * 136 + mb + 8); const bf16x8 a = __builtin_bit_cast(bf16x8, (u32x4){l0.x, l0.y, l1.x, l1.y}); oc1 = __builtin_amdgcn_mfma_f32_32x32x16_bf16(a, pb, oc1, 0, 0, 0); }
            }
            float gs[4], ls[4], px[4];
#pragma unroll
            for (int q = 0; q < 4; ++q) { gs[q] = (sc[4 * q] + sc[4 * q + 1]) + (sc[4 * q + 2] + sc[4 * q + 3]); ls[q] = sc[4 * q + 3];
                gs[q] += __shfl_xor(gs[q], 8); gs[q] += __shfl_xor(gs[q], 16); ls[q] += __shfl_xor(ls[q], 8); ls[q] += __shfl_xor(ls[q], 16); px[q] = __shfl_xor(ls[q], 32); }
            if (hr == 0) {
#pragma unroll
                for (int q = 0; q < 4; ++q) { const float prev = hh ? px[q] : (q > 0 ? px[q > 0 ? q - 1 : 0] : carry); const int j = (nb >> 2) + 2 * q + hh;
                    imp[(wid * 8 + ti) * 256 + j] = gs[q] + prev; }
            }
            carry = px[3];
        }
    }
    {
        const int nsub = (nkeys + 31) >> 5, jn = nsub * 8;
        if (hr == 0 && hh == 0 && jn < 256 && nkeys > 0) imp[(wid * 8 + ti) * 256 + jn] = carry;
    }
    {
        float* ocb = (float*)(p.ws + WS_OC) + (size_t)tq * 512 + head * 64; const float gc = gts[(size_t)tq * 24 + head];
#pragma unroll
        for (int i = 0; i < 16; ++i) { const int d = (i & 3) + 8 * (i >> 2) + 4 * hh; ocb[d] = gc * oc0[i]; ocb[32 + d] = gc * oc1[i]; }
    }
    __builtin_amdgcn_wave_barrier(); asm volatile("s_waitcnt lgkmcnt(0)" ::: "memory");
    for (int rep2 = 0; rep2 < (PROBE_DUP == 43 ? 2 : 1); ++rep2)
    for (int i = 0; i < 8; ++i) {
        const int tk = tw0 + i, cur = tk >> 6; unsigned key[4];
        int nf = 1; if (lane == 0) { idxs[i * 16 + 0] = 0; }
        if (cur >= 1) { if (lane == 0) idxs[i * 16 + nf] = cur; ++nf; }
        if (cur >= 2) { if (lane == 0) idxs[i * 16 + nf] = cur - 1; ++nf; }
#pragma unroll
        for (int k = 0; k < 4; ++k) { const int j = lane + 64 * k; const bool forced = (j == 0) || (j == cur) || (j == cur - 1);
            const float scv = imp[(wid * 8 + i) * 256 + j];
            key[k] = (j <= cur && !forced) ? __float_as_uint(scv) + 1u : 0u; }
        for (int sel = nf; sel < 16; ++sel) {
            unsigned best = key[0] > key[1] ? key[0] : key[1]; const unsigned b2 = key[2] > key[3] ? key[2] : key[3]; best = best > b2 ? best : b2;
            best = wave_max_u32(best);
            int jsel = -1;
            if (best != 0u) {
                const unsigned long long m0 = __ballot(key[0] == best), m1 = __ballot(key[1] == best), m2 = __ballot(key[2] == best), m3 = __ballot(key[3] == best);
                if (m0) jsel = __ffsll((long long)m0) - 1; else if (m1) jsel = 64 + __ffsll((long long)m1) - 1; else if (m2) jsel = 128 + __ffsll((long long)m2) - 1; else jsel = 192 + __ffsll((long long)m3) - 1;
                const int kl = jsel >> 6, ll = jsel & 63;
#pragma unroll
                for (int k = 0; k < 4; ++k) if (k == kl && lane == ll) key[k] = 0u;
            }
            if (lane == 0) idxs[i * 16 + sel] = jsel;
        }
    }
    __builtin_amdgcn_wave_barrier(); asm volatile("s_waitcnt lgkmcnt(0)" ::: "memory");
    float* Mst = (float*)(lds + 155392);
    const int c16 = lane & 15, quad = lane >> 4;
    f32x4 osA[4], osB[4]; float laccA = 0.f, laccB = 0.f;
    for (int rep3 = 0; rep3 < (PROBE_DUP == 44 ? 2 : 1); ++rep3) {
    {
        const float* kbm = (const float*)(p.ws + WS_KBM) + g * 256;
        for (int i = 0; i < 8; ++i) { const int tk = tw0 + i;
            const int jj = (lane < 16) ? idxs[i * 16 + lane] : -1; float km = (jj >= 0) ? kbm[jj] : 0.f;
#pragma unroll
            for (int o = 8; o >= 1; o >>= 1) km = fmaxf(km, __shfl_xor(km, o));
            km = __shfl(km, 0);
            const bf16_t* qp = QA + tk * 512 + g * 256 + lane * 4; const u32x2 qw = *(const u32x2*)qp;
            const float q0 = __uint_as_float(qw.x << 16), q1 = __uint_as_float(qw.x & 0xffff0000u), q2 = __uint_as_float(qw.y << 16), q3 = __uint_as_float(qw.y & 0xffff0000u);
            float ss = q0 * q0 + q1 * q1 + q2 * q2 + q3 * q3;
#pragma unroll
            for (int o = 8; o >= 1; o >>= 1) ss += __shfl_xor(ss, o);
            if ((lane & 15) == 0) Mst[(wid * 8 + i) * 4 + (lane >> 4)] = sqrtf(ss) * km * 1.0001f + 1e-3f; }
    }
    __syncthreads();
    for (int i = tid; i < 256; i += 512) masks[i] = 0ull;
    if (tid < 256) { float bm = -1e30f; const int hd = tid >> 6; for (int n = tid & 63; n <= 1024; n += 64) bm = fmaxf(bm, lut[hd * 1032 + n]);
#pragma unroll
        for (int o = 32; o >= 1; o >>= 1) bm = fmaxf(bm, __shfl_xor(bm, o));
        if ((tid & 63) == 0) ((float*)(lds + 154240 + 64))[hd] = bm; }
    __syncthreads();
    { const int* ia = (const int*)(lds + 147584); const float* bmh = (const float*)(lds + 154240 + 64);
      for (int e = tid; e < 1024; e += 512) { const int j = ia[e]; if (j >= 0) atomicOr(&masks[j], 1ull << (e >> 4)); }
      if (tid < 256) Mst[tid] += bmh[tid & 3]; }
    __syncthreads();
    if (wid == 0) { int run = 0;
        for (int base = 0; base < 256; base += 64) { const int j = base + lane; const bool nz = masks[j] != 0ull; const unsigned long long bal = __ballot(nz);
            const int pos = run + __popcll(bal & ((1ull << lane) - 1ull)); if (nz) act[pos] = (unsigned short)j; run += __popcll(bal); }
        if (lane == 0) *nact_p = run; }
    __syncthreads();
    {
        const int nact = *nact_p;
        const int slot = c16 >> 2, hsl = c16 & 3, swz = c16 & 7;
        const float* slut = lut + hsl * 1032;
        bf16x8 qA[2], qB[2];
        { const int qo = (g * 4 + hsl) * 64 + quad * 8;
          qA[0] = *(const bf16x8*)(QA + (tw0 + slot) * 512 + qo); qA[1] = *(const bf16x8*)(QA + (tw0 + slot) * 512 + qo + 32);
          qB[0] = *(const bf16x8*)(QA + (tw0 + 4 + slot) * 512 + qo); qB[1] = *(const bf16x8*)(QA + (tw0 + 4 + slot) * 512 + qo + 32); }
        const float mshA = Mst[(wid * 8 + slot) * 4 + hsl], mshB = Mst[(wid * 8 + 4 + slot) * 4 + hsl];
        laccA = 0.f; laccB = 0.f;
#pragma unroll
        for (int dt = 0; dt < 4; ++dt) { osA[dt] = (f32x4){0.f, 0.f, 0.f, 0.f}; osB[dt] = (f32x4){0.f, 0.f, 0.f, 0.f}; }
        const int drow = tid >> 3, dseg = (tid & 7) ^ (drow & 7);
#define SEL_DMA(set, pi) do { _Pragma("unroll") for (int _b = 0; _b < 2; ++_b) { const int _a = 2 * (pi) + _b; const int _j = act[_a < nact ? _a : nact - 1]; \
            LAS unsigned char* _k = (LAS unsigned char*)lds + ((set) * 2 + _b) * 16384 + __builtin_amdgcn_readfirstlane(wid) * 1024; \
            __builtin_amdgcn_global_load_lds((const unsigned*)(KVS + (64 * _j + drow) * 256 + g * 64 + dseg * 8), (LAS unsigned*)_k, 16, 0, 0); \
            __builtin_amdgcn_global_load_lds((const unsigned*)(VST + drow * SEQ + 64 * _j + dseg * 8), (LAS unsigned*)(_k + 8192), 16, 0, 0); } } while (0)
#define SEL_VISIT(QF, MSH, LACC, OS, TB, NIB) do { \
            const bool cval = ((NIB) >> slot) & 1; const int tkl = (TB) + slot; \
            bf16x8 kf[4][2]; u32x2 vv[2][4][2]; \
            _Pragma("unroll") for (int mt = 0; mt < 4; ++mt) { const unsigned char* kr = Kb + (mt * 16 + c16) * 128; kf[mt][0] = *(const bf16x8*)(kr + ((quad ^ swz) * 16)); kf[mt][1] = *(const bf16x8*)(kr + (((4 + quad) ^ swz) * 16)); } \
            __builtin_amdgcn_sched_barrier(0); \
            f32x4 sv[4]; \
            _Pragma("unroll") for (int mt = 0; mt < 4; ++mt) { sv[mt] = __builtin_amdgcn_mfma_f32_16x16x32_bf16(kf[mt][0], QF[0], (f32x4){0.f, 0.f, 0.f, 0.f}, 0, 0, 0); \
                sv[mt] = __builtin_amdgcn_mfma_f32_16x16x32_bf16(kf[mt][1], QF[1], sv[mt], 0, 0, 0); } \
            __builtin_amdgcn_sched_barrier(0); \
            _Pragma("unroll") for (int kk = 0; kk < 2; ++kk) _Pragma("unroll") for (int dt = 0; dt < 4; ++dt) { const unsigned char* vr = Vb + (dt * 16 + c16) * 128; \
                vv[kk][dt][0] = *(const u32x2*)(vr + (((4 * kk + (quad >> 1)) ^ swz) * 16) + 8 * (quad & 1)); vv[kk][dt][1] = *(const u32x2*)(vr + (((4 * kk + 2 + (quad >> 1)) ^ swz) * 16) + 8 * (quad & 1)); } \
            __builtin_amdgcn_sched_barrier(0); \
            float ps = 0.f; \
            if ((TB) - 64 * j - 63 >= 1024) { const float bc = slut[1024] - (MSH); \
                _Pragma("unroll") for (int mt = 0; mt < 4; ++mt) _Pragma("unroll") for (int e = 0; e < 4; ++e) { const float pe = __expf(fmaxf(sv[mt][e] + bc, -80.f)); sv[mt][e] = cval ? pe : 0.f; ps += sv[mt][e]; } \
            } else { const int dbase = tkl - 64 * j - 4 * quad; \
                _Pragma("unroll") for (int mt = 0; mt < 4; ++mt) { float bb[4]; \
                    _Pragma("unroll") for (int e = 0; e < 4; ++e) { int ds = dbase - mt * 16 - e; ds = ds < 0 ? 0 : (ds > 1024 ? 1024 : ds); bb[e] = slut[ds]; } \
                    _Pragma("unroll") for (int e = 0; e < 4; ++e) { const int ds = dbase - mt * 16 - e; const float pe = __expf(fmaxf(sv[mt][e] + bb[e] - (MSH), -80.f)); sv[mt][e] = (cval && ds >= 0) ? pe : 0.f; ps += sv[mt][e]; } } } \
            LACC += ps; \
            _Pragma("unroll") for (int kk = 0; kk < 2; ++kk) { \
                u32x4 pw; pw.x = cvt_pk_bf16(sv[2 * kk][0], sv[2 * kk][1]); pw.y = cvt_pk_bf16(sv[2 * kk][2], sv[2 * kk][3]); pw.z = cvt_pk_bf16(sv[2 * kk + 1][0], sv[2 * kk + 1][1]); pw.w = cvt_pk_bf16(sv[2 * kk + 1][2], sv[2 * kk + 1][3]); \
                const bf16x8 pa = __builtin_bit_cast(bf16x8, pw); \
                _Pragma("unroll") for (int dt = 0; dt < 4; ++dt) { const u32x2 l0 = vv[kk][dt][0], l1 = vv[kk][dt][1]; const bf16x8 vb = __builtin_bit_cast(bf16x8, (u32x4){l0.x, l0.y, l1.x, l1.y}); \
                    OS[dt] = __builtin_amdgcn_mfma_f32_16x16x32_bf16(pa, vb, OS[dt], 0, 0, 0); } } \
        } while (0)
        const int npair = (nact + 1) >> 1;
        SEL_DMA(0, 0); if (npair > 1) SEL_DMA(1, 1); if (npair > 2) SEL_DMA(2, 2); if (npair > 3) SEL_DMA(3, 3);
        for (int it = 0; it < npair; it += 2) {
            { const int younger = (it == 0) ? npair - 2 : 0; if (younger >= 2) asm volatile("s_waitcnt vmcnt(8)" ::: "memory"); else if (younger == 1) asm volatile("s_waitcnt vmcnt(4)" ::: "memory"); else asm volatile("s_waitcnt vmcnt(0)" ::: "memory"); }
            asm volatile("" ::: "memory"); __builtin_amdgcn_s_barrier(); asm volatile("" ::: "memory");
            if (it >= 2) { if (it + 2 < npair) SEL_DMA((it + 2) & 3, it + 2); if (it + 3 < npair) SEL_DMA((it + 3) & 3, it + 3); }
            for (int b = 0; b < 4; ++b) {
                const int a = 2 * it + b; if (a >= nact) break;
                const int j = act[a]; const unsigned long long mk = masks[j];
                const unsigned nib8 = (unsigned)__builtin_amdgcn_readfirstlane((int)(unsigned)(mk >> (wid * 8))) & 0xffu;
                if (nib8 == 0u) continue;
                const unsigned char* Kb = lds + ((((it + (b >> 1)) & 3) * 2) + (b & 1)) * 16384; const unsigned char* Vb = Kb + 8192;
                if (nib8 & 0xfu) SEL_VISIT(qA, mshA, laccA, osA, tw0, nib8 & 0xfu);
                if (nib8 >> 4) SEL_VISIT(qB, mshB, laccB, osB, tw0 + 4, nib8 >> 4);
            }
        }
#undef SEL_DMA
#undef SEL_VISIT
    }
    }
    __syncthreads();
    {
        float* fin = imp + wid * 8 * 256;
        laccA += __shfl_xor(laccA, 16); laccA += __shfl_xor(laccA, 32); laccB += __shfl_xor(laccB, 16); laccB += __shfl_xor(laccB, 32);
        float wA[4], wB[4];
#pragma unroll
        for (int hq = 0; hq < 4; ++hq) { const float la = __shfl(laccA, quad * 4 + hq), lb = __shfl(laccB, quad * 4 + hq);
            wA[hq] = gts[(size_t)(tw0 + quad) * 24 + 8 + g * 4 + hq] / la; wB[hq] = gts[(size_t)(tw0 + 4 + quad) * 24 + 8 + g * 4 + hq] / lb; }
#pragma unroll
        for (int dt = 0; dt < 4; ++dt)
#pragma unroll
            for (int hq = 0; hq < 4; ++hq) { fin[quad * 256 + hq * 64 + dt * 16 + c16] = wA[hq] * osA[dt][hq]; fin[(4 + quad) * 256 + hq * 64 + dt * 16 + c16] = wB[hq] * osB[dt][hq]; }
    }
    float* oc = imp + wid * 8 * 256;
    __builtin_amdgcn_wave_barrier(); asm volatile("s_waitcnt lgkmcnt(0)" ::: "memory");
    {
        const float* OW = (const float*)(p.ws + WS_OW); bf16_t* mix = (bf16_t*)(p.ws + WS_MIX);
        const float* OCb = (const float*)(p.ws + WS_OC);
        for (int i = 0; i < 8; ++i) { const int tk = tw0 + i; const f32x4 a = *(const f32x4*)(oc + i * 256 + lane * 4), b = *(const f32x4*)(OW + (size_t)tk * 512 + g * 256 + lane * 4) + *(const f32x4*)(OCb + (size_t)tk * 512 + g * 256 + lane * 4);
            u32x2 w; w.x = cvt_pk_bf16(a[0] + b[0], a[1] + b[1]); w.y = cvt_pk_bf16(a[2] + b[2], a[3] + b[3]); *(u32x2*)(mix + (size_t)tk * 1024 + g * 256 + lane * 4) = w; }
    }
    __syncthreads();
}


template <int K0, int K1> __device__ __forceinline__ void cmp_sample_issue(const Params& p, int u, f32x4 (&v)[33]) {
    int tid = threadIdx.x; asm volatile("" : "+v"(tid)); const int b = u >> 6, kv = (u >> 5) & 1, grp = u & 31; const int p0 = grp * 512;
    const int* pt = p.page_tab + b * 128 + (p0 >> 7);
    int pg[5];
#pragma unroll
    for (int i = 0; i < 5; ++i) pg[i] = pt[(p0 >> 7) + i < 128 ? i : 0];
#pragma unroll
    for (int k = K0; k < K1; ++k) { const int idx = k * 512 + tid, q = idx >> 5, f4 = idx & 31, pos = p0 + q; const int pi = q >> 7;
        const int page = pi == 0 ? pg[0] : (pi == 1 ? pg[1] : (pi == 2 ? pg[2] : (pi == 3 ? pg[3] : pg[4])));
        if (pos < PAST) v[k] = *(const f32x4*)(p.cache_c + (((size_t)page * 128 + (pos & 127)) * 2 + kv) * 128 + f4 * 4);
        else v[k] = (f32x4){0.f, 0.f, 0.f, 0.f}; }
}
constexpr int CS_NPF = 26;
__device__ __forceinline__ void cmp_sample_stream(const Params& p, unsigned char* lds) {
    int tid_op = threadIdx.x; asm volatile("" : "+v"(tid_op));
    const int tid = tid_op, wid = tid >> 6, lane = tid & 63, r = lane & 31, hh = lane >> 5, G = gridDim.x;
    bf16_t* X = (bf16_t*)lds;
    int u = blockIdx.x; if (u >= 2048) return;
    f32x4 v[33];
    cmp_sample_issue<0, CS_NPF>(p, u, v);
    for (;;) {
        const int b = u >> 6, kv = (u >> 5) & 1, grp = u & 31; const int un = u + G; const bool more = un < 2048;
        const bf16_t* W1T = (const bf16_t*)(p.ws + WS_W1T) + (size_t)kv * 128 * 2048; const bf16_t* W2T = (const bf16_t*)(p.ws + WS_W2T) + (size_t)kv * 64 * 128;
        cmp_sample_issue<CS_NPF, 33>(p, u, v);
        { int tid_o = tid; asm volatile("" : "+v"(tid_o));
#pragma unroll
          for (int k = 0; k < 33; ++k) { const int idx = k * 512 + tid_o, q = idx >> 5, f4 = idx & 31;
            u32x2 w; w.x = cvt_pk_bf16(v[k][0], v[k][1]); w.y = cvt_pk_bf16(v[k][2], v[k][3]); *(u32x2*)(X + ((q & 15) * 33 + (q >> 4)) * 136 + f4 * 4) = w; } }
        const float* pet = (const float*)(p.ws + WS_PET) + kv * 1024; float ptsum = 0.f;
#pragma unroll
        for (int s8 = 0; s8 < 8; ++s8) ptsum += pet[s8 * 128 + (tid & 127)];
        const int rt2 = wid & 1, et = (wid >> 1) & 1;
        bf16_t* W2s = (bf16_t*)(lds + 143616);
        { const u32x4 wa = *(const u32x4*)(W2T + tid * 16), wb = *(const u32x4*)(W2T + tid * 16 + 8); *(u32x4*)(W2s + tid * 16) = wa; *(u32x4*)(W2s + tid * 16 + 8) = wb; }
        __syncthreads();
        const int ct = wid & 3, kh = wid >> 2; const int nl0 = (r >> 1), g = r & 1;
        f32x16 acc0, acc1;
#pragma unroll
        for (int i = 0; i < 16; ++i) { acc0[i] = 0.f; acc1[i] = 0.f; }
        const bf16_t* bp = W1T + (size_t)(ct * 32 + r) * 2048 + (16 * kh) * 64 + 8 * hh;
#define CS_BATCH(L0, NL, ISSUE) do { bf16x8 bf[NL][4]; \
            _Pragma("unroll") for (int li = 0; li < NL; ++li) _Pragma("unroll") for (int ks = 0; ks < 4; ++ks) bf[li][ks] = *(const bf16x8*)(bp + ((L0) + li) * 64 + ks * 16); \
            if ((ISSUE) && more) cmp_sample_issue<0, CS_NPF>(p, un, v); \
            __builtin_amdgcn_sched_barrier(0); \
            _Pragma("unroll") for (int li = 0; li < NL; ++li) { const int l = 16 * kh + (L0) + li; const bf16_t* ap = X + ((l & 15) * 33 + nl0 + (l >> 4)) * 136 + g * 64 + 8 * hh; \
                _Pragma("unroll") for (int ks = 0; ks < 4; ++ks) { const bf16x8 a0 = *(const bf16x8*)(ap + ks * 16), a1 = *(const bf16x8*)(ap + 16 * 136 + ks * 16); \
                    acc0 = __builtin_amdgcn_mfma_f32_32x32x16_bf16(a0, bf[li][ks], acc0, 0, 0, 0); acc1 = __builtin_amdgcn_mfma_f32_32x32x16_bf16(a1, bf[li][ks], acc1, 0, 0, 0); } } \
            __builtin_amdgcn_sched_barrier(0); } while (0)
        if (PROBE_DUP == 35) { CS_BATCH(0, 4, false); CS_BATCH(4, 4, false); CS_BATCH(8, 4, false); CS_BATCH(12, 2, false); CS_BATCH(14, 2, false);
#pragma unroll
            for (int i = 0; i < 16; ++i) { acc0[i] = 0.f; acc1[i] = 0.f; } }
        CS_BATCH(0, 4, false); CS_BATCH(4, 4, false); CS_BATCH(8, 4, false); CS_BATCH(12, 2, false); CS_BATCH(14, 2, true);
#undef CS_BATCH
        for (int rep5 = 0; rep5 < (PROBE_DUP == 36 ? 2 : 1); ++rep5) {
        __syncthreads();
        float* red = (float*)lds;
#pragma unroll
        for (int i = 0; i < 16; ++i) { const int m = (i & 3) + 8 * (i >> 2) + 4 * hh; red[(((kh * 2 + 0) * 4 + ct) * 32 + m) * 32 + r] = acc0[i]; red[(((kh * 2 + 1) * 4 + ct) * 32 + m) * 32 + r] = acc1[i]; }
        __syncthreads();
        bf16_t* hid = (bf16_t*)(lds + 65536);
        for (int e = tid; e < 64 * 128; e += 512) { const int m = e >> 7, hc = e & 127; const int rt = m >> 5, mm = m & 31, c4 = hc >> 5, cc = hc & 31;
            const float vv = red[(((0 * 2 + rt) * 4 + c4) * 32 + mm) * 32 + cc] + red[(((1 * 2 + rt) * 4 + c4) * 32 + mm) * 32 + cc] + ptsum;
            hid[m * 136 + hc] = f2bf(gelu_tanh(vv)); }
        __syncthreads();
        if (wid < 4) {
            f32x16 o;
#pragma unroll
            for (int i = 0; i < 16; ++i) o[i] = 0.f;
#pragma unroll
            for (int ks = 0; ks < 8; ++ks) { const bf16x8 a = *(const bf16x8*)(hid + (rt2 * 32 + r) * 136 + ks * 16 + 8 * hh), wb = *(const bf16x8*)(W2s + (et * 32 + r) * 128 + ks * 16 + 8 * hh); o = __builtin_amdgcn_mfma_f32_32x32x16_bf16(a, wb, o, 0, 0, 0); }
            bf16_t* dst = (bf16_t*)(p.ws + WS_KCMPS) + ((size_t)b * 2 + kv) * 1024 * 128;
#pragma unroll
            for (int i = 0; i < 16; ++i) { const int m = rt2 * 32 + (i & 3) + 8 * (i >> 2) + 4 * hh; const int n = grp * 32 + (m >> 1), gg = m & 1;
                dst[((size_t)n * 2 + gg) * 64 + et * 32 + r] = (n < 1023) ? f2bf(o[i]) : (bf16_t)0; }
        }
        __syncthreads();
        }
        if (!more) break;
        u = un;
    }
}

__device__ __forceinline__ void softmax4(float* sc, int pitch, int nk) {
    const int tid = threadIdx.x, wid = tid >> 6, lane = tid & 63;
    if (wid < 4) { float* s = sc + wid * pitch; float mx = -1e30f;
        for (int k = lane; k < nk; k += 64) mx = fmaxf(mx, s[k]);
#pragma unroll
        for (int o = 32; o >= 1; o >>= 1) mx = fmaxf(mx, __shfl_xor(mx, o));
        float sum = 0.f;
        for (int k = lane; k < nk; k += 64) { const float e = __expf(s[k] - mx); s[k] = e; sum += e; }
        sum = wave_sum(sum); const float inv = 1.0f / sum;
        for (int k = lane; k < nk; k += 64) s[k] *= inv; }
}

__device__ __forceinline__ void nsa_sample_unit(const Params& p, unsigned char* lds, int b, int g) {
    int tid_op = threadIdx.x; asm volatile("" : "+v"(tid_op));
    const int tid = tid_op, wid = tid >> 6, lane = tid & 63;
    constexpr int PITCH = 1040;
    float* qv = (float*)lds;
    float* sc = qv + 256;
    float* osum = sc + 4 * PITCH;
    float* part = osum + 256;
    float* impv = part + 2048;
    int* sidx = (int*)(impv + 264);
    const float** kptr = (const float**)(lds + 32768);
    const float* zs = (const float*)(p.ws + WS_ZS) + (size_t)b * NZ; const float* bl = (const float*)(p.ws + WS_BIAS); const float* gts_dummy = nullptr; (void)gts_dummy;
    const int* pt = p.page_tab + b * 128;
    if (tid < 256) { qv[tid] = zs[ZC_QA + g * 256 + tid] * 0.125f; osum[tid] = 0.f; }
    __syncthreads();
    const int ph = tid >> 6 & 3, pd = tid & 63;
    const float gate_c = sigmoidf_(zs[ZC_GT + 0 + g * 4 + ph]), gate_s = sigmoidf_(zs[ZC_GT + 8 + g * 4 + ph]), gate_w = sigmoidf_(zs[ZC_GT + 16 + g * 4 + ph]);
    {
        const bf16_t* KC = (const bf16_t*)(p.ws + WS_KCMPS) + ((size_t)b * 2) * 1024 * 128; const bf16_t* VC = KC + (size_t)1024 * 128;
        for (int n = tid; n < 1023; n += 512) { const bf16_t* kr = KC + ((size_t)n * 2 + g) * 64; float a0 = 0.f, a1 = 0.f, a2 = 0.f, a3 = 0.f;
#pragma unroll 1
            for (int d8 = 0; d8 < 8; ++d8) { const bf16x8 kk = *(const bf16x8*)(kr + d8 * 8);
#pragma unroll
                for (int e = 0; e < 8; ++e) { const float kf = bf2f((bf16_t)kk[e]); const int d = d8 * 8 + e; a0 += qv[d] * kf; a1 += qv[64 + d] * kf; a2 += qv[128 + d] * kf; a3 += qv[192 + d] * kf; } }
            const int dc = PAST - (16 * n + 31); const int bi = dc < 1024 ? dc : 1024;
            sc[n] = a0 + bl[(g * 4 + 0) * 1032 + bi]; sc[PITCH + n] = a1 + bl[(g * 4 + 1) * 1032 + bi]; sc[2 * PITCH + n] = a2 + bl[(g * 4 + 2) * 1032 + bi]; sc[3 * PITCH + n] = a3 + bl[(g * 4 + 3) * 1032 + bi]; }
        __syncthreads();
        softmax4(sc, PITCH, 1023);
        __syncthreads();
        { float o0 = 0.f, o1 = 0.f, o2 = 0.f, o3 = 0.f;
          for (int k = wid; k < 1023; k += 64) { float v[8];
#pragma unroll
              for (int u = 0; u < 8; ++u) { const int kk = k + 8 * u; v[u] = (kk < 1023) ? bf2f(VC[((size_t)kk * 2 + g) * 64 + pd]) : 0.f; }
#pragma unroll
              for (int u = 0; u < 8; ++u) { const int kk = k + 8 * u; if (kk < 1023) { o0 += sc[kk] * v[u]; o1 += sc[PITCH + kk] * v[u]; o2 += sc[2 * PITCH + kk] * v[u]; o3 += sc[3 * PITCH + kk] * v[u]; } } }
          part[wid * 256 + pd] = o0; part[wid * 256 + 64 + pd] = o1; part[wid * 256 + 128 + pd] = o2; part[wid * 256 + 192 + pd] = o3; }
        for (int j = tid; j < 257; j += 512) { float sacc = 0.f;
            for (int n = 4 * j - 1; n <= 4 * j + 3; ++n) if (n >= 0 && n < 1023) sacc += sc[n] + sc[PITCH + n] + sc[2 * PITCH + n] + sc[3 * PITCH + n];
            impv[j] = sacc; }
        __syncthreads();
        if (tid < 256) { float a = 0.f;
#pragma unroll
            for (int w = 0; w < 8; ++w) a += part[w * 256 + tid];
            osum[tid] += gate_c * a; }
        if (wid == 0) { unsigned long long key[5];
#pragma unroll
            for (int k = 0; k < 5; ++k) { const int j = lane + 64 * k; const bool forced = (j == 0) || (j == 256) || (j == 255); const float v = (j < 257) ? (forced ? 1e4f : impv[j]) : 0.f;
                key[k] = (j < 257) ? (((unsigned long long)__float_as_uint(v) << 32) | (unsigned long long)(512 - j)) : 0ull; }
            for (int sel = 0; sel < 16; ++sel) { unsigned long long best = key[0];
#pragma unroll
                for (int k = 1; k < 5; ++k) best = best > key[k] ? best : key[k];
#pragma unroll
                for (int o = 32; o >= 1; o >>= 1) { const unsigned long long ot = __shfl_xor(best, o); best = best > ot ? best : ot; }
                if (lane == 0) sidx[sel] = 512 - (int)(best & 0x3ffull);
#pragma unroll
                for (int k = 0; k < 5; ++k) if (key[k] == best) key[k] = 0ull; } }
        __syncthreads();
    }
    for (int br = 0; br < 2; ++br) {
        int nk;
        if (br == 0) { nk = 1024;
            for (int k = tid; k < 1024; k += 512) { const int j = sidx[k >> 6], pos = 64 * j + (k & 63); const float* rp = nullptr;
                if (pos < PAST) rp = p.cache_s + (((size_t)pt[pos >> 7] * 128 + (pos & 127)) * 2) * 128 + g * 64; else if (pos == PAST) rp = zs + ZC_KVS + g * 64;
                kptr[k] = rp; ((int*)(lds + 32768 + 8192))[k] = PAST - pos; }
        } else { nk = 513;
            for (int k = tid; k < 513; k += 512) { kptr[k] = (k < 512) ? p.st_win + (((size_t)b * 512 + k) * 2) * 128 + g * 64 : zs + ZC_KVW + g * 64; ((int*)(lds + 32768 + 8192))[k] = 512 - k; } }
        __syncthreads();
        const int* dist = (const int*)(lds + 32768 + 8192);
        for (int k = tid; k < nk; k += 512) { const float* kr = kptr[k]; const int ds = dist[k];
            if (kr == nullptr || ds < 0) { sc[k] = -1e30f; sc[PITCH + k] = -1e30f; sc[2 * PITCH + k] = -1e30f; sc[3 * PITCH + k] = -1e30f; continue; }
            float a0 = 0.f, a1 = 0.f, a2 = 0.f, a3 = 0.f;
#pragma unroll 2
            for (int d4 = 0; d4 < 16; ++d4) { const f32x4 kk = *(const f32x4*)(kr + d4 * 4);
#pragma unroll
                for (int e = 0; e < 4; ++e) { const int d = d4 * 4 + e; a0 += qv[d] * kk[e]; a1 += qv[64 + d] * kk[e]; a2 += qv[128 + d] * kk[e]; a3 += qv[192 + d] * kk[e]; } }
            const int bi = ds < 1024 ? ds : 1024;
            sc[k] = a0 + bl[(g * 4 + 0) * 1032 + bi]; sc[PITCH + k] = a1 + bl[(g * 4 + 1) * 1032 + bi]; sc[2 * PITCH + k] = a2 + bl[(g * 4 + 2) * 1032 + bi]; sc[3 * PITCH + k] = a3 + bl[(g * 4 + 3) * 1032 + bi]; }
        __syncthreads();
        softmax4(sc, PITCH, nk);
        __syncthreads();
        { float o0 = 0.f, o1 = 0.f, o2 = 0.f, o3 = 0.f;
          for (int k = wid; k < nk; k += 64) { float v[8];
#pragma unroll
              for (int u = 0; u < 8; ++u) { const int kk = k + 8 * u; const float* kr = (kk < nk) ? kptr[kk] : nullptr; v[u] = (kr != nullptr) ? kr[128 + pd] : 0.f; }
#pragma unroll
              for (int u = 0; u < 8; ++u) { const int kk = k + 8 * u; if (kk < nk) { o0 += sc[kk] * v[u]; o1 += sc[PITCH + kk] * v[u]; o2 += sc[2 * PITCH + kk] * v[u]; o3 += sc[3 * PITCH + kk] * v[u]; } } }
          part[wid * 256 + pd] = o0; part[wid * 256 + 64 + pd] = o1; part[wid * 256 + 128 + pd] = o2; part[wid * 256 + 192 + pd] = o3; }
        __syncthreads();
        if (tid < 256) { float a = 0.f;
#pragma unroll
            for (int w = 0; w < 8; ++w) a += part[w * 256 + tid];
            osum[tid] += (br == 0 ? gate_s : gate_w) * a; }
        __syncthreads();
    }
    if (tid < 256) ((bf16_t*)(p.ws + WS_MIX))[(size_t)(SEQ + b) * 1024 + g * 256 + tid] = f2bf(osum[tid]);
    __syncthreads();
}

__device__ __forceinline__ void phase3(const Params& p, unsigned char* lds) {
    const int G = gridDim.x, bid = blockIdx.x;
    for (int rep = 0; rep < (PROBE_DUP == 31 ? 2 : 1); ++rep) for (int u = bid; u < 256; u += G) win_unit(p, lds, u & 1, u >> 1);
    for (int rep = 0; rep < (PROBE_DUP == 32 ? 2 : 1); ++rep) for (int u = bid; u < 1024; u += G) ret_uc_unit(p, lds, u >> 3, u & 7);
    for (int rep = 0; rep < (PROBE_DUP == 30 ? 2 : 1); ++rep) cmp_sample_stream(p, lds);
    for (int rep = 0; rep < (PROBE_DUP == 33 ? 2 : 1); ++rep) { for (int u = bid; u < 128; u += G) cmp_prompt_unit(p, lds, u & 1, (u >> 1) * 16);
    for (int u = G - 1 - bid; u < 256; u += G) vst_unit(p, lds, u * 64); }
}
__device__ __forceinline__ void phase4(const Params& p, unsigned char* lds) {
    const int G = gridDim.x, bid = blockIdx.x, tid = threadIdx.x, wid = tid >> 6, lane = tid & 63;
    for (int rep = 0; rep < (PROBE_DUP == 41 ? 2 : 1); ++rep) for (int u = bid; u < 512; u += G) nsa_unit(p, lds, u & 1, 255 - (u >> 1));
    for (int rep = 0; rep < (PROBE_DUP == 40 ? 2 : 1); ++rep) for (int u = G - 1 - bid; u < 64; u += G) nsa_sample_unit(p, lds, u >> 1, u & 1);
    for (int u = bid; u < 16; u += G) ret_scan(p, u * 512 + tid);
    for (int u = (G - 1 - bid) * 8 + wid; u < NB * 8; u += G * 8) ret_sample_wave(p, u >> 3, u & 7, lane);
}
__device__ __forceinline__ void phase5(const Params& p, unsigned char* lds) {
    const int G = gridDim.x, bid = blockIdx.x;
    for (int u = bid; u < 512; u += G) ret_out_unit(p, lds, u >> 2, u & 3);
}

struct EpiRes {
    static constexpr bool PERM = false, AFTER_DRAIN = false;
    const float* base; float* dst; const float* gate;
    __device__ __forceinline__ void operator()(const f32x4 (&acc)[2][2][4][2], const pg8::Unit& u, int wr, int wc, int fr, int fq) const {
        const int row0 = u.pm * 256 + wr * 64 + fr; const int cb = u.pn * 256 + wc * 32 + 4 * fq;
        f32x4 gv[2][2];
#pragma unroll
        for (int bj = 0; bj < 2; ++bj)
#pragma unroll
            for (int n = 0; n < 2; ++n) gv[bj][n] = *(const f32x4*)(gate + cb + bj * 128 + n * 16);
#pragma unroll
        for (int ai = 0; ai < 2; ++ai)
#pragma unroll
            for (int m = 0; m < 4; ++m) { const size_t ro = (size_t)(row0 + ai * 128 + m * 16) * 1024;
#pragma unroll
                for (int bj = 0; bj < 2; ++bj)
#pragma unroll
                    for (int n = 0; n < 2; ++n) { const int c = cb + bj * 128 + n * 16; const f32x4 b = *(const f32x4*)(base + ro + c);
                        *(f32x4*)(dst + ro + c) = b + gv[bj][n] * acc[ai][bj][m][n]; } }
    }
};
__device__ __forceinline__ void phase6(const Params& p, unsigned char* lds) {
    const int G = gridDim.x, bid = blockIdx.x;
    const bf16_t* MIX = (const bf16_t*)(p.ws + WS_MIX); const bf16_t* WoutT = (const bf16_t*)(p.ws + WS_WOUT_T);
    float* X1 = (float*)(p.ws + WS_X1); const float* mod = (const float*)(p.ws + WS_MOD);
    {
        pg8::Gemm g{MIX, WoutT, SEQ, 1024, 1024}; pg8::StaticOrder S; S.init(SEQ, 1024, G, bid);
        EpiRes E{p.x_p, X1, mod + 2048};
        pg8::gemm_phase<EpiRes, pg8::StaticOrder, true, true>((LAS unsigned char*)lds, g, S, E);
    }
    __syncthreads();
    for (int u = bid; u < 32; u += G)
        skinny32_unit(lds, MIX + (size_t)SEQ * 1024, WoutT, 1024, u * 32, [&](int m, int n, float v) {
            X1[(size_t)(SEQ + m) * 1024 + n] = p.x_s[(size_t)m * 1024 + n] + mod[(size_t)(1 + m) * 6144 + 2048 + n] * v; });
}
__device__ __forceinline__ void phase7(const Params& p, unsigned char* lds) {
    const int tid = threadIdx.x, wid = tid >> 6, lane = tid & 63, G = gridDim.x, bid = blockIdx.x;
    float* sA = (float*)lds; float* sB = sA + 1024;
    const float* X1 = (const float*)(p.ws + WS_X1); bf16_t* HN2 = (bf16_t*)(p.ws + WS_HN2); const float* mod = (const float*)(p.ws + WS_MOD);
    int cur = -1;
    for (int u = bid; u < 256 + NB; u += G) {
        const int mr = (u < 256) ? 0 : (1 + u - 256);
        if (mr != cur) { __syncthreads(); for (int c = tid; c < 1024; c += 512) { sA[c] = p.g_ffn[c] * (1.0f + mod[(size_t)mr * 6144 + 4096 + c]); sB[c] = mod[(size_t)mr * 6144 + 3072 + c]; } __syncthreads(); cur = mr; }
        if (u < 256) { for (int i = 0; i < 8; ++i) { const int row = u * 64 + wid * 8 + i; norm_row_store(X1 + (size_t)row * 1024, sA, sB, HN2 + (size_t)row * 1024, lane); } }
        else if (wid == 0) { const int row = SEQ + u - 256; norm_row_store(X1 + (size_t)row * 1024, sA, sB, HN2 + (size_t)row * 1024, lane); }
    }
}
struct EpiUp {
    static constexpr bool PERM = false, AFTER_DRAIN = false;
    unsigned char* ws; float* out;
    __device__ __forceinline__ void operator()(const f32x4 (&acc)[2][2][4][2], const pg8::Unit& u, int wr, int wc, int fr, int fq) const {
        const int pn = u.pn; const int row0 = u.pm * 256 + wr * 64 + fr; const int cb = wc * 32 + 4 * fq;
        bf16_t* bdst = (pn < 11) ? (bf16_t*)(ws + WS_AG) + pn * 256 : (bf16_t*)(ws + WS_AV) + (pn - 11) * 256;
#pragma unroll
        for (int ai = 0; ai < 2; ++ai)
#pragma unroll
            for (int m = 0; m < 4; ++m) { const int row = row0 + ai * 128 + m * 16;
#pragma unroll
                for (int bj = 0; bj < 2; ++bj)
#pragma unroll
                    for (int n = 0; n < 2; ++n) { const int c = cb + bj * 128 + n * 16; const f32x4 v = acc[ai][bj][m][n];
                        u32x2 w; w.x = cvt_pk_bf16(v[0], v[1]); w.y = cvt_pk_bf16(v[2], v[3]);
                        *(u32x2*)(bdst + (size_t)row * DFF + c) = w;
                        if (pn < 11 && row >= SEQ - 2) *(f32x4*)(out + O_CONV_P + (size_t)(row - (SEQ - 2)) * DFF + pn * 256 + c) = v; } }
    }
};
__device__ __forceinline__ void phase8(const Params& p, unsigned char* lds) {
    const int G = gridDim.x, bid = blockIdx.x;
    const bf16_t* HN2 = (const bf16_t*)(p.ws + WS_HN2); const bf16_t* WupT = (const bf16_t*)(p.ws + WS_WUP_T);
    {
        pg8::Gemm g{HN2, WupT, SEQ, 5632, 1024}; pg8::StaticOrder S; S.init(SEQ, 5632, G, bid);
        EpiUp E{p.ws, p.out};
        pg8::gemm_phase<EpiUp, pg8::StaticOrder, true, true>((LAS unsigned char*)lds, g, S, E);
    }
    __syncthreads();
    float* ags = (float*)(p.ws + WS_AGS); float* avs = (float*)(p.ws + WS_AVS); float* out = p.out;
    for (int u = G - 1 - bid; u < 176; u += G)
        skinny32_unit(lds, HN2 + (size_t)SEQ * 1024, WupT, 1024, u * 32, [&](int m, int n, float v) {
            if (n < DFF) { ags[(size_t)m * DFF + n] = v; out[O_CONV_S + ((size_t)m * 2 + 1) * DFF + n] = v; } else avs[(size_t)m * DFF + (n - DFF)] = v; });
}
__device__ __forceinline__ void phase9(const Params& p, unsigned char* lds) {
    const int G = gridDim.x, bid = blockIdx.x, tid = threadIdx.x;
    const bf16_t* AG = (const bf16_t*)(p.ws + WS_AG); const bf16_t* AV = (const bf16_t*)(p.ws + WS_AV); bf16_t* H = (bf16_t*)(p.ws + WS_H);
    const int gt = bid * 512 + tid, GT = G * 512;
    for (int it = gt; it < 512 * 352; it += GT) {
        const int rb = it / 352, cg = it % 352; const int c0 = cg * 8, t0 = rb * 32;
        float w0[8], w1[8], w2[8], cb[8], p2[8], p1[8];
#pragma unroll
        for (int e = 0; e < 8; ++e) { w0[e] = p.conv_w[c0 + e]; w1[e] = p.conv_w[DFF + c0 + e]; w2[e] = p.conv_w[2 * DFF + c0 + e]; cb[e] = p.conv_b[c0 + e]; p2[e] = 0.f; p1[e] = 0.f; }
        if (t0 > 0) { const bf16x8 a = *(const bf16x8*)(AG + (size_t)(t0 - 2) * DFF + c0), b = *(const bf16x8*)(AG + (size_t)(t0 - 1) * DFF + c0);
#pragma unroll
            for (int e = 0; e < 8; ++e) { p2[e] = bf2f((bf16_t)a[e]); p1[e] = bf2f((bf16_t)b[e]); } }
        for (int tb = t0; tb < t0 + 32; tb += 8) {
            bf16x8 av8[8], vv8[8];
#pragma unroll
            for (int r8 = 0; r8 < 8; ++r8) { av8[r8] = *(const bf16x8*)(AG + (size_t)(tb + r8) * DFF + c0); vv8[r8] = *(const bf16x8*)(AV + (size_t)(tb + r8) * DFF + c0); }
            __builtin_amdgcn_sched_barrier(0);
#pragma unroll
            for (int r8 = 0; r8 < 8; ++r8) { float y[8];
#pragma unroll
                for (int e = 0; e < 8; ++e) { const float ag = bf2f((bf16_t)av8[r8][e]); const float cv = cb[e] + w0[e] * p2[e] + w1[e] * p1[e] + w2[e] * ag; y[e] = cv / (1.0f + __expf(-cv)) * bf2f((bf16_t)vv8[r8][e]); p2[e] = p1[e]; p1[e] = ag; }
                u32x4 w; w.x = cvt_pk_bf16(y[0], y[1]); w.y = cvt_pk_bf16(y[2], y[3]); w.z = cvt_pk_bf16(y[4], y[5]); w.w = cvt_pk_bf16(y[6], y[7]);
                *(u32x4*)(H + (size_t)(tb + r8) * DFF + c0) = w; }
        }
    }
    const float* ags = (const float*)(p.ws + WS_AGS); const float* avs = (const float*)(p.ws + WS_AVS); bf16_t* HS = (bf16_t*)(p.ws + WS_HS);
    for (int i = gt; i < NB * DFF; i += GT) { const int b = i / DFF, c = i % DFF;
        const float cv = p.conv_b[c] + p.conv_w[c] * p.st_conv[(size_t)b * 2 * DFF + c] + p.conv_w[DFF + c] * p.st_conv[(size_t)b * 2 * DFF + DFF + c] + p.conv_w[2 * DFF + c] * ags[i];
        HS[i] = f2bf(cv / (1.0f + __expf(-cv)) * avs[i]); }
}
__device__ __forceinline__ void phase10(const Params& p, unsigned char* lds) {
    const int G = gridDim.x, bid = blockIdx.x;
    const bf16_t* H = (const bf16_t*)(p.ws + WS_H); const bf16_t* WdnT = (const bf16_t*)(p.ws + WS_WDN_T);
    float* X1 = (float*)(p.ws + WS_X1); const float* mod = (const float*)(p.ws + WS_MOD);
    {
        pg8::Gemm g{H, WdnT, SEQ, 1024, DFF}; pg8::StaticOrder S; S.init(SEQ, 1024, G, bid);
        EpiRes E{X1, X1, mod + 5120};
        pg8::gemm_phase<EpiRes, pg8::StaticOrder, true, true>((LAS unsigned char*)lds, g, S, E);
    }
    __syncthreads();
    const bf16_t* HS = (const bf16_t*)(p.ws + WS_HS);
    for (int u = bid; u < 32; u += G)
        skinny32_unit(lds, HS, WdnT, DFF, u * 32, [&](int m, int n, float v) {
            float* x = X1 + (size_t)(SEQ + m) * 1024 + n; *x = *x + mod[(size_t)(1 + m) * 6144 + 5120 + n] * v; });
}
__device__ __forceinline__ void phase11(const Params& p, unsigned char* lds) {
    const int tid = threadIdx.x, wid = tid >> 6, lane = tid & 63, G = gridDim.x, bid = blockIdx.x;
    const float* X1 = (const float*)(p.ws + WS_X1);
    for (int r = bid * 8 + wid; r < SEQ + NB; r += G * 8) {
        const float* xr = X1 + (size_t)r * 1024; float* dst = (r < SEQ) ? p.out + O_YP + (size_t)r * 1024 : p.out + O_YS + (size_t)(r - SEQ) * 1024;
        f32x4 v[4]; float ss = 0.f;
#pragma unroll
        for (int j = 0; j < 4; ++j) { v[j] = *(const f32x4*)(xr + lane * 4 + 256 * j); ss += v[j][0] * v[j][0] + v[j][1] * v[j][1] + v[j][2] * v[j][2] + v[j][3] * v[j][3]; }
        ss = wave_sum(ss); const float rstd = rsqrtf(ss * (1.0f / 1024.0f) + 1e-6f);
#pragma unroll
        for (int j = 0; j < 4; ++j) { const int c = lane * 4 + 256 * j; const f32x4 g = *(const f32x4*)(p.g_fin + c); *(f32x4*)(dst + c) = v[j] * rstd * g; }
    }
}

constexpr int LDS_BYTES = 163840, LDS_CTL = LDS_BYTES - 64;
constexpr int N_PHASES = 12;
__global__ void __launch_bounds__(512, 2) fwd_kernel(Params p) {
    extern __shared__ __attribute__((aligned(16))) unsigned char lds[];
    const int lo = (int)p.ph_lo, hi = (int)p.ph_hi;
    if (threadIdx.x < 16) ((LAS unsigned*)((LAS unsigned char*)lds + LDS_CTL))[threadIdx.x] = 0u;
    __syncthreads();
    XcdBarrier bar; bar.bar = (unsigned*)(p.ws + WS_BAR); bar.x = 0; bar.st = nullptr;
    if (hi - lo > 1) bar = xcd_barrier_post((unsigned*)(p.ws + WS_BAR), (volatile LAS unsigned*)((LAS unsigned char*)lds + LDS_CTL));
#define IN(k) (lo <= (k) && (k) < hi)
#define SEAM(k) do { if (IN(k) && IN((k) + 1)) xcd_barrier(bar); } while (0)
    if (IN(0)) { phase0(p, lds); if (PROBE_DUP == 0) { xcd_barrier(bar); phase0(p, lds); } } SEAM(0);
    if (IN(1)) { phase1(p, lds); if (PROBE_DUP == 1) { xcd_barrier(bar); phase1(p, lds); } } SEAM(1);
    if (IN(2)) { phase2(p, lds); if (PROBE_DUP == 2) { xcd_barrier(bar); phase2(p, lds); } } SEAM(2);
    if (IN(3)) { phase3(p, lds); if (PROBE_DUP == 3) { xcd_barrier(bar); phase3(p, lds); } } SEAM(3);
    if (IN(4)) { phase4(p, lds); if (PROBE_DUP == 4) { xcd_barrier(bar); phase4(p, lds); } } SEAM(4);
    if (IN(5)) { phase5(p, lds); if (PROBE_DUP == 5) { xcd_barrier(bar); phase5(p, lds); } } SEAM(5);
    if (IN(6)) { phase6(p, lds); if (PROBE_DUP == 6) { xcd_barrier(bar); phase6(p, lds); } } SEAM(6);
    if (IN(7)) { phase7(p, lds); if (PROBE_DUP == 7) { xcd_barrier(bar); phase7(p, lds); } } SEAM(7);
    if (IN(8)) { phase8(p, lds); if (PROBE_DUP == 8) { xcd_barrier(bar); phase8(p, lds); } } SEAM(8);
    if (IN(9)) { phase9(p, lds); if (PROBE_DUP == 9) { xcd_barrier(bar); phase9(p, lds); } } SEAM(9);
    if (IN(10)) { phase10(p, lds); if (PROBE_DUP == 10) { xcd_barrier(bar); phase10(p, lds); } } SEAM(10);
    if (IN(11)) { phase11(p, lds); if (PROBE_DUP == 11) { xcd_barrier(bar); phase11(p, lds); } }
#undef IN
#undef SEAM
}

extern "C" void kernel_launch(void* const* d_in, const int* in_sizes, int n_in, void* d_out, int out_size, void* d_ws, size_t ws_size, hipStream_t stream) {
    static int grid = 0;
    if (grid == 0) {
        if (n_in != 29 || out_size != (int)O_END || ws_size < WS_END) { fprintf(stderr, "kernel_launch: unexpected sizes n_in %d out %d ws %zu (need %zu)\n", n_in, out_size, ws_size, (size_t)WS_END); grid = -1; return; }
        int dev = 0, cus = 0;
        if (hipGetDevice(&dev) != hipSuccess || hipDeviceGetAttribute(&cus, hipDeviceAttributeMultiprocessorCount, dev) != hipSuccess) { grid = -1; return; }
        if (hipFuncSetAttribute((const void*)fwd_kernel, hipFuncAttributeMaxDynamicSharedMemorySize, LDS_BYTES) != hipSuccess) { fprintf(stderr, "kernel_launch: hipFuncSetAttribute failed\n"); grid = -1; return; }
        int per_cu = 0;
        if (hipOccupancyMaxActiveBlocksPerMultiprocessor(&per_cu, (const void*)fwd_kernel, 512, LDS_BYTES) != hipSuccess || per_cu < 1) fprintf(stderr, "kernel_launch: occupancy query says %d\n", per_cu);
        (void)hipGetLastError();
        grid = cus;
    }
    if (grid < 0) return;
    (void)hipMemsetAsync((char*)d_ws + WS_BAR, 0, 16384, stream);
    Params p{};
    p.x_p = (const float*)d_in[0]; p.x_s = (const float*)d_in[1]; p.cache_c = (const float*)d_in[2]; p.cache_s = (const float*)d_in[3]; p.st_win = (const float*)d_in[4];
    p.st_ret = (const float*)d_in[5]; p.st_conv = (const float*)d_in[6]; p.page_tab = (const int*)d_in[7]; p.c_p = (const float*)d_in[8]; p.c_s = (const float*)d_in[9];
    p.w_ada = (const float*)d_in[10]; p.b_ada = (const float*)d_in[11]; p.g_mix = (const float*)d_in[12]; p.w_in = (const float*)d_in[13]; p.pe_k = (const float*)d_in[14]; p.pe_v = (const float*)d_in[15];
    p.w1_k = (const float*)d_in[16]; p.w1_v = (const float*)d_in[17]; p.w2_k = (const float*)d_in[18]; p.w2_v = (const float*)d_in[19]; p.table = (const float*)d_in[20]; p.gn_g = (const float*)d_in[21];
    p.w_out = (const float*)d_in[22]; p.g_ffn = (const float*)d_in[23]; p.w_up = (const float*)d_in[24]; p.conv_w = (const float*)d_in[25]; p.conv_b = (const float*)d_in[26]; p.w_down = (const float*)d_in[27]; p.g_fin = (const float*)d_in[28];
    p.out = (float*)d_out; p.ws = (unsigned char*)d_ws;
#if MK_ONE_LAUNCH
    p.ph_lo = 0; p.ph_hi = N_PHASES;
    hipLaunchKernelGGL(fwd_kernel, dim3(grid), dim3(512), LDS_BYTES, stream, p);
#else
    for (int ph = 0; ph < N_PHASES; ++ph) { if (DBG_SKIP_MIX && ph == 5) continue; p.ph_lo = ph; p.ph_hi = ph + 1; hipLaunchKernelGGL(fwd_kernel, dim3(grid), dim3(512), LDS_BYTES, stream, p); }
#endif
}
```

```cpp
#include <hip/hip_runtime.h>
#include <cstdio>
#include <cstdint>

#ifndef DBG_SKIP_MIX
#define DBG_SKIP_MIX 0
#endif
#ifndef DBG_NO_NSA
#define DBG_NO_NSA 0
#endif
#ifndef PROBE_DUP
#define PROBE_DUP -1
#endif
#ifndef MK_ONE_LAUNCH
#define MK_ONE_LAUNCH 1
#endif

#define LAS __attribute__((address_space(3)))
typedef unsigned short bf16_t;
typedef short bf16x8 __attribute__((ext_vector_type(8)));
typedef float f32x4 __attribute__((ext_vector_type(4)));
typedef float f32x2 __attribute__((ext_vector_type(2)));
typedef float f32x16 __attribute__((ext_vector_type(16)));
typedef unsigned u32x4 __attribute__((ext_vector_type(4)));
typedef unsigned u32x2 __attribute__((ext_vector_type(2)));

constexpr int SEQ = 16384, DM = 1024, NB = 32, DFF = 2816, NZ = 3584  , PAST = 16384;
constexpr int MROWS = SEQ + NB;
constexpr size_t O_YP = 0, O_YS = 16777216, O_CMP_P = 16809984, O_CMP_S = 21004288, O_SLC_P = 21012480, O_SLC_S = 25206784,
                 O_WIN_P = 25214976, O_WIN_S = 25346048, O_RET_P = 29540352, O_RET_S = 29573120, O_CONV_P = 30621696, O_CONV_S = 30627328, O_END = 30807552;
constexpr int ZC_QA = 0, ZC_KVC = 512, ZC_KVS = 768, ZC_KVW = 1024, ZC_QR = 1280, ZC_KR = 1792, ZC_VR = 2304, ZC_GR = 2816, ZC_GT = 3328;

constexpr size_t al256(size_t x) { return (x + 255) & ~(size_t)255; }
constexpr size_t WS_BAR = 0;
constexpr size_t WS_MODP = 16384;
constexpr size_t WS_MOD = WS_MODP + al256((size_t)8 * 33 * 6144 * 4);
constexpr size_t WS_ROPE = WS_MOD + al256((size_t)33 * 6144 * 4);
constexpr size_t WS_BIAS = WS_ROPE + al256((size_t)2 * 16385 * 32 * 4);
constexpr size_t WS_WIN_T = WS_BIAS + al256((size_t)8 * 1032 * 4);
constexpr size_t WS_WOUT_T = WS_WIN_T + (size_t)NZ * 1024 * 2;
constexpr size_t WS_WUP_T = WS_WOUT_T + (size_t)1024 * 1024 * 2;
constexpr size_t WS_WDN_T = WS_WUP_T + (size_t)5632 * 1024 * 2;
constexpr size_t WS_W1T = WS_WDN_T + (size_t)1024 * 2816 * 2;
constexpr size_t WS_W2T = WS_W1T + (size_t)2 * 128 * 2048 * 2;
constexpr size_t WS_PET = WS_W2T + (size_t)2 * 64 * 128 * 2;
constexpr size_t WS_HN = WS_PET + 8192;
constexpr size_t WS_QA = WS_HN + (size_t)(SEQ + 256) * 1024 * 2;
constexpr size_t WS_KVC = WS_QA + (size_t)SEQ * 512 * 2;
constexpr size_t WS_KVS = WS_KVC + (size_t)SEQ * 256 * 2;
constexpr size_t WS_KVW = WS_KVS + (size_t)SEQ * 256 * 2;
constexpr size_t WS_QR = WS_KVW + (size_t)SEQ * 256 * 2;
constexpr size_t WS_KR = WS_QR + (size_t)SEQ * 512 * 2;
constexpr size_t WS_VR = WS_KR + (size_t)SEQ * 512 * 2;
constexpr size_t WS_GR = WS_VR + (size_t)SEQ * 512 * 2;
constexpr size_t WS_GATES = WS_GR + (size_t)SEQ * 512 * 2;
constexpr size_t WS_ZS = WS_GATES + (size_t)SEQ * 24 * 4;
constexpr size_t WS_UC = WS_ZS + (size_t)NB * NZ * 4;
constexpr size_t WS_SC = WS_UC + (size_t)128 * 8 * 4096 * 4;
constexpr size_t WS_MIX = WS_SC + (size_t)128 * 8 * 4096 * 4;
constexpr size_t WS_X1 = WS_MIX + (size_t)(SEQ + 256) * 1024 * 2;
constexpr size_t WS_HN2 = WS_X1 + (size_t)(SEQ + 32) * 1024 * 4;
constexpr size_t WS_AG = WS_HN2 + (size_t)(SEQ + 256) * 1024 * 2;
constexpr size_t WS_AV = WS_AG + (size_t)SEQ * DFF * 2;
constexpr size_t WS_H = WS_AV + (size_t)SEQ * DFF * 2;
constexpr size_t WS_AGS = WS_H + (size_t)SEQ * DFF * 2;
constexpr size_t WS_AVS = WS_AGS + (size_t)NB * DFF * 4;
constexpr size_t WS_HS = WS_AVS + (size_t)NB * DFF * 4;
constexpr size_t WS_KCMP = WS_HS + (size_t)NB * DFF * 2;
constexpr size_t WS_VST = WS_KCMP + (size_t)2 * 1024 * 128 * 2;
constexpr size_t WS_OW = WS_VST + (size_t)2 * 64 * SEQ * 2;
constexpr size_t WS_KCMPS = WS_OW + (size_t)SEQ * 512 * 4;
constexpr size_t WS_KBM = WS_KCMPS + (size_t)NB * 2 * 1024 * 128 * 2;
constexpr size_t WS_KCM = WS_KBM + 2048;
constexpr size_t WS_OC = WS_KBM + 4096;
constexpr size_t WS_END = WS_OC + (size_t)SEQ * 512 * 4;

struct Params {
    const float *x_p, *x_s, *cache_c, *cache_s, *st_win, *st_ret, *st_conv; const int* page_tab;
    const float *c_p, *c_s, *w_ada, *b_ada, *g_mix, *w_in, *pe_k, *pe_v, *w1_k, *w1_v, *w2_k, *w2_v, *table, *gn_g, *w_out, *g_ffn, *w_up, *conv_w, *conv_b, *w_down, *g_fin;
    float* out; unsigned char* ws; long long ph_lo, ph_hi;
};

typedef __bf16 bf16v2_t __attribute__((ext_vector_type(2)));
__device__ __forceinline__ unsigned cvt_pk_bf16(float lo, float hi) { const f32x2 v = {lo, hi}; const bf16v2_t b = __builtin_convertvector(v, bf16v2_t); return __builtin_bit_cast(unsigned, b); }
__device__ __forceinline__ bf16_t f2bf(float f) { unsigned u = __float_as_uint(f); u += 0x7FFFu + ((u >> 16) & 1u); return (bf16_t)(u >> 16); }
__device__ __forceinline__ float bf2f(bf16_t b) { return __uint_as_float(((unsigned)b) << 16); }
__device__ __forceinline__ float wave_sum(float v) {
#pragma unroll
    for (int o = 32; o >= 1; o >>= 1) v += __shfl_xor(v, o);
    return v;
}
__device__ __forceinline__ float sigmoidf_(float x) { return 1.0f / (1.0f + __expf(-x)); }

#define XB_TMO      128
#define XB_XCNT(j)  (256  + 64 * (j))
#define XB_XSUB(j)  (1280 + 64 * (j))
#define XB_XGEN(j)  (2304 + 64 * (j))
#define XB_TOP      3328
#define XB_TOPGEN   3392
#define XCD_BAR_WORDS 3456
#define XB_SPIN_CAP (1u << 18)
__device__ __forceinline__ unsigned xb_ld(unsigned* p)              { return __hip_atomic_load(p, __ATOMIC_RELAXED, __HIP_MEMORY_SCOPE_AGENT); }
__device__ __forceinline__ unsigned xb_add(unsigned* p, unsigned v) { return __hip_atomic_fetch_add(p, v, __ATOMIC_RELAXED, __HIP_MEMORY_SCOPE_AGENT); }
__device__ __forceinline__ unsigned xb_xcc_id() { return (unsigned)__builtin_amdgcn_s_getreg((3 << 11) | 20) & 0xFu; }
#define XB_SPIN(cond, bar) do { unsigned _sp = 0; while (cond) { __builtin_amdgcn_s_sleep(1); \
    if ((++_sp & 255u) == 0u) { if (xb_ld(&(bar)[XB_TMO])) break; if (_sp > XB_SPIN_CAP) { atomicAdd(&(bar)[XB_TMO], 1u); break; } } } } while (0)
struct XcdBarrier { unsigned* bar; unsigned x; volatile LAS unsigned* st; };
__device__ __forceinline__ XcdBarrier xcd_barrier_post(unsigned* bar, volatile LAS unsigned* st) {
    XcdBarrier b; b.bar = bar; b.x = xb_xcc_id(); b.st = st;
    if (threadIdx.x == 0) (void)xb_add(&bar[XB_XCNT(b.x)], 1u);
    return b;
}
__device__ __forceinline__ void xcd_barrier_complete(unsigned* bar, unsigned x, unsigned& nloc, unsigned& nx) {
    const unsigned G = gridDim.x * gridDim.y * gridDim.z;
    unsigned sum, cnt, mine, sp = 0u;
    for (;;) {
        sum = 0u; cnt = 0u; mine = 0u;
#pragma unroll
        for (unsigned j = 0; j < 16; ++j) { const unsigned c = xb_ld(&bar[XB_XCNT(j)]); sum += c; cnt += (c > 0u) ? 1u : 0u; mine = (j == x) ? c : mine; }
        if (sum == G) break;
        __builtin_amdgcn_s_sleep(1);
        if ((++sp & 255u) == 0u) { if (xb_ld(&bar[XB_TMO])) break; if (sp > XB_SPIN_CAP) { atomicAdd(&bar[XB_TMO], 1u); break; } }
    }
    nloc = mine > 0u ? mine : 1u; nx = cnt > 0u ? cnt : 1u;
}
__device__ __forceinline__ void xcd_barrier(const XcdBarrier& b) {
    asm volatile("s_waitcnt vmcnt(0)" ::: "memory");
    __syncthreads();
    if (threadIdx.x == 0) {
        unsigned* bar = b.bar;
        __builtin_amdgcn_s_waitcnt(0);
        unsigned nloc = b.st[0], nx = b.st[1];
        if (nloc == 0u) { xcd_barrier_complete(bar, b.x, nloc, nx); b.st[0] = nloc; b.st[1] = nx; }
        const unsigned old = xb_add(&bar[XB_XSUB(b.x)], 1u);
        const unsigned gen = old / nloc;
        if (old + 1u == (gen + 1u) * nloc) {
            __builtin_amdgcn_fence(__ATOMIC_RELEASE, "agent");
            asm volatile("s_waitcnt vmcnt(0)" ::: "memory");
            const unsigned og = xb_add(&bar[XB_TOP], 1u);
            const unsigned tg = og / nx;
            if (og + 1u == (tg + 1u) * nx) xb_add(&bar[XB_TOPGEN], 1u);
            else XB_SPIN(xb_ld(&bar[XB_TOPGEN]) == tg, bar);
            __builtin_amdgcn_fence(__ATOMIC_ACQUIRE, "agent");
            xb_add(&bar[XB_XGEN(b.x)], 1u);
            asm volatile("s_waitcnt vmcnt(0)" ::: "memory");
        } else {
            XB_SPIN(xb_ld(&bar[XB_XGEN(b.x)]) == gen, bar);
            __builtin_amdgcn_fence(__ATOMIC_ACQUIRE, "agent");
            asm volatile("s_waitcnt vmcnt(0)" ::: "memory");
        }
    }
    __syncthreads();
}

namespace pg8 {
constexpr int BM = 256, BK = 64, HALF = 128, HTB = HALF * BK * 2, STAGE_BYTES = 8 * HTB, NXCD = 8, WGM = 8;
__host__ __device__ __forceinline__ int lds_byte(int r, int c) { const int st = (r >> 4) * 2 + (c >> 5), rr = r & 15, cc = c & 31, ob = rr * 64 + cc * 2; return st * 1024 + (ob ^ (((ob >> 9) & 1) << 5)); }
__host__ __device__ __forceinline__ void stage_rc(int b, int& R, int& C) { const int st = b / 1024, sb = b % 1024, swz = sb ^ (((sb >> 9) & 1) << 5); R = (st >> 1) * 16 + swz / 64; C = (st & 1) * 32 + (swz % 64) / 2; }
__host__ __device__ __forceinline__ int perm32(int rho) { const int n = rho >> 4, i = rho & 15; return 8 * (i >> 2) + 4 * n + (i & 3); }
struct Unit { int pm, pn; };
struct Gemm { const bf16_t* A; const bf16_t* Bt; int M, N, K; };
struct StaticOrder {
    int nM, nN, nwg, G, c;
    __host__ __device__ void init(int M, int N, int G_, int c_) { nM = M / BM; nN = N / BM; nwg = nM * nN; G = G_; c = c_; }
    __host__ __device__ bool next(int i, Unit& u) const {
        const long L = (long)i * G + c; if (L >= nwg) return false;
        int wgid = (int)L; { const int q = nwg / NXCD, r = nwg % NXCD, xcd = wgid % NXCD, off = wgid / NXCD; wgid = (xcd < r ? xcd * (q + 1) : r * (q + 1) + (xcd - r) * q) + off; }
        const int nig = WGM * nN, gid = wgid / nig, fm = gid * WGM, gsz = (nM - fm) < WGM ? (nM - fm) : WGM;
        u.pm = fm + ((wgid % nig) % gsz); u.pn = (wgid % nig) / gsz; return true;
    }
    __device__ __forceinline__ void a_ready(const Unit&) const {}
    __device__ __forceinline__ void done(const Unit&) const {}
};
template <class Epi, class Sched, bool ALIGN_EPI = false, bool SP2 = false>
__device__ __forceinline__ void gemm_phase(LAS unsigned char* lds, const Gemm g, const Sched& S, const Epi& E) {
    const int tid = threadIdx.x, wid = __builtin_amdgcn_readfirstlane(tid >> 6), lane = tid & 63, wr = wid >> 2, wc = wid & 3, fr = lane & 15, fq = lane >> 4;
    const int K = g.K, nt = K / BK;
    unsigned voffA[2], voffB[2];
#pragma unroll
    for (int i = 0; i < 2; ++i) { int R, C; stage_rc(tid * 16 + i * 8192, R, C); const int Rb = Epi::PERM ? ((R & ~31) + perm32(R & 31)) : R;
        voffA[i] = (unsigned)(R * K + C) * 2u; voffB[i] = (unsigned)(Rb * K + C) * 2u; }
    const size_t kstep = (size_t)(BK * 2);
    const size_t hstep = (size_t)HALF * K * 2;
    const size_t tstep = 2 * hstep;
    const unsigned ldsw = (unsigned)wid * 1024u;
    const int aoff = lds_byte(wr * 64 + fr, fq * 8), boff = lds_byte(wc * 32 + fr, fq * 8);
#define PG8_SA(b, h) (((b) * 2 + (h)) * HTB)
#define PG8_SB(b, h) ((4 + (b) * 2 + (h)) * HTB)
#define PG8_STAGE(bufoff, gbase, voff) do { _Pragma("unroll") for (int _i = 0; _i < 2; ++_i) \
        __builtin_amdgcn_global_load_lds((const unsigned*)((const char*)(gbase) + (voff)[_i]), (LAS unsigned*)(lds + (bufoff) + ldsw + _i * 8192), 16, 0, 0); } while (0)
#define PG8_LDA(dst, b, h) do { _Pragma("unroll") for (int m = 0; m < 4; ++m) _Pragma("unroll") for (int k = 0; k < 2; ++k) dst[m][k] = *(const LAS bf16x8*)(lds + PG8_SA(b, h) + aoff + m * 2048 + k * 1024); } while (0)
#define PG8_LDB(dst, b, h) do { _Pragma("unroll") for (int n = 0; n < 2; ++n) _Pragma("unroll") for (int k = 0; k < 2; ++k) dst[n][k] = *(const LAS bf16x8*)(lds + PG8_SB(b, h) + boff + n * 2048 + k * 1024); } while (0)
#define PG8_MMA(ai, bj, At, Bt) do { __builtin_amdgcn_s_setprio(1); _Pragma("unroll") for (int m = 0; m < 4; ++m) _Pragma("unroll") for (int n = 0; n < 2; ++n) _Pragma("unroll") for (int k = 0; k < 2; ++k) \
        acc[ai][bj][m][n] = __builtin_amdgcn_mfma_f32_16x16x32_bf16(Bt[n][k], At[m][k], acc[ai][bj][m][n], 0, 0, 0); __builtin_amdgcn_s_setprio(0); } while (0)
#define PG8_WAIT_V(n) asm volatile("s_waitcnt vmcnt(" #n ")" ::: "memory")
#define PG8_WAIT_L(n) asm volatile("s_waitcnt lgkmcnt(" #n ")" ::: "memory")
#define PG8_BAR __builtin_amdgcn_s_barrier()
#define PG8_SCHED __builtin_amdgcn_sched_barrier(0)
    Unit cur, nxt; int ui = 0;
    if (!S.next(0, cur)) return;
    f32x4 acc[2][2][4][2];
#pragma unroll
    for (int a = 0; a < 2; ++a)
#pragma unroll
        for (int b = 0; b < 2; ++b)
#pragma unroll
            for (int m = 0; m < 4; ++m)
#pragma unroll
                for (int n = 0; n < 2; ++n) acc[a][b][m][n] = (f32x4){0.f, 0.f, 0.f, 0.f};
    bf16x8 At[4][2], B0[2][2], B1[2][2];
    const char* cA = (const char*)g.A + (size_t)cur.pm * tstep; const char* cB = (const char*)g.Bt + (size_t)cur.pn * tstep;
    S.a_ready(cur);
    if constexpr (SP2) {
        PG8_STAGE(PG8_SB(0, 0), cB, voffB); PG8_STAGE(PG8_SB(0, 1), cB + hstep, voffB); PG8_STAGE(PG8_SA(0, 0), cA, voffA); PG8_STAGE(PG8_SA(0, 1), cA + hstep, voffA);
        if (wr == 1) PG8_BAR;
        PG8_WAIT_V(2); PG8_BAR;
        PG8_STAGE(PG8_SB(1, 0), cB + kstep, voffB); PG8_STAGE(PG8_SA(1, 0), cA + kstep, voffA); PG8_STAGE(PG8_SB(1, 1), cB + hstep + kstep, voffB);
        PG8_WAIT_V(6); PG8_BAR;
    } else {
        PG8_STAGE(PG8_SB(0, 0), cB, voffB); PG8_STAGE(PG8_SA(0, 0), cA, voffA); PG8_STAGE(PG8_SB(0, 1), cB + hstep, voffB); PG8_STAGE(PG8_SA(0, 1), cA + hstep, voffA);
        if (wr == 1) PG8_BAR;
        PG8_WAIT_V(4); PG8_BAR;
        PG8_STAGE(PG8_SB(1, 0), cB + kstep, voffB); PG8_STAGE(PG8_SA(1, 0), cA + kstep, voffA); PG8_STAGE(PG8_SB(1, 1), cB + hstep + kstep, voffB);
        PG8_WAIT_V(6); PG8_BAR;
    }
    for (;;) {
        const bool has_next = S.next(ui + 1, nxt);
        const char* nA = has_next ? (const char*)g.A + (size_t)nxt.pm * tstep : cA; const char* nB = has_next ? (const char*)g.Bt + (size_t)nxt.pn * tstep : cB;
        for (int t = 0; t < nt; t += 2) {
            const bool last = (t == nt - 2);
            const char* a1 = cA + (size_t)(t + 1) * kstep;
            const char* a2 = last ? nA : cA + (size_t)(t + 2) * kstep; const char* b2 = last ? nB : cB + (size_t)(t + 2) * kstep;
            const char* a3 = a2 + kstep; const char* b3 = b2 + kstep;
            if (last && has_next) S.a_ready(nxt);
            if constexpr (SP2) {
            PG8_LDB(B0, 0, 0); PG8_LDB(B1, 0, 1); PG8_SCHED; PG8_LDA(At, 0, 0); PG8_STAGE(PG8_SA(1, 1), a1 + hstep, voffA);
            PG8_WAIT_V(8); PG8_WAIT_L(0); PG8_BAR; PG8_MMA(0, 0, At, B0); PG8_MMA(0, 1, At, B1); PG8_BAR; PG8_SCHED;
            PG8_LDA(At, 0, 1); PG8_STAGE(PG8_SB(0, 0), b2, voffB); PG8_STAGE(PG8_SB(0, 1), b2 + hstep, voffB); PG8_STAGE(PG8_SA(0, 0), a2, voffA);
            PG8_WAIT_V(8); PG8_WAIT_L(0); PG8_BAR; PG8_MMA(1, 0, At, B0); PG8_MMA(1, 1, At, B1); PG8_BAR; PG8_SCHED;
            PG8_LDB(B0, 1, 0); PG8_LDB(B1, 1, 1); PG8_SCHED; PG8_LDA(At, 1, 0); PG8_STAGE(PG8_SA(0, 1), a2 + hstep, voffA);
            PG8_WAIT_V(8); PG8_WAIT_L(0); PG8_BAR; PG8_MMA(0, 0, At, B0); PG8_MMA(0, 1, At, B1); PG8_BAR; PG8_SCHED;
            PG8_LDA(At, 1, 1); PG8_STAGE(PG8_SB(1, 0), b3, voffB); PG8_STAGE(PG8_SB(1, 1), b3 + hstep, voffB); PG8_STAGE(PG8_SA(1, 0), a3, voffA);
            PG8_WAIT_V(8); PG8_WAIT_L(0); PG8_BAR; PG8_MMA(1, 0, At, B0); PG8_MMA(1, 1, At, B1); PG8_BAR; PG8_SCHED;
            } else {
            PG8_LDB(B0, 0, 0); PG8_SCHED; PG8_LDA(At, 0, 0); PG8_STAGE(PG8_SA(1, 1), a1 + hstep, voffA);
            PG8_WAIT_L(8); PG8_BAR; PG8_WAIT_L(0); PG8_MMA(0, 0, At, B0); PG8_BAR; PG8_SCHED;
            PG8_LDB(B1, 0, 1); PG8_STAGE(PG8_SB(0, 0), b2, voffB);
            PG8_BAR; PG8_WAIT_L(0); PG8_MMA(0, 1, At, B1); PG8_BAR;
            PG8_LDA(At, 0, 1); PG8_STAGE(PG8_SA(0, 0), a2, voffA);
            PG8_BAR; PG8_WAIT_L(0); PG8_MMA(1, 0, At, B0); PG8_BAR; PG8_SCHED;
            PG8_STAGE(PG8_SB(0, 1), b2 + hstep, voffB);
            PG8_WAIT_V(6); PG8_BAR; PG8_MMA(1, 1, At, B1); PG8_BAR;
            PG8_LDB(B0, 1, 0); PG8_SCHED; PG8_LDA(At, 1, 0); PG8_STAGE(PG8_SA(0, 1), a2 + hstep, voffA);
            PG8_WAIT_L(8); PG8_BAR; PG8_WAIT_L(0); PG8_MMA(0, 0, At, B0); PG8_BAR; PG8_SCHED;
            PG8_LDB(B1, 1, 1); PG8_STAGE(PG8_SB(1, 0), b3, voffB);
            PG8_BAR; PG8_WAIT_L(0); PG8_MMA(0, 1, At, B1); PG8_BAR;
            PG8_LDA(At, 1, 1); PG8_STAGE(PG8_SA(1, 0), a3, voffA);
            PG8_BAR; PG8_WAIT_L(0); PG8_MMA(1, 0, At, B0); PG8_BAR; PG8_SCHED;
            PG8_STAGE(PG8_SB(1, 1), b3 + hstep, voffB);
            PG8_WAIT_V(6); PG8_BAR; PG8_MMA(1, 1, At, B1); PG8_BAR;
            }
        }
        if constexpr (ALIGN_EPI) { if (wr == 0) PG8_BAR; }
        if constexpr (!Epi::AFTER_DRAIN) { E(acc, cur, wr, wc, fr, fq); S.done(cur); }
        if (!has_next) break;
#pragma unroll
        for (int a = 0; a < 2; ++a)
#pragma unroll
            for (int b = 0; b < 2; ++b)
#pragma unroll
                for (int m = 0; m < 4; ++m)
#pragma unroll
                    for (int n = 0; n < 2; ++n) acc[a][b][m][n] = (f32x4){0.f, 0.f, 0.f, 0.f};
        cur = nxt; cA = nA; cB = nB; ++ui;
        if constexpr (ALIGN_EPI) { if (wr == 1) PG8_BAR; }
    }
    PG8_WAIT_V(0);
    if constexpr (!ALIGN_EPI) { if (wr == 0) PG8_BAR; }
    PG8_BAR;
    if constexpr (Epi::AFTER_DRAIN) { E.fused(acc, cur, wr, wc, fr, fq, lds, wid, lane); S.done(cur); }
#undef PG8_SA
#undef PG8_SB
#undef PG8_STAGE
#undef PG8_LDA
#undef PG8_LDB
#undef PG8_MMA
#undef PG8_WAIT_V
#undef PG8_WAIT_L
#undef PG8_BAR
#undef PG8_SCHED
}
}

template <class F>
__device__ __forceinline__ void skinny32_unit(unsigned char* lds, const bf16_t* A, const bf16_t* Bt, int K, int n0, F&& f) {
    const int tid = threadIdx.x, wid = tid >> 6, lane = tid & 63, r = lane & 31, h = lane >> 5;
    const int kw = K >> 3, k0 = wid * kw;
    f32x16 acc;
#pragma unroll
    for (int i = 0; i < 16; ++i) acc[i] = 0.f;
    const bf16_t* ap = A + (size_t)r * K + k0 + 8 * h; const bf16_t* bp = Bt + (size_t)(n0 + r) * K + k0 + 8 * h;
    int ks = 0;
    for (; ks + 128 <= kw; ks += 128) {
        bf16x8 af[8], bf[8];
#pragma unroll
        for (int i = 0; i < 8; ++i) { af[i] = *(const bf16x8*)(ap + ks + 16 * i); bf[i] = *(const bf16x8*)(bp + ks + 16 * i); }
        __builtin_amdgcn_sched_barrier(0);
#pragma unroll
        for (int i = 0; i < 8; ++i) acc = __builtin_amdgcn_mfma_f32_32x32x16_bf16(af[i], bf[i], acc, 0, 0, 0);
    }
    if (ks < kw) {
        bf16x8 af[6], bf[6];
#pragma unroll
        for (int i = 0; i < 6; ++i) { const int kk = (ks + 16 * i < kw) ? ks + 16 * i : ks; af[i] = *(const bf16x8*)(ap + kk); bf[i] = *(const bf16x8*)(bp + kk); }
        __builtin_amdgcn_sched_barrier(0);
#pragma unroll
        for (int i = 0; i < 6; ++i) if (ks + 16 * i < kw) acc = __builtin_amdgcn_mfma_f32_32x32x16_bf16(af[i], bf[i], acc, 0, 0, 0);
    }
    float* red = (float*)lds;
#pragma unroll
    for (int i = 0; i < 16; ++i) { const int m = (i & 3) + 8 * (i >> 2) + 4 * h; red[wid * 1024 + m * 32 + r] = acc[i]; }
    __syncthreads();
    for (int e = tid; e < 1024; e += 512) { float s = 0.f;
#pragma unroll
        for (int w = 0; w < 8; ++w) s += red[w * 1024 + e];
        f(e >> 5, n0 + (e & 31), s); }
    __syncthreads();
}

__device__ __forceinline__ int map_win(int n) { return n < 1280 ? n : (n < 3328 ? n + 24 : (n < 3352 ? n - 2048 : -1)); }
struct TrDesc { const float* src; bf16_t* dst; int ldsrc, K, n0, k0, mode; };
__device__ __forceinline__ void tr_load(const TrDesc& d, float (&v)[8]) {
    const int tid = threadIdx.x, nn = tid & 63, kk0 = tid >> 6; const int n = d.n0 + nn; const int sc = (d.mode == 1) ? map_win(n) : n;
#pragma unroll
    for (int i = 0; i < 8; ++i) { const int kk = kk0 + 8 * i; v[i] = (sc >= 0) ? d.src[(size_t)(d.k0 + kk) * d.ldsrc + sc] : 0.f; }
}
__device__ __forceinline__ void tr_store(float* t, const TrDesc& d, const float (&v)[8]) {
    const int tid = threadIdx.x, nn = tid & 63, kk0 = tid >> 6;
#pragma unroll
    for (int i = 0; i < 8; ++i) t[nn * 65 + kk0 + 8 * i] = v[i];
    __syncthreads();
    const int r = tid >> 3, ks = (tid & 7) * 8; const float* row = t + r * 65 + ks;
    u32x4 w; w.x = cvt_pk_bf16(row[0], row[1]); w.y = cvt_pk_bf16(row[2], row[3]); w.z = cvt_pk_bf16(row[4], row[5]); w.w = cvt_pk_bf16(row[6], row[7]);
    *(u32x4*)(d.dst + (size_t)(d.n0 + r) * d.K + d.k0 + ks) = w;
    __syncthreads();
}
__device__ __forceinline__ void tr_unit(float* t, const float* src, int ldsrc, bf16_t* dst, int K, int n0, int k0, int mode) {
    const int tid = threadIdx.x, nn = tid & 63, kk0 = tid >> 6;
    const int n = n0 + nn; const int sc = (mode == 1) ? map_win(n) : n;
#pragma unroll
    for (int i = 0; i < 8; ++i) { const int kk = kk0 + 8 * i; t[nn * 65 + kk] = (sc >= 0) ? src[(size_t)(k0 + kk) * ldsrc + sc] : 0.f; }
    __syncthreads();
    const int r = tid >> 3, ks = (tid & 7) * 8; const float* row = t + r * 65 + ks;
    u32x4 w; w.x = cvt_pk_bf16(row[0], row[1]); w.y = cvt_pk_bf16(row[2], row[3]); w.z = cvt_pk_bf16(row[4], row[5]); w.w = cvt_pk_bf16(row[6], row[7]);
    *(u32x4*)(dst + (size_t)(n0 + r) * K + k0 + ks) = w;
    __syncthreads();
}

__device__ __forceinline__ TrDesc tr_desc(const Params& p, int list, int v) {
    unsigned char* ws = p.ws;
    bf16_t* WinT = (bf16_t*)(ws + WS_WIN_T); bf16_t* WoutT = (bf16_t*)(ws + WS_WOUT_T); bf16_t* WupT = (bf16_t*)(ws + WS_WUP_T); bf16_t* WdnT = (bf16_t*)(ws + WS_WDN_T);
    bf16_t* W1T = (bf16_t*)(ws + WS_W1T); bf16_t* W2T = (bf16_t*)(ws + WS_W2T);
    if (list == 0) {
        if (v < 896) return TrDesc{p.w_in, WinT, 3352, 1024, (v % 56) * 64, (v / 56) * 64, 1};
        if (v < 1024) { const int x = v - 896; const int kv = x >> 6, w = x & 63; return TrDesc{kv ? p.w1_v : p.w1_k, W1T + (size_t)kv * 128 * 2048, 128, 2048, (w & 1) * 64, (w >> 1) * 64, 0}; }
        const int x = v - 1024; const int kv = x >> 1, w = x & 1; return TrDesc{kv ? p.w2_v : p.w2_k, W2T + (size_t)kv * 64 * 128, 64, 128, 0, w * 64, 0};
    }
    if (list == 1) {
        if (v < 256) return TrDesc{p.w_out, WoutT, 1024, 1024, (v % 16) * 64, (v / 16) * 64, 0};
        const int x = v - 256; return TrDesc{p.w_up, WupT, 5632, 1024, (x % 88) * 64, (x / 88) * 64, 0};
    }
    return TrDesc{p.w_down, WdnT, 1024, 2816, (v % 16) * 64, (v / 16) * 64, 0};
}
__device__ __forceinline__ void tr_stream(const Params& p, unsigned char* lds, int list, int rank, int nranks) {
    const int n = (list == 0) ? 1028 : (list == 1 ? 1664 : 704);
    float* t = (float*)lds; int u = rank; float cur[8], nxt[8];
    if (u < n) { TrDesc dc = tr_desc(p, list, u); tr_load(dc, cur);
        for (;;) { const int un = u + nranks; const bool more = un < n; TrDesc dn = dc; if (more) { dn = tr_desc(p, list, un); tr_load(dn, nxt); }
            tr_store(t, dc, cur);
            if (!more) break;
#pragma unroll
            for (int i = 0; i < 8; ++i) cur[i] = nxt[i];
            dc = dn; u = un; } }
}
__device__ __forceinline__ int idle_rank(int nwg, int G, int bid, int& nranks) { const int R = nwg % G; if (R == 0) { nranks = G; return bid; } nranks = G - R; return bid >= R ? bid - R : -1; }
__device__ __forceinline__ void phase0(const Params& p, unsigned char* lds) {
    const int tid = threadIdx.x, G = gridDim.x, bid = blockIdx.x;
    unsigned char* ws = p.ws;
    bf16_t* WinT = (bf16_t*)(ws + WS_WIN_T); bf16_t* WoutT = (bf16_t*)(ws + WS_WOUT_T); bf16_t* WupT = (bf16_t*)(ws + WS_WUP_T); bf16_t* WdnT = (bf16_t*)(ws + WS_WDN_T);
    bf16_t* W1T = (bf16_t*)(ws + WS_W1T); bf16_t* W2T = (bf16_t*)(ws + WS_W2T);
    float* t = (float*)lds;
    constexpr int U_ADA = 96, U_WIN = 16 * 56, U_WOUT = 16 * 16, U_WUP = 16 * 88, U_WDN = 44 * 16, U_W1 = 2 * 32 * 2, U_W2 = 2 * 2, U_PE = 16;
    constexpr int B_ADA = 0, B_WIN = B_ADA + U_ADA, B_WOUT = B_WIN + U_WIN, B_WUP = B_WOUT + U_WOUT, B_WDN = B_WUP + U_WUP, B_W1 = B_WDN + U_WDN, B_W2 = B_W1 + U_W1, B_PE = B_W2 + U_W2, B_END = B_PE + U_PE;
    tr_stream(p, lds, 0, bid, G);
    for (int u = bid; u < B_END; u += G) {
        if (u >= B_WIN && u < B_PE) continue;
        if (u < B_WIN) {
            const int ks = u / 12, cc = u % 12; float* st = t;
            for (int i = tid; i < 33 * 128; i += 512) { const int row = i >> 7, k = i & 127; const float c = (row == 0) ? p.c_p[ks * 128 + k] : p.c_s[(size_t)(row - 1) * 1024 + ks * 128 + k]; st[i] = c / (1.0f + __expf(-c)); }
            __syncthreads();
            const int col = cc * 512 + tid; float acc[33];
#pragma unroll
            for (int r = 0; r < 33; ++r) acc[r] = 0.f;
            const float* wp = p.w_ada + (size_t)(ks * 128) * 6144 + col;
            for (int k0 = 0; k0 < 128; k0 += 8) { float wv[8];
#pragma unroll
                for (int u8 = 0; u8 < 8; ++u8) wv[u8] = wp[(size_t)(k0 + u8) * 6144];
                __builtin_amdgcn_sched_barrier(0);
#pragma unroll
                for (int u8 = 0; u8 < 8; ++u8)
#pragma unroll
                    for (int r = 0; r < 33; ++r) acc[r] += st[r * 128 + k0 + u8] * wv[u8]; }
            float* mp = (float*)(ws + WS_MODP) + (size_t)ks * 33 * 6144 + col;
#pragma unroll
            for (int r = 0; r < 33; ++r) mp[(size_t)r * 6144] = acc[r];
            __syncthreads();
        } else if (u < B_WOUT) { const int v = u - B_WIN; tr_unit(t, p.w_in, 3352, WinT, 1024, (v % 56) * 64, (v / 56) * 64, 1); }
        else if (u < B_WUP) { const int v = u - B_WOUT; tr_unit(t, p.w_out, 1024, WoutT, 1024, (v % 16) * 64, (v / 16) * 64, 0); }
        else if (u < B_WDN) { const int v = u - B_WUP; tr_unit(t, p.w_up, 5632, WupT, 1024, (v % 88) * 64, (v / 88) * 64, 0); }
        else if (u < B_W1) { const int v = u - B_WDN; tr_unit(t, p.w_down, 1024, WdnT, 2816, (v % 16) * 64, (v / 16) * 64, 0); }
        else if (u < B_W2) { const int v = u - B_W1; const int kv = v >> 6, w = v & 63; tr_unit(t, kv ? p.w1_v : p.w1_k, 128, W1T + (size_t)kv * 128 * 2048, 2048, (w & 1) * 64, (w >> 1) * 64, 0); }
        else if (u < B_PE) { const int v = u - B_W2; const int kv = v >> 1, w = v & 1; tr_unit(t, kv ? p.w2_v : p.w2_k, 64, W2T + (size_t)kv * 64 * 128, 128, 0, w * 64, 0); }
        else {
            const int kv = (u - B_PE) >> 3, sl = (u - B_PE) & 7; const float* pe = kv ? p.pe_v : p.pe_k; const float* w1 = kv ? p.w1_v : p.w1_k;
            const int hh = tid & 127, q = tid >> 7; float s = 0.f; const int kb = sl * 256 + q * 64;
            for (int k0 = kb; k0 < kb + 64; k0 += 16) { float wv[16], pv[16];
#pragma unroll
                for (int i = 0; i < 16; ++i) { wv[i] = w1[(size_t)(k0 + i) * 128 + hh]; pv[i] = pe[k0 + i]; }
#pragma unroll
                for (int i = 0; i < 16; ++i) s += pv[i] * wv[i]; }
            t[tid] = s; __syncthreads();
            if (tid < 128) ((float*)(ws + WS_PET))[(kv * 8 + sl) * 128 + tid] = t[tid] + t[tid + 128] + t[tid + 256] + t[tid + 384];
            __syncthreads();
        }
    }
    const int gt = bid * 512 + tid, GT = G * 512;
    if (gt < 2) ((unsigned*)(ws + WS_KCM))[gt] = 0u;
    {
        float* rc = (float*)(ws + WS_ROPE); float* rs = rc + (size_t)16385 * 32;
        for (int i = gt; i < 16385 * 32; i += GT) { const int pos = i >> 5, j = i & 31;
            const float inv = powf(10000.0f, -(float)j / 32.0f); const float ang = (float)pos * inv;
            const double a = (double)ang; const double k = rint(a * 0.15915494309189535); const double rr = a - k * 6.283185307179586;
            const float r = (float)rr; rc[i] = cosf(r); rs[i] = sinf(r); }
    }
    {
        float* bl = (float*)(ws + WS_BIAS);
        for (int i = gt; i < 8 * 1025; i += GT) { const int hh = i / 1025, n = i % 1025; int b;
            if (n < 16) b = n; else { const float v = logf((float)n / 16.0f) / 4.1588830833596715f * 16.0f; b = 16 + (int)v; if (b > 31) b = 31; }
            bl[hh * 1032 + n] = p.table[b * 8 + hh]; }
        if (gt < 8) { float m = -1e30f; for (int b = 0; b < 32; ++b) m = fmaxf(m, p.table[b * 8 + gt]); bl[gt * 1032 + 1025] = m; }
    }
    {
        bf16_t* mix = (bf16_t*)(ws + WS_MIX);
#if DBG_SKIP_MIX
        for (int i = gt; i < SEQ * 128; i += GT) { const int row = i >> 7, c8 = i & 127; unsigned hsh = (unsigned)(row * 2654435761u) ^ (unsigned)(c8 * 40503u); hsh ^= hsh >> 13; hsh *= 0x5bd1e995u; hsh ^= hsh >> 15; const unsigned v = 0x3e803e80u + (hsh & 0xffu) * 0x00010001u + ((hsh & 0x100u) << 7) + ((hsh & 0x200u) << 22); *(u32x4*)(mix + (size_t)row * 1024 + c8 * 8) = (u32x4){v, v ^ 0x80000000u, v + 0x00100010u, v ^ 0x00008000u}; }
#endif
        if (DBG_NO_NSA) for (int i = gt; i < (SEQ + NB) * 64; i += GT) { const int row = i >> 6, c8 = i & 63; *(u32x4*)(mix + (size_t)row * 1024 + c8 * 8) = (u32x4){0u, 0u, 0u, 0u}; }
    }
    {
        for (int i = gt; i < NB * DFF; i += GT) { const int b = i / DFF, c = i % DFF; p.out[O_CONV_S + (size_t)b * 2 * DFF + c] = p.st_conv[(size_t)b * 2 * DFF + DFF + c]; }
    }
    {
        const f32x4* src = (const f32x4*)p.st_win; f32x4* dst = (f32x4*)(p.out + O_WIN_S);
        for (int i = gt; i < NB * 511 * 64; i += GT) { const int b = i / (511 * 64), rem = i % (511 * 64); dst[(size_t)b * 512 * 64 + rem] = src[(size_t)b * 512 * 64 + 64 + rem]; }
    }
}

__device__ __forceinline__ void norm_row_store(const float* xr, const float* sA, const float* sB, bf16_t* dst, int lane) {
    f32x4 v[4]; float ss = 0.f;
#pragma unroll
    for (int j = 0; j < 4; ++j) { v[j] = *(const f32x4*)(xr + lane * 4 + 256 * j); ss += v[j][0] * v[j][0] + v[j][1] * v[j][1] + v[j][2] * v[j][2] + v[j][3] * v[j][3]; }
    ss = wave_sum(ss); const float rstd = rsqrtf(ss * (1.0f / 1024.0f) + 1e-6f);
#pragma unroll
    for (int j = 0; j < 4; ++j) { const int c = lane * 4 + 256 * j; const f32x4 a = *(const f32x4*)(sA + c), b = *(const f32x4*)(sB + c);
        u32x2 w; w.x = cvt_pk_bf16(v[j][0] * rstd * a[0] + b[0], v[j][1] * rstd * a[1] + b[1]); w.y = cvt_pk_bf16(v[j][2] * rstd * a[2] + b[2], v[j][3] * rstd * a[3] + b[3]);
        *(u32x2*)(dst + c) = w; }
}
__device__ __forceinline__ void build_mod_partial(const Params& p, float* sA, float* sB, int modrow, const float* gvec) {
    const float* mp = (const float*)(p.ws + WS_MODP);
    for (int c = threadIdx.x; c < 1024; c += 512) { float sc = p.b_ada[1024 + c], sh = p.b_ada[c];
#pragma unroll
        for (int ks = 0; ks < 8; ++ks) { const float* q = mp + ((size_t)ks * 33 + modrow) * 6144; sc += q[1024 + c]; sh += q[c]; }
        sA[c] = gvec[c] * (1.0f + sc); sB[c] = sh; }
}
__device__ __forceinline__ void phase1(const Params& p, unsigned char* lds) {
    const int tid = threadIdx.x, wid = tid >> 6, lane = tid & 63, G = gridDim.x, bid = blockIdx.x;
    float* sA = (float*)lds; float* sB = sA + 1024;
    bf16_t* HN = (bf16_t*)(p.ws + WS_HN);
    bool built = false;
    for (int u = bid; u < 256 + NB; u += G) {
        if (u < 256) {
            if (!built) { build_mod_partial(p, sA, sB, 0, p.g_mix); __syncthreads(); built = true; }
            for (int i = 0; i < 8; ++i) { const int row = u * 64 + wid * 8 + i; norm_row_store(p.x_p + (size_t)row * 1024, sA, sB, HN + (size_t)row * 1024, lane); }
        } else {
            __syncthreads(); const int b = u - 256; build_mod_partial(p, sA, sB, 1 + b, p.g_mix); __syncthreads(); built = false;
            if (wid == 0) norm_row_store(p.x_s + (size_t)b * 1024, sA, sB, HN + (size_t)(SEQ + b) * 1024, lane);
            __syncthreads();
        }
    }
    const float* mp = (const float*)(p.ws + WS_MODP); float* mod = (float*)(p.ws + WS_MOD);
    for (int i = bid * 512 + tid; i < 33 * 6144; i += G * 512) { float s = p.b_ada[i % 6144];
#pragma unroll
        for (int ks = 0; ks < 8; ++ks) s += mp[(size_t)ks * 33 * 6144 + i];
        mod[i] = s; }
}

struct EpiWin {
    static constexpr bool PERM = false, AFTER_DRAIN = false;
    unsigned char* ws; float* out;
    __device__ __forceinline__ void operator()(const f32x4 (&acc)[2][2][4][2], const pg8::Unit& u, int wr, int wc, int fr, int fq) const {
        const int pn = u.pn; const int row0 = u.pm * 256 + wr * 64 + fr; const int cb = wc * 32 + 4 * fq;
        if (pn == 13) {
            if (wc == 0) { float* gts = (float*)(ws + WS_GATES);
#pragma unroll
                for (int ai = 0; ai < 2; ++ai)
#pragma unroll
                    for (int m = 0; m < 4; ++m) { const int row = row0 + ai * 128 + m * 16;
#pragma unroll
                        for (int n = 0; n < 2; ++n) { const int c = n * 16 + 4 * fq; if (c < 24) { const f32x4 v = acc[ai][0][m][n];
                            *(f32x4*)(gts + (size_t)row * 24 + c) = (f32x4){sigmoidf_(v[0]), sigmoidf_(v[1]), sigmoidf_(v[2]), sigmoidf_(v[3])}; } } } }
            return;
        }
        bf16_t* bdst; int ld; float sc = 1.f; float* fdst = nullptr; int rmin = 0;
        if (pn < 2) { bdst = (bf16_t*)(ws + WS_QA) + pn * 256; ld = 512; sc = 0.125f; }
        else if (pn == 2) { bdst = (bf16_t*)(ws + WS_KVC); ld = 256; fdst = out + O_CMP_P; }
        else if (pn == 3) { bdst = (bf16_t*)(ws + WS_KVS); ld = 256; fdst = out + O_SLC_P; }
        else if (pn == 4) { bdst = (bf16_t*)(ws + WS_KVW); ld = 256; fdst = out + O_WIN_P - (size_t)15872 * 256; rmin = 15872; }
        else if (pn < 7) { bdst = (bf16_t*)(ws + WS_QR) + (pn - 5) * 256; ld = 512; }
        else if (pn < 9) { bdst = (bf16_t*)(ws + WS_KR) + (pn - 7) * 256; ld = 512; }
        else if (pn < 11) { bdst = (bf16_t*)(ws + WS_VR) + (pn - 9) * 256; ld = 512; }
        else { bdst = (bf16_t*)(ws + WS_GR) + (pn - 11) * 256; ld = 512; }
#pragma unroll
        for (int ai = 0; ai < 2; ++ai)
#pragma unroll
            for (int m = 0; m < 4; ++m) { const int row = row0 + ai * 128 + m * 16;
#pragma unroll
                for (int bj = 0; bj < 2; ++bj)
#pragma unroll
                    for (int n = 0; n < 2; ++n) { const int c = cb + bj * 128 + n * 16; const f32x4 v = acc[ai][bj][m][n];
                        u32x2 w; w.x = cvt_pk_bf16(v[0] * sc, v[1] * sc); w.y = cvt_pk_bf16(v[2] * sc, v[3] * sc);
                        *(u32x2*)(bdst + (size_t)row * ld + c) = w;
                        if (fdst != nullptr && row >= rmin) *(f32x4*)(fdst + (size_t)row * 256 + c) = v; } }
    }
};
__device__ __forceinline__ void phase2(const Params& p, unsigned char* lds) {
    const int G = gridDim.x, bid = blockIdx.x;
    const bf16_t* HN = (const bf16_t*)(p.ws + WS_HN); const bf16_t* WinT = (const bf16_t*)(p.ws + WS_WIN_T);
    {
        pg8::Gemm g{HN, WinT, SEQ, NZ, 1024}; pg8::StaticOrder S; S.init(SEQ, NZ, G, bid);
        EpiWin E{p.ws, p.out};
        pg8::gemm_phase<EpiWin, pg8::StaticOrder, true, true>((LAS unsigned char*)lds, g, S, E);
    }
    __syncthreads();
    float* zs = (float*)(p.ws + WS_ZS); float* out = p.out;
    for (int u = G - 1 - bid; u < NZ / 32; u += G) {
        skinny32_unit(lds, HN + (size_t)SEQ * 1024, WinT, 1024, u * 32, [&](int m, int n, float v) {
            zs[(size_t)m * NZ + n] = v;
            if (n >= ZC_KVC && n < ZC_KVS) out[O_CMP_S + (size_t)m * 256 + (n - ZC_KVC)] = v;
            else if (n >= ZC_KVS && n < ZC_KVW) out[O_SLC_S + (size_t)m * 256 + (n - ZC_KVS)] = v;
            else if (n >= ZC_KVW && n < ZC_QR) out[O_WIN_S + ((size_t)m * 512 + 511) * 256 + (n - ZC_KVW)] = v;
        });
    }
    { int nr; const int rk = idle_rank((SEQ / 256) * (NZ / 256), G, bid, nr); if (rk >= 0) tr_stream(p, lds, 1, rk, nr); }
}


__device__ __forceinline__ float log2_gamma(int h) { return log1pf(-exp2f(-5.0f - (float)h)) * 1.4426950408889634f; }

__device__ __forceinline__ void ret_uc_unit(const Params& p, unsigned char* lds, int c, int h) {
    int tid_op = threadIdx.x; asm volatile("" : "+v"(tid_op));
    const int tid = tid_op, wid = tid >> 6, lane = tid & 63;
    bf16_t* KT = (bf16_t*)lds;
    bf16_t* VT = KT + 64 * 136;
    const bf16_t* KR = (const bf16_t*)(p.ws + WS_KR); const bf16_t* VR = (const bf16_t*)(p.ws + WS_VR);
    const float* rc = (const float*)(p.ws + WS_ROPE); const float* rs = rc + (size_t)16385 * 32;
    const float l2g = log2_gamma(h);
    {
        const int m = tid & 127, jq = tid >> 7; const int tok = c * 128 + m;
        const bf16x8 x1 = *(const bf16x8*)(KR + (size_t)tok * 512 + h * 64 + jq * 8), x2 = *(const bf16x8*)(KR + (size_t)tok * 512 + h * 64 + 32 + jq * 8);
        const float sc = 0.125f * exp2f(-(float)m * l2g);
#pragma unroll
        for (int e = 0; e < 8; ++e) { const int j = jq * 8 + e; const float cs = rc[(size_t)tok * 32 + j], sn = rs[(size_t)tok * 32 + j];
            const float a = bf2f((bf16_t)x1[e]), b = bf2f((bf16_t)x2[e]);
            KT[j * 136 + m] = f2bf((a * cs - b * sn) * sc); KT[(j + 32) * 136 + m] = f2bf((a * sn + b * cs) * sc); }
        const bf16x8 v0 = *(const bf16x8*)(VR + (size_t)tok * 512 + h * 64 + jq * 16), v1 = *(const bf16x8*)(VR + (size_t)tok * 512 + h * 64 + jq * 16 + 8);
#pragma unroll
        for (int e = 0; e < 8; ++e) { VT[(jq * 16 + e) * 136 + m] = (bf16_t)v0[e]; VT[(jq * 16 + 8 + e) * 136 + m] = (bf16_t)v1[e]; }
    }
    __syncthreads();
    if (wid < 4) {
        const int r = lane & 31, hh = lane >> 5, dk0 = (wid >> 1) * 32, dv0 = (wid & 1) * 32;
        f32x16 acc;
#pragma unroll
        for (int i = 0; i < 16; ++i) acc[i] = 0.f;
#pragma unroll
        for (int ks = 0; ks < 8; ++ks) { const bf16x8 a = *(const bf16x8*)(KT + (dk0 + r) * 136 + ks * 16 + 8 * hh), b = *(const bf16x8*)(VT + (dv0 + r) * 136 + ks * 16 + 8 * hh);
            acc = __builtin_amdgcn_mfma_f32_32x32x16_bf16(a, b, acc, 0, 0, 0); }
        const float g127 = exp2f(127.0f * l2g);
        float* uc = (float*)(p.ws + WS_UC) + ((size_t)c * 8 + h) * 4096;
#pragma unroll
        for (int i = 0; i < 16; ++i) { const int dk = dk0 + (i & 3) + 8 * (i >> 2) + 4 * hh; uc[dk * 64 + dv0 + r] = acc[i] * g127; }
    }
    __syncthreads();
}

__device__ __forceinline__ void ret_scan(const Params& p, int item  ) {
    const int h = item >> 10; const float dc = exp2f(128.0f * log2_gamma(h));
    const f32x4* uc = (const f32x4*)(p.ws + WS_UC) + item; f32x4* sc = (f32x4*)(p.ws + WS_SC) + item;
    f32x4 s = (f32x4){0.f, 0.f, 0.f, 0.f};
    for (int c0 = 0; c0 < 128; c0 += 8) { f32x4 u[8];
#pragma unroll
        for (int i = 0; i < 8; ++i) u[i] = uc[(size_t)(c0 + i) * 8192];
#pragma unroll
        for (int i = 0; i < 8; ++i) { sc[(size_t)(c0 + i) * 8192] = s; s = s * dc + u[i]; } }
    ((f32x4*)(p.out + O_RET_P))[item] = s;
}

__device__ __forceinline__ void ret_sample_wave(const Params& p, int b, int h, int lane) {
    const float* zs = (const float*)(p.ws + WS_ZS) + (size_t)b * NZ;
    const float* rc = (const float*)(p.ws + WS_ROPE) + (size_t)16384 * 32; const float* rs = rc + (size_t)16385 * 32;
    const float gam = exp2f(log2_gamma(h));
    const int j = lane & 31; const float cs = rc[j], sn = rs[j];
    const float q1 = zs[ZC_QR + h * 64 + j], q2 = zs[ZC_QR + h * 64 + 32 + j], k1 = zs[ZC_KR + h * 64 + j], k2 = zs[ZC_KR + h * 64 + 32 + j];
    const float qd = (lane < 32) ? (q1 * cs - q2 * sn) : (q1 * sn + q2 * cs);
    const float kd = ((lane < 32) ? (k1 * cs - k2 * sn) : (k1 * sn + k2 * cs)) * 0.125f;
    const float v = zs[ZC_VR + h * 64 + lane];
    const float* s0 = p.st_ret + ((size_t)b * 8 + h) * 4096; float* so = p.out + O_RET_S + ((size_t)b * 8 + h) * 4096;
    float o = 0.f;
    for (int dk = 0; dk < 64; ++dk) { const float kk = __shfl(kd, dk), qq = __shfl(qd, dk); const float s = gam * s0[dk * 64 + lane] + kk * v; so[dk * 64 + lane] = s; o += qq * s; }
    const float mu = wave_sum(o) * (1.0f / 64.0f); const float d = o - mu; const float var = wave_sum(d * d) * (1.0f / 64.0f);
    const float g = zs[ZC_GR + h * 64 + lane]; const float y = d * rsqrtf(var + 1e-5f) * p.gn_g[h * 64 + lane] * (g / (1.0f + __expf(-g)));
    ((bf16_t*)(p.ws + WS_MIX))[(size_t)(SEQ + b) * 1024 + 512 + h * 64 + lane] = f2bf(y);
}

__device__ __forceinline__ void ret_out_unit(const Params& p, unsigned char* lds, int c, int hp) {
    int tid_op = threadIdx.x; asm volatile("" : "+v"(tid_op));
    const int tid = tid_op, wid = tid >> 6, lane = tid & 63;
    constexpr int HB = 63488;
    const bf16_t* QR = (const bf16_t*)(p.ws + WS_QR); const bf16_t* KR = (const bf16_t*)(p.ws + WS_KR); const bf16_t* VR = (const bf16_t*)(p.ws + WS_VR);
    const float* rc = (const float*)(p.ws + WS_ROPE); const float* rs = rc + (size_t)16385 * 32;
    for (int hl = 0; hl < 2; ++hl) {
        const int h = hp * 2 + hl; const float l2g = log2_gamma(h);
        bf16_t* Qs = (bf16_t*)(lds + hl * HB); bf16_t* Ks = Qs + 128 * 72; bf16_t* VT = Ks + 128 * 72; bf16_t* ST = VT + 64 * 136;
        const int m = tid & 127, jq = tid >> 7; const int tok = c * 128 + m;
        const float qs = exp2f((float)m * l2g), ks_ = 0.125f * exp2f(-(float)m * l2g);
        float cs[8], sn[8];
#pragma unroll
        for (int e = 0; e < 8; ++e) { cs[e] = rc[(size_t)tok * 32 + jq * 8 + e]; sn[e] = rs[(size_t)tok * 32 + jq * 8 + e]; }
        {
            const bf16x8 x1 = *(const bf16x8*)(QR + (size_t)tok * 512 + h * 64 + jq * 8), x2 = *(const bf16x8*)(QR + (size_t)tok * 512 + h * 64 + 32 + jq * 8);
            u32x4 w1, w2; float o1[8], o2[8];
#pragma unroll
            for (int e = 0; e < 8; ++e) { const float a = bf2f((bf16_t)x1[e]), b = bf2f((bf16_t)x2[e]); o1[e] = (a * cs[e] - b * sn[e]) * qs; o2[e] = (a * sn[e] + b * cs[e]) * qs; }
            w1.x = cvt_pk_bf16(o1[0], o1[1]); w1.y = cvt_pk_bf16(o1[2], o1[3]); w1.z = cvt_pk_bf16(o1[4], o1[5]); w1.w = cvt_pk_bf16(o1[6], o1[7]);
            w2.x = cvt_pk_bf16(o2[0], o2[1]); w2.y = cvt_pk_bf16(o2[2], o2[3]); w2.z = cvt_pk_bf16(o2[4], o2[5]); w2.w = cvt_pk_bf16(o2[6], o2[7]);
            *(u32x4*)(Qs + m * 72 + jq * 8) = w1; *(u32x4*)(Qs + m * 72 + 32 + jq * 8) = w2;
        }
        {
            const bf16x8 x1 = *(const bf16x8*)(KR + (size_t)tok * 512 + h * 64 + jq * 8), x2 = *(const bf16x8*)(KR + (size_t)tok * 512 + h * 64 + 32 + jq * 8);
            u32x4 w1, w2; float o1[8], o2[8];
#pragma unroll
            for (int e = 0; e < 8; ++e) { const float a = bf2f((bf16_t)x1[e]), b = bf2f((bf16_t)x2[e]); o1[e] = (a * cs[e] - b * sn[e]) * ks_; o2[e] = (a * sn[e] + b * cs[e]) * ks_; }
            w1.x = cvt_pk_bf16(o1[0], o1[1]); w1.y = cvt_pk_bf16(o1[2], o1[3]); w1.z = cvt_pk_bf16(o1[4], o1[5]); w1.w = cvt_pk_bf16(o1[6], o1[7]);
            w2.x = cvt_pk_bf16(o2[0], o2[1]); w2.y = cvt_pk_bf16(o2[2], o2[3]); w2.z = cvt_pk_bf16(o2[4], o2[5]); w2.w = cvt_pk_bf16(o2[6], o2[7]);
            *(u32x4*)(Ks + m * 72 + jq * 8) = w1; *(u32x4*)(Ks + m * 72 + 32 + jq * 8) = w2;
        }
        {
            const bf16x8 v0 = *(const bf16x8*)(VR + (size_t)tok * 512 + h * 64 + jq * 16), v1 = *(const bf16x8*)(VR + (size_t)tok * 512 + h * 64 + jq * 16 + 8);
#pragma unroll
            for (int e = 0; e < 8; ++e) { VT[(jq * 16 + e) * 136 + m] = (bf16_t)v0[e]; VT[(jq * 16 + 8 + e) * 136 + m] = (bf16_t)v1[e]; }
        }
        {
            const float gam = exp2f(l2g); const float* sc = (const float*)(p.ws + WS_SC) + ((size_t)c * 8 + h) * 4096;
            const int dk = tid >> 3, dvq = tid & 7; const f32x4 a = *(const f32x4*)(sc + dk * 64 + dvq * 8), b = *(const f32x4*)(sc + dk * 64 + dvq * 8 + 4);
#pragma unroll
            for (int e = 0; e < 4; ++e) { ST[(dvq * 8 + e) * 72 + dk] = f2bf(a[e] * gam); ST[(dvq * 8 + 4 + e) * 72 + dk] = f2bf(b[e] * gam); }
        }
    }
    __syncthreads();
    {
        const int hl = wid >> 2, nt = wid & 3, h = hp * 2 + hl, r = lane & 31, hh = lane >> 5;
        const bf16_t* Qs = (const bf16_t*)(lds + hl * HB); const bf16_t* Ks = Qs + 128 * 72; const bf16_t* VT = Ks + 128 * 72; const bf16_t* ST = VT + 64 * 136;
        bf16x8 qf[4];
#pragma unroll
        for (int ks = 0; ks < 4; ++ks) qf[ks] = *(const bf16x8*)(Qs + (nt * 32 + r) * 72 + ks * 16 + 8 * hh);
        f32x16 o0, o1;
#pragma unroll
        for (int i = 0; i < 16; ++i) { o0[i] = 0.f; o1[i] = 0.f; }
#pragma unroll
        for (int ks = 0; ks < 4; ++ks) { const bf16x8 a0 = *(const bf16x8*)(ST + r * 72 + ks * 16 + 8 * hh), a1 = *(const bf16x8*)(ST + (32 + r) * 72 + ks * 16 + 8 * hh);
            o0 = __builtin_amdgcn_mfma_f32_32x32x16_bf16(a0, qf[ks], o0, 0, 0, 0); o1 = __builtin_amdgcn_mfma_f32_32x32x16_bf16(a1, qf[ks], o1, 0, 0, 0); }
        for (int mt = 0; mt <= nt; ++mt) {
            f32x16 at;
#pragma unroll
            for (int i = 0; i < 16; ++i) at[i] = 0.f;
#pragma unroll
            for (int ks = 0; ks < 4; ++ks) { const bf16x8 a = *(const bf16x8*)(Ks + (mt * 32 + r) * 72 + ks * 16 + 8 * hh); at = __builtin_amdgcn_mfma_f32_32x32x16_bf16(a, qf[ks], at, 0, 0, 0); }
            if (mt == nt) {
#pragma unroll
                for (int i = 0; i < 16; ++i) { const int mrow = (i & 3) + 8 * (i >> 2) + 4 * hh; if (mrow > r) at[i] = 0.f; }
            }
#pragma unroll
            for (int s = 0; s < 2; ++s) {
                bf16x8 pb; u32x4 pw;
                pw.x = cvt_pk_bf16(at[8 * s + 0], at[8 * s + 1]); pw.y = cvt_pk_bf16(at[8 * s + 2], at[8 * s + 3]); pw.z = cvt_pk_bf16(at[8 * s + 4], at[8 * s + 5]); pw.w = cvt_pk_bf16(at[8 * s + 6], at[8 * s + 7]);
                pb = __builtin_bit_cast(bf16x8, pw);
                const int mb = mt * 32 + 16 * s + 4 * hh;
                u32x2 l0 = *(const u32x2*)(VT + r * 136 + mb), l1 = *(const u32x2*)(VT + r * 136 + mb + 8), h0 = *(const u32x2*)(VT + (32 + r) * 136 + mb), h1 = *(const u32x2*)(VT + (32 + r) * 136 + mb + 8);
                const bf16x8 a0 = __builtin_bit_cast(bf16x8, (u32x4){l0.x, l0.y, l1.x, l1.y}), a1 = __builtin_bit_cast(bf16x8, (u32x4){h0.x, h0.y, h1.x, h1.y});
                o0 = __builtin_amdgcn_mfma_f32_32x32x16_bf16(a0, pb, o0, 0, 0, 0); o1 = __builtin_amdgcn_mfma_f32_32x32x16_bf16(a1, pb, o1, 0, 0, 0);
            }
        }
        float s = 0.f;
#pragma unroll
        for (int i = 0; i < 16; ++i) s += o0[i] + o1[i];
        s += __shfl_xor(s, 32); const float mu = s * (1.0f / 64.0f);
        float q = 0.f;
#pragma unroll
        for (int i = 0; i < 16; ++i) { const float d0 = o0[i] - mu, d1 = o1[i] - mu; q += d0 * d0 + d1 * d1; }
        q += __shfl_xor(q, 32); const float rstd = rsqrtf(q * (1.0f / 64.0f) + 1e-5f);
        const int tok = c * 128 + nt * 32 + r;
        const bf16_t* GR = (const bf16_t*)(p.ws + WS_GR) + (size_t)tok * 512 + h * 64; bf16_t* mix = (bf16_t*)(p.ws + WS_MIX) + (size_t)tok * 1024 + 512 + h * 64;
#pragma unroll
        for (int t2 = 0; t2 < 2; ++t2)
#pragma unroll
            for (int gq = 0; gq < 4; ++gq) { const int dv = t2 * 32 + 8 * gq + 4 * hh; const u32x2 gw = *(const u32x2*)(GR + dv); const f32x4 gn = *(const f32x4*)(p.gn_g + h * 64 + dv);
                float y[4];
#pragma unroll
                for (int e = 0; e < 4; ++e) { const float ov = t2 ? o1[gq * 4 + e] : o0[gq * 4 + e]; const unsigned gb = (e < 2) ? gw.x : gw.y; const float g = __uint_as_float((e & 1) ? (gb & 0xffff0000u) : (gb << 16));
                    y[e] = (ov - mu) * rstd * gn[e] * (g / (1.0f + __expf(-g))); }
                u32x2 w; w.x = cvt_pk_bf16(y[0], y[1]); w.y = cvt_pk_bf16(y[2], y[3]); *(u32x2*)(mix + dv) = w; }
    }
    __syncthreads();
}


__device__ __forceinline__ float gelu_tanh(float x) { const float u = 0.7978845608028654f * (x + 0.044715f * x * x * x); const float e = __expf(2.0f * u); const float th = 1.0f - 2.0f / (e + 1.0f); return 0.5f * x * (1.0f + th); }

__device__ __forceinline__ void cmp_prompt_unit(const Params& p, unsigned char* lds, int kv, int n0) {
    int tid_op = threadIdx.x; asm volatile("" : "+v"(tid_op));
    const int tid = tid_op, wid = tid >> 6, lane = tid & 63, r = lane & 31, hh = lane >> 5;
    const bf16_t* KVC = (const bf16_t*)(p.ws + WS_KVC); const bf16_t* W1T = (const bf16_t*)(p.ws + WS_W1T) + (size_t)kv * 128 * 2048; const bf16_t* W2T = (const bf16_t*)(p.ws + WS_W2T) + (size_t)kv * 64 * 128;
    float* red = (float*)lds;
    bf16_t* hid = (bf16_t*)(lds + 32768);
    const int ht = wid & 3, kh = wid >> 2;
    const int n = n0 + (r >> 1), g = r & 1;
    const int nn = n < 1023 ? n : 1022;
    f32x16 acc;
#pragma unroll
    for (int i = 0; i < 16; ++i) acc[i] = 0.f;
    const bf16_t* ap = KVC + (size_t)(16 * nn + 16 * kh) * 256 + kv * 128 + g * 64 + 8 * hh;
    const bf16_t* bp = W1T + (size_t)(ht * 32 + r) * 2048 + (16 * kh) * 64 + 8 * hh;
    for (int l0 = 0; l0 < 16; l0 += 4) {
        bf16x8 af[4][4], bfr[4][4];
#pragma unroll
        for (int li = 0; li < 4; ++li)
#pragma unroll
            for (int ks = 0; ks < 4; ++ks) { af[li][ks] = *(const bf16x8*)(ap + (size_t)(l0 + li) * 256 + ks * 16); bfr[li][ks] = *(const bf16x8*)(bp + (l0 + li) * 64 + ks * 16); }
        __builtin_amdgcn_sched_barrier(0);
#pragma unroll
        for (int li = 0; li < 4; ++li)
#pragma unroll
            for (int ks = 0; ks < 4; ++ks) acc = __builtin_amdgcn_mfma_f32_32x32x16_bf16(af[li][ks], bfr[li][ks], acc, 0, 0, 0);
    }
#pragma unroll
    for (int i = 0; i < 16; ++i) { const int m = (i & 3) + 8 * (i >> 2) + 4 * hh; red[wid * 1024 + m * 32 + r] = acc[i]; }
    __syncthreads();
    const float* pet = (const float*)(p.ws + WS_PET) + kv * 1024;
    float ptsum = 0.f;
#pragma unroll
    for (int s8 = 0; s8 < 8; ++s8) ptsum += pet[s8 * 128 + (tid & 127)];
    for (int e = tid; e < 4096; e += 512) { const int m = e >> 7, hc = e & 127; const int t4 = hc >> 5, c = hc & 31;
        const float v = red[t4 * 1024 + m * 32 + c] + red[(4 + t4) * 1024 + m * 32 + c] + ptsum; hid[m * 136 + hc] = f2bf(gelu_tanh(v)); }
    __syncthreads();
    if (wid < 2) {
        f32x16 o;
#pragma unroll
        for (int i = 0; i < 16; ++i) o[i] = 0.f;
        bf16x8 w2f[8];
#pragma unroll
        for (int ks = 0; ks < 8; ++ks) w2f[ks] = *(const bf16x8*)(W2T + (size_t)(wid * 32 + r) * 128 + ks * 16 + 8 * hh);
#pragma unroll
        for (int ks = 0; ks < 8; ++ks) { const bf16x8 a = *(const bf16x8*)(hid + r * 136 + ks * 16 + 8 * hh); o = __builtin_amdgcn_mfma_f32_32x32x16_bf16(a, w2f[ks], o, 0, 0, 0); }
        bf16_t* dst = (bf16_t*)(p.ws + WS_KCMP) + (size_t)kv * 1024 * 128;
#pragma unroll
        for (int i = 0; i < 16; ++i) { const int m = (i & 3) + 8 * (i >> 2) + 4 * hh; const int nb = n0 + (m >> 1), gg = m & 1;
            dst[((size_t)nb * 2 + gg) * 64 + wid * 32 + r] = (nb < 1023) ? f2bf(o[i]) : (bf16_t)0; }
    }
    __syncthreads();
    if (kv == 0 && tid < 32) {
        const int nb = n0 + (tid >> 1), gg = tid & 1; const bf16_t* row = (const bf16_t*)(p.ws + WS_KCMP) + ((size_t)nb * 2 + gg) * 64; float ss = 0.f;
#pragma unroll
        for (int d8 = 0; d8 < 8; ++d8) { const bf16x8 v = *(const volatile bf16x8*)(row + d8 * 8);
#pragma unroll
            for (int e = 0; e < 8; ++e) { const float f = bf2f((bf16_t)v[e]); ss += f * f; } }
        atomicMax((unsigned*)(p.ws + WS_KCM) + gg, __float_as_uint(sqrtf(ss))); }
    __syncthreads();
}

__device__ __forceinline__ void vst_unit(const Params& p, unsigned char* lds, int s0) {
    int tid_op = threadIdx.x; asm volatile("" : "+v"(tid_op));
    const int tid = tid_op; bf16_t* t = (bf16_t*)lds;
    const bf16_t* KVS = (const bf16_t*)(p.ws + WS_KVS); bf16_t* VST = (bf16_t*)(p.ws + WS_VST);
    for (int i = tid; i < 64 * 16; i += 512) { const int s = i >> 4, c8 = i & 15; const bf16x8 v = *(const bf16x8*)(KVS + (size_t)(s0 + s) * 256 + 128 + c8 * 8);
#pragma unroll
        for (int e = 0; e < 8; ++e) t[(c8 * 8 + e) * 72 + s] = (bf16_t)v[e]; }
    __syncthreads();
    for (int i = tid; i < 128 * 8; i += 512) { const int c = i >> 3, s8 = i & 7; *(u32x4*)(VST + (size_t)c * SEQ + s0 + s8 * 8) = *(const u32x4*)(t + c * 72 + s8 * 8); }
    float* nrm = (float*)(lds + 32768);
    if (tid < 128) { const int key = tid & 63, gg = tid >> 6; float ss = 0.f;
#pragma unroll
        for (int d8 = 0; d8 < 8; ++d8) { const bf16x8 v = *(const bf16x8*)(KVS + (size_t)(s0 + key) * 256 + gg * 64 + d8 * 8);
#pragma unroll
            for (int e = 0; e < 8; ++e) { const float f = bf2f((bf16_t)v[e]); ss += f * f; } }
        nrm[tid] = sqrtf(ss); }
    __syncthreads();
    if (tid < 2) { float m = 0.f; for (int k = 0; k < 64; ++k) m = fmaxf(m, nrm[tid * 64 + k]); ((float*)(p.ws + WS_KBM))[tid * 256 + (s0 >> 6)] = m; }
    __syncthreads();
}

__device__ __forceinline__ void win_unit(const Params& p, unsigned char* lds, int g, int qt) {
    int tid_op = threadIdx.x; asm volatile("" : "+v"(tid_op));
    const int tid = tid_op, wid = tid >> 6, lane = tid & 63, r = lane & 31, hh = lane >> 5;
    bf16_t* Ks = (bf16_t*)lds;
    bf16_t* VT = Ks + 128 * 72;
    float* lut = (float*)(lds + 36864);
    const bf16_t* QA = (const bf16_t*)(p.ws + WS_QA); const bf16_t* KVW = (const bf16_t*)(p.ws + WS_KVW);
    const float* bl = (const float*)(p.ws + WS_BIAS);
    const int t0 = qt * 128, hr = wid & 3, head = g * 4 + hr, q0 = t0 + (wid >> 2) * 64;
    for (int i = tid; i < 4 * 768; i += 512) { const int hd = i / 768, d = (i % 768) - 127; lut[i] = (d < 0 || d > 512) ? -1e30f : bl[(g * 4 + hd) * 1032 + d]; }
    bf16x8 qf[2][4];
#pragma unroll
    for (int cb = 0; cb < 2; ++cb)
#pragma unroll
        for (int ks = 0; ks < 4; ++ks) qf[cb][ks] = *(const bf16x8*)(QA + (size_t)(q0 + cb * 32 + r) * 512 + head * 64 + ks * 16 + 8 * hh);
    f32x16 o[2][2]; float mrun[2], lrun[2];
#pragma unroll
    for (int cb = 0; cb < 2; ++cb) { mrun[cb] = -1e30f; lrun[cb] = 0.f;
#pragma unroll
        for (int dt = 0; dt < 2; ++dt)
#pragma unroll
            for (int i = 0; i < 16; ++i) o[cb][dt][i] = 0.f; }
    const float* mylut = lut + hr * 768 + 127;
    const int kstart = (t0 >= 512) ? t0 - 512 : 0;
    for (int kt = kstart; kt < t0 + 128; kt += 128) {
        __syncthreads();
        { const int key = tid >> 2, seg = tid & 3; const bf16_t* src = KVW + (size_t)(kt + key) * 256 + g * 64 + seg * 16;
          *(u32x4*)(Ks + key * 72 + seg * 16) = *(const u32x4*)src; *(u32x4*)(Ks + key * 72 + seg * 16 + 8) = *(const u32x4*)(src + 8); }
        { const int key = tid & 127, dq = tid >> 7; const bf16_t* src = KVW + (size_t)(kt + key) * 256 + 128 + g * 64 + dq * 16; const bf16x8 v0 = *(const bf16x8*)src, v1 = *(const bf16x8*)(src + 8);
#pragma unroll
          for (int e = 0; e < 8; ++e) { VT[(dq * 16 + e) * 136 + key] = (bf16_t)v0[e]; VT[(dq * 16 + 8 + e) * 136 + key] = (bf16_t)v1[e]; } }
        __syncthreads();
        for (int sub = 0; sub < 4; ++sub) {
            const int k0 = kt + sub * 32;
            if (k0 > q0 + 63 || k0 + 31 < q0 - 512) continue;
            bf16x8 kf[4];
#pragma unroll
            for (int ks = 0; ks < 4; ++ks) kf[ks] = *(const bf16x8*)(Ks + (sub * 32 + r) * 72 + ks * 16 + 8 * hh);
#pragma unroll
            for (int cb = 0; cb < 2; ++cb) {
                f32x16 sc;
#pragma unroll
                for (int i = 0; i < 16; ++i) sc[i] = 0.f;
#pragma unroll
                for (int ks = 0; ks < 4; ++ks) sc = __builtin_amdgcn_mfma_f32_32x32x16_bf16(kf[ks], qf[cb][ks], sc, 0, 0, 0);
                const int tq = q0 + cb * 32 + r; float mx = -1e30f;
#pragma unroll
                for (int i = 0; i < 16; ++i) { const int s = k0 + (i & 3) + 8 * (i >> 2) + 4 * hh; sc[i] += mylut[tq - s]; mx = fmaxf(mx, sc[i]); }
                mx = fmaxf(mx, __shfl_xor(mx, 32));
                const float mnew = fmaxf(mrun[cb], mx), alpha = __expf(mrun[cb] - mnew); mrun[cb] = mnew;
                float ps = 0.f;
#pragma unroll
                for (int i = 0; i < 16; ++i) { sc[i] = __expf(sc[i] - mnew); ps += sc[i]; }
                ps += __shfl_xor(ps, 32); lrun[cb] = lrun[cb] * alpha + ps;
#pragma unroll
                for (int dt = 0; dt < 2; ++dt)
#pragma unroll
                    for (int i = 0; i < 16; ++i) o[cb][dt][i] *= alpha;
#pragma unroll
                for (int s2 = 0; s2 < 2; ++s2) {
                    u32x4 pw; pw.x = cvt_pk_bf16(sc[8 * s2 + 0], sc[8 * s2 + 1]); pw.y = cvt_pk_bf16(sc[8 * s2 + 2], sc[8 * s2 + 3]); pw.z = cvt_pk_bf16(sc[8 * s2 + 4], sc[8 * s2 + 5]); pw.w = cvt_pk_bf16(sc[8 * s2 + 6], sc[8 * s2 + 7]);
                    const bf16x8 pb = __builtin_bit_cast(bf16x8, pw); const int mb = sub * 32 + 16 * s2 + 4 * hh;
#pragma unroll
                    for (int dt = 0; dt < 2; ++dt) { const u32x2 l0 = *(const u32x2*)(VT + (dt * 32 + r) * 136 + mb), l1 = *(const u32x2*)(VT + (dt * 32 + r) * 136 + mb + 8);
                        const bf16x8 a = __builtin_bit_cast(bf16x8, (u32x4){l0.x, l0.y, l1.x, l1.y});
                        o[cb][dt] = __builtin_amdgcn_mfma_f32_32x32x16_bf16(a, pb, o[cb][dt], 0, 0, 0); }
                }
            }
        }
    }
    float* OW = (float*)(p.ws + WS_OW); const float* gts = (const float*)(p.ws + WS_GATES);
#pragma unroll
    for (int cb = 0; cb < 2; ++cb) { const int tq = q0 + cb * 32 + r; const float sc = gts[(size_t)tq * 24 + 16 + head] / lrun[cb];
#pragma unroll
        for (int dt = 0; dt < 2; ++dt)
#pragma unroll
            for (int gq = 0; gq < 4; ++gq) { const int d = dt * 32 + 8 * gq + 4 * hh;
                *(f32x4*)(OW + (size_t)tq * 512 + head * 64 + d) = (f32x4){o[cb][dt][gq * 4 + 0] * sc, o[cb][dt][gq * 4 + 1] * sc, o[cb][dt][gq * 4 + 2] * sc, o[cb][dt][gq * 4 + 3] * sc}; } }
    __syncthreads();
}


__device__ __forceinline__ float dpp_quad_xor1(float x) { const int v = __builtin_bit_cast(int, x); return __builtin_bit_cast(float, __builtin_amdgcn_update_dpp(v, v, 0xB1, 0xf, 0xf, false)); }
__device__ __forceinline__ float dpp_quad_xor2(float x) { const int v = __builtin_bit_cast(int, x); return __builtin_bit_cast(float, __builtin_amdgcn_update_dpp(v, v, 0x4E, 0xf, 0xf, false)); }
__device__ __forceinline__ unsigned wave_max_u32(unsigned x) {
    unsigned y;
    y = (unsigned)__builtin_amdgcn_update_dpp((int)x, (int)x, 0x111, 0xf, 0xf, false); x = x > y ? x : y;
    y = (unsigned)__builtin_amdgcn_update_dpp((int)x, (int)x, 0x112, 0xf, 0xf, false); x = x > y ? x : y;
    y = (unsigned)__builtin_amdgcn_update_dpp((int)x, (int)x, 0x114, 0xf, 0xf, false); x = x > y ? x : y;
    y = (unsigned)__builtin_amdgcn_update_dpp((int)x, (int)x, 0x118, 0xf, 0xf, false); x = x > y ? x : y;
    const unsigned a = (unsigned)__builtin_amdgcn_readlane((int)x, 15), b = (unsigned)__builtin_amdgcn_readlane((int)x, 31), c = (unsigned)__builtin_amdgcn_readlane((int)x, 47), d = (unsigned)__builtin_amdgcn_readlane((int)x, 63);
    const unsigned ab = a > b ? a : b, cd = c > d ? c : d; return ab > cd ? ab : cd;
}
__device__ __forceinline__ void nsa_unit(const Params& p, unsigned char* lds, int g, int tt) {
    int tid_op = threadIdx.x; asm volatile("" : "+v"(tid_op));
    const int tid = tid_op, wid = tid >> 6, lane = tid & 63, r = lane & 31, hh = lane >> 5;
    float* imp = (float*)lds;
    bf16_t* Ks = (bf16_t*)(lds + 65536);
    bf16_t* VT = (bf16_t*)(lds + 65536 + 18432);
    float* lut = (float*)(lds + 131072);
    int* idxs = (int*)(lds + 147584) + wid * 128;
    unsigned long long* masks = (unsigned long long*)(lds + 151680);
    unsigned short* act = (unsigned short*)(lds + 153728);
    int* nact_p = (int*)(lds + 154240);
    const bf16_t* QA = (const bf16_t*)(p.ws + WS_QA); const bf16_t* KCMP = (const bf16_t*)(p.ws + WS_KCMP);
    const bf16_t* KVS = (const bf16_t*)(p.ws + WS_KVS); const bf16_t* VST = (const bf16_t*)(p.ws + WS_VST) + (size_t)g * 64 * SEQ;
    const float* bl = (const float*)(p.ws + WS_BIAS); const float* gts = (const float*)(p.ws + WS_GATES);
    const int t0 = tt * 64, tw0 = t0 + wid * 8;
    const int hr = r & 3, ti = r >> 2, tq = tw0 + ti, head = g * 4 + hr;
    for (int i = tid; i < 64 * 256; i += 512) imp[i] = 0.f;
    for (int i = tid; i < 4 * 1025; i += 512) { const int hd = i / 1025, n = i % 1025; lut[hd * 1032 + n] = bl[(g * 4 + hd) * 1032 + n]; }
    bf16x8 qf[4];
#pragma unroll
    for (int ks = 0; ks < 4; ++ks) qf[ks] = *(const bf16x8*)(QA + (size_t)tq * 512 + head * 64 + ks * 16 + 8 * hh);
    const int nkeys = (t0 + 63 >= 31) ? ((t0 + 63 - 31) >> 4) + 1 : 0;
    const float* mylut = lut + hr * 1032;
    float mshc;
    { float ss = 0.f;
#pragma unroll
      for (int ks = 0; ks < 4; ++ks)
#pragma unroll
          for (int e = 0; e < 8; ++e) { const float f = bf2f((bf16_t)qf[ks][e]); ss += f * f; }
      ss += __shfl_xor(ss, 32);
      const float kcm = __uint_as_float(((const unsigned*)(p.ws + WS_KCM))[g]);
      mshc = sqrtf(ss) * kcm * 1.0001f + 1e-3f; }
    __syncthreads();
    mshc += bl[(g * 4 + hr) * 1032 + 1025];
    const float bfar = mylut[1024] - mshc;
    float lrun = 0.f;
    for (int rep1 = 0; rep1 < (PROBE_DUP == 42 ? 2 : 1); ++rep1) { lrun = 0.f;
    for (int kt = 0; kt < nkeys; kt += 128) {
        __syncthreads();
        { const int key = tid >> 2, seg = tid & 3; const bf16_t* src = KCMP + ((size_t)(kt + key) * 2 + g) * 64 + seg * 16;
          *(u32x4*)(Ks + key * 72 + seg * 16) = *(const u32x4*)src; *(u32x4*)(Ks + key * 72 + seg * 16 + 8) = *(const u32x4*)(src + 8); }
        __syncthreads();
        for (int sub = 0; sub < 4; ++sub) {
            const int nb = kt + sub * 32; if (nb >= nkeys) break;
            f32x16 sc;
#pragma unroll
            for (int i = 0; i < 16; ++i) sc[i] = 0.f;
#pragma unroll
            for (int ks = 0; ks < 4; ++ks) { const bf16x8 kf = *(const bf16x8*)(Ks + (sub * 32 + r) * 72 + ks * 16 + 8 * hh); sc = __builtin_amdgcn_mfma_f32_32x32x16_bf16(kf, qf[ks], sc, 0, 0, 0); }
            float ps = 0.f;
            if (tw0 - (16 * (nb + 31) + 31) >= 1024) {
#pragma unroll
                for (int i = 0; i < 16; ++i) ps += __expf(fmaxf(sc[i] + bfar, -80.f));
            } else {
#pragma unroll
                for (int i = 0; i < 16; ++i) { const int n = nb + (i & 3) + 8 * (i >> 2) + 4 * hh; const int dc = tq - (16 * n + 31); const int di = dc < 0 ? 0 : (dc < 1024 ? dc : 1024);
                    const float pe = __expf(fmaxf(sc[i] + mylut[di] - mshc, -80.f)); ps += (dc >= 0) ? pe : 0.f; }
            }
            lrun += ps;
        }
    }
    }
    lrun += __shfl_xor(lrun, 32);
    const float inv_l = (tq >= 31) ? 1.0f / lrun : 0.f;
    f32x16 oc0, oc1;
#pragma unroll
    for (int i = 0; i < 16; ++i) { oc0[i] = 0.f; oc1[i] = 0.f; }
    float carry = 0.f;
    for (int kt = 0; kt < nkeys; kt += 128) {
        __syncthreads();
        { const int key = tid >> 2, seg = tid & 3; const bf16_t* src = KCMP + ((size_t)(kt + key) * 2 + g) * 64 + seg * 16;
          *(u32x4*)(Ks + key * 72 + seg * 16) = *(const u32x4*)src; *(u32x4*)(Ks + key * 72 + seg * 16 + 8) = *(const u32x4*)(src + 8); }
        { const int key = tid & 127, dq = tid >> 7; const bf16_t* src = KCMP + (size_t)1024 * 128 + ((size_t)(kt + key) * 2 + g) * 64 + dq * 16; const bf16x8 v0 = *(const bf16x8*)src, v1 = *(const bf16x8*)(src + 8);
#pragma unroll
          for (int e = 0; e < 8; ++e) { VT[(dq * 16 + e) * 136 + key] = (bf16_t)v0[e]; VT[(dq * 16 + 8 + e) * 136 + key] = (bf16_t)v1[e]; } }
        __syncthreads();
        for (int sub = 0; sub < 4; ++sub) {
            const int nb = kt + sub * 32; if (nb >= nkeys) break;
            f32x16 sc;
#pragma unroll
            for (int i = 0; i < 16; ++i) sc[i] = 0.f;
#pragma unroll
            for (int ks = 0; ks < 4; ++ks) { const bf16x8 kf = *(const bf16x8*)(Ks + (sub * 32 + r) * 72 + ks * 16 + 8 * hh); sc = __builtin_amdgcn_mfma_f32_32x32x16_bf16(kf, qf[ks], sc, 0, 0, 0); }
            if (tw0 - (16 * (nb + 31) + 31) >= 1024) {
#pragma unroll
                for (int i = 0; i < 16; ++i) sc[i] = __expf(fmaxf(sc[i] + bfar, -80.f)) * inv_l;
            } else {
#pragma unroll
                for (int i = 0; i < 16; ++i) { const int n = nb + (i & 3) + 8 * (i >> 2) + 4 * hh; const int dc = tq - (16 * n + 31); const int di = dc < 0 ? 0 : (dc < 1024 ? dc : 1024);
                    const float pe = __expf(fmaxf(sc[i] + mylut[di] - mshc, -80.f)) * inv_l; sc[i] = (dc >= 0) ? pe : 0.f; }
            }
#pragma unroll
            for (int s2 = 0; s2 < 2; ++s2) {
                u32x4 pw; pw.x = cvt_pk_bf16(sc[8 * s2 + 0], sc[8 * s2 + 1]); pw.y = cvt_pk_bf16(sc[8 * s2 + 2], sc[8 * s2 + 3]); pw.z = cvt_pk_bf16(sc[8 * s2 + 4], sc[8 * s2 + 5]); pw.w = cvt_pk_bf16(sc[8 * s2 + 6], sc[8 * s2 + 7]);
                const bf16x8 pb = __builtin_bit_cast(bf16x8, pw); const int mb = sub * 32 + 16 * s2 + 4 * hh;
                { const u32x2 l0 = *(const u32x2*)(VT + r * 136 + mb), l1 = *(const u32x2*)(VT + r * 136 + mb + 8); const bf16x8 a = __builtin_bit_cast(bf16x8, (u32x4){l0.x, l0.y, l1.x, l1.y}); oc0 = __builtin_amdgcn_mfma_f32_32x32x16_bf16(a, pb, oc0, 0, 0, 0); }
                { const u32x2 l0 = *(const u32x2*)(VT + (32 + r) * 136 + mb), l1 = *(const u32x2*)(VT + (32 + r) * 136 + mb + 8); const bf16x8 a = __builtin_bit_cast(bf16x8, (u32x4){l0.x, l0.y, l1.x, l1.y}); oc1 = __builtin_amdgcn_mfma_f32_32x32x16_bf16(a, pb, oc1, 0, 0, 0); }
            }
            float gs[4], ls[4], px[4];
#pragma unroll
            for (int q = 0; q < 4; ++q) { gs[q] = (sc[4 * q] + sc[4 * q + 1]) + (sc[4 * q + 2] + sc[4 * q + 3]); ls[q] = sc[4 * q + 3];
                gs[q] += dpp_quad_xor1(gs[q]); gs[q] += dpp_quad_xor2(gs[q]); ls[q] += dpp_quad_xor1(ls[q]); ls[q] += dpp_quad_xor2(ls[q]); px[q] = __shfl_xor(ls[q], 32); }
            if (hr == 0) {
#pragma unroll
                for (int q = 0; q < 4; ++q) { const float prev = hh ? px[q] : (q > 0 ? px[q > 0 ? q - 1 : 0] : carry); const int j = (nb >> 2) + 2 * q + hh;
                    imp[(wid * 8 + ti) * 256 + j] = gs[q] + prev; }
            }
            carry = px[3];
        }
    }
    {
        const int nsub = (nkeys + 31) >> 5, jn = nsub * 8;
        if (hr == 0 && hh == 0 && jn < 256 && nkeys > 0) imp[(wid * 8 + ti) * 256 + jn] = carry;
    }
    {
        float* ocb = (float*)(p.ws + WS_OC) + (size_t)tq * 512 + head * 64; const float gc = gts[(size_t)tq * 24 + head];
#pragma unroll
        for (int i = 0; i < 16; ++i) { const int d = (i & 3) + 8 * (i >> 2) + 4 * hh; ocb[d] = gc * oc0[i]; ocb[32 + d] = gc * oc1[i]; }
    }
    __builtin_amdgcn_wave_barrier(); asm volatile("s_waitcnt lgkmcnt(0)" ::: "memory");
    for (int rep2 = 0; rep2 < (PROBE_DUP == 43 ? 2 : 1); ++rep2)
    for (int i = 0; i < 8; ++i) {
        const int tk = tw0 + i, cur = tk >> 6; unsigned key[4];
#pragma unroll
        for (int k = 0; k < 4; ++k) { const int j = lane + 64 * k; const bool forced = (j == 0) || (j == cur) || (j == cur - 1);
            const float scv = forced ? 1e4f : imp[(wid * 8 + i) * 256 + j];
            key[k] = (j <= cur) ? __float_as_uint(scv) + 1u : 0u; }
        for (int sel = 0; sel < 16; ++sel) {
            unsigned best = key[0] > key[1] ? key[0] : key[1]; const unsigned b2 = key[2] > key[3] ? key[2] : key[3]; best = best > b2 ? best : b2;
            best = wave_max_u32(best);
            int jsel = -1;
            if (best != 0u) {
                const unsigned long long m0 = __ballot(key[0] == best), m1 = __ballot(key[1] == best), m2 = __ballot(key[2] == best), m3 = __ballot(key[3] == best);
                if (m0) jsel = __ffsll((long long)m0) - 1; else if (m1) jsel = 64 + __ffsll((long long)m1) - 1; else if (m2) jsel = 128 + __ffsll((long long)m2) - 1; else jsel = 192 + __ffsll((long long)m3) - 1;
                const int kl = jsel >> 6, ll = jsel & 63;
#pragma unroll
                for (int k = 0; k < 4; ++k) if (k == kl && lane == ll) key[k] = 0u;
            }
            if (lane == 0) idxs[i * 16 + sel] = jsel;
        }
    }
    __builtin_amdgcn_wave_barrier(); asm volatile("s_waitcnt lgkmcnt(0)" ::: "memory");
    float* Mst = (float*)(lds + 155392);
    const int c16 = lane & 15, quad = lane >> 4;
    f32x4 osA[4], osB[4]; float laccA = 0.f, laccB = 0.f;
    for (int rep3 = 0; rep3 < (PROBE_DUP == 44 ? 2 : 1); ++rep3) {
    {
        const float* kbm = (const float*)(p.ws + WS_KBM) + g * 256;
        for (int i = 0; i < 8; ++i) { const int tk = tw0 + i;
            const int jj = (lane < 16) ? idxs[i * 16 + lane] : -1; float km = (jj >= 0) ? kbm[jj] : 0.f;
#pragma unroll
            for (int o = 8; o >= 1; o >>= 1) km = fmaxf(km, __shfl_xor(km, o));
            km = __shfl(km, 0);
            const bf16_t* qp = QA + tk * 512 + g * 256 + lane * 4; const u32x2 qw = *(const u32x2*)qp;
            const float q0 = __uint_as_float(qw.x << 16), q1 = __uint_as_float(qw.x & 0xffff0000u), q2 = __uint_as_float(qw.y << 16), q3 = __uint_as_float(qw.y & 0xffff0000u);
            float ss = q0 * q0 + q1 * q1 + q2 * q2 + q3 * q3;
#pragma unroll
            for (int o = 8; o >= 1; o >>= 1) ss += __shfl_xor(ss, o);
            if ((lane & 15) == 0) Mst[(wid * 8 + i) * 4 + (lane >> 4)] = sqrtf(ss) * km * 1.0001f + 1e-3f; }
    }
    __syncthreads();
    for (int i = tid; i < 256; i += 512) masks[i] = 0ull;
    if (tid < 256) { float bm = -1e30f; const int hd = tid >> 6; for (int n = tid & 63; n <= 1024; n += 64) bm = fmaxf(bm, lut[hd * 1032 + n]);
#pragma unroll
        for (int o = 32; o >= 1; o >>= 1) bm = fmaxf(bm, __shfl_xor(bm, o));
        if ((tid & 63) == 0) ((float*)(lds + 154240 + 64))[hd] = bm; }
    __syncthreads();
    { const int* ia = (const int*)(lds + 147584); const float* bmh = (const float*)(lds + 154240 + 64);
      for (int e = tid; e < 1024; e += 512) { const int j = ia[e]; if (j >= 0) atomicOr(&masks[j], 1ull << (e >> 4)); }
      if (tid < 256) Mst[tid] += bmh[tid & 3]; }
    __syncthreads();
    if (wid == 0) { int run = 0;
        for (int base = 0; base < 256; base += 64) { const int j = base + lane; const bool nz = masks[j] != 0ull; const unsigned long long bal = __ballot(nz);
            const int pos = run + __popcll(bal & ((1ull << lane) - 1ull)); if (nz) act[pos] = (unsigned short)j; run += __popcll(bal); }
        if (lane == 0) *nact_p = run; }
    __syncthreads();
    {
        const int nact = *nact_p;
        const int slot = c16 >> 2, hsl = c16 & 3, swz = c16 & 7;
        const float* slut = lut + hsl * 1032;
        bf16x8 qA[2], qB[2];
        { const int qo = (g * 4 + hsl) * 64 + quad * 8;
          qA[0] = *(const bf16x8*)(QA + (tw0 + slot) * 512 + qo); qA[1] = *(const bf16x8*)(QA + (tw0 + slot) * 512 + qo + 32);
          qB[0] = *(const bf16x8*)(QA + (tw0 + 4 + slot) * 512 + qo); qB[1] = *(const bf16x8*)(QA + (tw0 + 4 + slot) * 512 + qo + 32); }
        const float mshA = Mst[(wid * 8 + slot) * 4 + hsl], mshB = Mst[(wid * 8 + 4 + slot) * 4 + hsl];
        laccA = 0.f; laccB = 0.f;
#pragma unroll
        for (int dt = 0; dt < 4; ++dt) { osA[dt] = (f32x4){0.f, 0.f, 0.f, 0.f}; osB[dt] = (f32x4){0.f, 0.f, 0.f, 0.f}; }
        const int drow = tid >> 3, dseg = (tid & 7) ^ (drow & 7);
#define SEL_DMA(set, pi) do { _Pragma("unroll") for (int _b = 0; _b < 2; ++_b) { const int _a = 2 * (pi) + _b; const int _j = act[_a < nact ? _a : nact - 1]; \
            LAS unsigned char* _k = (LAS unsigned char*)lds + ((set) * 2 + _b) * 16384 + __builtin_amdgcn_readfirstlane(wid) * 1024; \
            __builtin_amdgcn_global_load_lds((const unsigned*)(KVS + (64 * _j + drow) * 256 + g * 64 + dseg * 8), (LAS unsigned*)_k, 16, 0, 0); \
            __builtin_amdgcn_global_load_lds((const unsigned*)(VST + drow * SEQ + 64 * _j + dseg * 8), (LAS unsigned*)(_k + 8192), 16, 0, 0); } } while (0)
#define SEL_VISIT(QF, MSH, LACC, OS, TB, NIB) do { \
            const bool cval = ((NIB) >> slot) & 1; const int tkl = (TB) + slot; \
            bf16x8 kf[4][2]; u32x2 vv[2][4][2]; \
            _Pragma("unroll") for (int mt = 0; mt < 4; ++mt) { const unsigned char* kr = Kb + (mt * 16 + c16) * 128; kf[mt][0] = *(const bf16x8*)(kr + ((quad ^ swz) * 16)); kf[mt][1] = *(const bf16x8*)(kr + (((4 + quad) ^ swz) * 16)); } \
            __builtin_amdgcn_sched_barrier(0); \
            f32x4 sv[4]; \
            _Pragma("unroll") for (int mt = 0; mt < 4; ++mt) { sv[mt] = __builtin_amdgcn_mfma_f32_16x16x32_bf16(kf[mt][0], QF[0], (f32x4){0.f, 0.f, 0.f, 0.f}, 0, 0, 0); \
                sv[mt] = __builtin_amdgcn_mfma_f32_16x16x32_bf16(kf[mt][1], QF[1], sv[mt], 0, 0, 0); } \
            __builtin_amdgcn_sched_barrier(0); \
            _Pragma("unroll") for (int kk = 0; kk < 2; ++kk) _Pragma("unroll") for (int dt = 0; dt < 4; ++dt) { const unsigned char* vr = Vb + (dt * 16 + c16) * 128; \
                vv[kk][dt][0] = *(const u32x2*)(vr + (((4 * kk + (quad >> 1)) ^ swz) * 16) + 8 * (quad & 1)); vv[kk][dt][1] = *(const u32x2*)(vr + (((4 * kk + 2 + (quad >> 1)) ^ swz) * 16) + 8 * (quad & 1)); } \
            __builtin_amdgcn_sched_barrier(0); \
            float ps = 0.f; \
            if ((TB) - 64 * j - 63 >= 1024) { const float bc = slut[1024] - (MSH); \
                _Pragma("unroll") for (int mt = 0; mt < 4; ++mt) _Pragma("unroll") for (int e = 0; e < 4; ++e) { const float pe = __expf(fmaxf(sv[mt][e] + bc, -80.f)); sv[mt][e] = cval ? pe : 0.f; ps += sv[mt][e]; } \
            } else { const int dbase = tkl - 64 * j - 4 * quad; \
                _Pragma("unroll") for (int mt = 0; mt < 4; ++mt) { float bb[4]; \
                    _Pragma("unroll") for (int e = 0; e < 4; ++e) { int ds = dbase - mt * 16 - e; ds = ds < 0 ? 0 : (ds > 1024 ? 1024 : ds); bb[e] = slut[ds]; } \
                    _Pragma("unroll") for (int e = 0; e < 4; ++e) { const int ds = dbase - mt * 16 - e; const float pe = __expf(fmaxf(sv[mt][e] + bb[e] - (MSH), -80.f)); sv[mt][e] = (cval && ds >= 0) ? pe : 0.f; ps += sv[mt][e]; } } } \
            LACC += ps; \
            _Pragma("unroll") for (int kk = 0; kk < 2; ++kk) { \
                u32x4 pw; pw.x = cvt_pk_bf16(sv[2 * kk][0], sv[2 * kk][1]); pw.y = cvt_pk_bf16(sv[2 * kk][2], sv[2 * kk][3]); pw.z = cvt_pk_bf16(sv[2 * kk + 1][0], sv[2 * kk + 1][1]); pw.w = cvt_pk_bf16(sv[2 * kk + 1][2], sv[2 * kk + 1][3]); \
                const bf16x8 pa = __builtin_bit_cast(bf16x8, pw); \
                _Pragma("unroll") for (int dt = 0; dt < 4; ++dt) { const u32x2 l0 = vv[kk][dt][0], l1 = vv[kk][dt][1]; const bf16x8 vb = __builtin_bit_cast(bf16x8, (u32x4){l0.x, l0.y, l1.x, l1.y}); \
                    OS[dt] = __builtin_amdgcn_mfma_f32_16x16x32_bf16(pa, vb, OS[dt], 0, 0, 0); } } \
        } while (0)
        const int npair = (nact + 1) >> 1;
        SEL_DMA(0, 0); if (npair > 1) SEL_DMA(1, 1); if (npair > 2) SEL_DMA(2, 2); if (npair > 3) SEL_DMA(3, 3);
        for (int it = 0; it < npair; it += 2) {
            { const int younger = (it == 0) ? npair - 2 : 0; if (younger >= 2) asm volatile("s_waitcnt vmcnt(8)" ::: "memory"); else if (younger == 1) asm volatile("s_waitcnt vmcnt(4)" ::: "memory"); else asm volatile("s_waitcnt vmcnt(0)" ::: "memory"); }
            asm volatile("" ::: "memory"); __builtin_amdgcn_s_barrier(); asm volatile("" ::: "memory");
            if (it >= 2) { if (it + 2 < npair) SEL_DMA((it + 2) & 3, it + 2); if (it + 3 < npair) SEL_DMA((it + 3) & 3, it + 3); }
            for (int b = 0; b < 4; ++b) {
                const int a = 2 * it + b; if (a >= nact) break;
                const int j = act[a]; const unsigned long long mk = masks[j];
                const unsigned nib8 = (unsigned)__builtin_amdgcn_readfirstlane((int)(unsigned)(mk >> (wid * 8))) & 0xffu;
                if (nib8 == 0u) continue;
                const unsigned char* Kb = lds + ((((it + (b >> 1)) & 3) * 2) + (b & 1)) * 16384; const unsigned char* Vb = Kb + 8192;
                if (nib8 & 0xfu) SEL_VISIT(qA, mshA, laccA, osA, tw0, nib8 & 0xfu);
                if (nib8 >> 4) SEL_VISIT(qB, mshB, laccB, osB, tw0 + 4, nib8 >> 4);
            }
        }
#undef SEL_DMA
#undef SEL_VISIT
    }
    }
    __syncthreads();
    {
        float* fin = imp + wid * 8 * 256;
        laccA += __shfl_xor(laccA, 16); laccA += __shfl_xor(laccA, 32); laccB += __shfl_xor(laccB, 16); laccB += __shfl_xor(laccB, 32);
        float wA[4], wB[4];
#pragma unroll
        for (int hq = 0; hq < 4; ++hq) { const float la = __shfl(laccA, quad * 4 + hq), lb = __shfl(laccB, quad * 4 + hq);
            wA[hq] = gts[(size_t)(tw0 + quad) * 24 + 8 + g * 4 + hq] / la; wB[hq] = gts[(size_t)(tw0 + 4 + quad) * 24 + 8 + g * 4 + hq] / lb; }
#pragma unroll
        for (int dt = 0; dt < 4; ++dt)
#pragma unroll
            for (int hq = 0; hq < 4; ++hq) { fin[quad * 256 + hq * 64 + dt * 16 + c16] = wA[hq] * osA[dt][hq]; fin[(4 + quad) * 256 + hq * 64 + dt * 16 + c16] = wB[hq] * osB[dt][hq]; }
    }
    float* oc = imp + wid * 8 * 256;
    __builtin_amdgcn_wave_barrier(); asm volatile("s_waitcnt lgkmcnt(0)" ::: "memory");
    {
        const float* OW = (const float*)(p.ws + WS_OW); bf16_t* mix = (bf16_t*)(p.ws + WS_MIX);
        const float* OCb = (const float*)(p.ws + WS_OC);
        for (int i = 0; i < 8; ++i) { const int tk = tw0 + i; const f32x4 a = *(const f32x4*)(oc + i * 256 + lane * 4), b = *(const f32x4*)(OW + (size_t)tk * 512 + g * 256 + lane * 4) + *(const f32x4*)(OCb + (size_t)tk * 512 + g * 256 + lane * 4);
            u32x2 w; w.x = cvt_pk_bf16(a[0] + b[0], a[1] + b[1]); w.y = cvt_pk_bf16(a[2] + b[2], a[3] + b[3]); *(u32x2*)(mix + (size_t)tk * 1024 + g * 256 + lane * 4) = w; }
    }
    __syncthreads();
}


template <int K0, int K1> __device__ __forceinline__ void cmp_sample_issue(const Params& p, int u, f32x4 (&v)[33]) {
    int tid = threadIdx.x; asm volatile("" : "+v"(tid)); const int b = u >> 6, kv = (u >> 5) & 1, grp = u & 31; const int p0 = grp * 512;
    const int* pt = p.page_tab + b * 128 + (p0 >> 7);
    int pg[5];
#pragma unroll
    for (int i = 0; i < 5; ++i) pg[i] = pt[(p0 >> 7) + i < 128 ? i : 0];
#pragma unroll
    for (int k = K0; k < K1; ++k) { const int idx = k * 512 + tid, q = idx >> 5, f4 = idx & 31, pos = p0 + q; const int pi = q >> 7;
        const int page = pi == 0 ? pg[0] : (pi == 1 ? pg[1] : (pi == 2 ? pg[2] : (pi == 3 ? pg[3] : pg[4])));
        if (pos < PAST) v[k] = __builtin_nontemporal_load((const f32x4*)(p.cache_c + (((size_t)page * 128 + (pos & 127)) * 2 + kv) * 128 + f4 * 4));
        else v[k] = (f32x4){0.f, 0.f, 0.f, 0.f}; }
}
constexpr int CS_NPF = 26;
__device__ __forceinline__ void cmp_sample_stream(const Params& p, unsigned char* lds) {
    int tid_op = threadIdx.x; asm volatile("" : "+v"(tid_op));
    const int tid = tid_op, wid = tid >> 6, lane = tid & 63, r = lane & 31, hh = lane >> 5, G = gridDim.x;
    bf16_t* X = (bf16_t*)lds;
    int u = blockIdx.x; if (u >= 2048) return;
    f32x4 v[33];
    cmp_sample_issue<0, CS_NPF>(p, u, v);
    for (;;) {
        const int b = u >> 6, kv = (u >> 5) & 1, grp = u & 31; const int un = u + G; const bool more = un < 2048;
        const bf16_t* W1T = (const bf16_t*)(p.ws + WS_W1T) + (size_t)kv * 128 * 2048; const bf16_t* W2T = (const bf16_t*)(p.ws + WS_W2T) + (size_t)kv * 64 * 128;
        cmp_sample_issue<CS_NPF, 33>(p, u, v);
        { int tid_o = tid; asm volatile("" : "+v"(tid_o));
#pragma unroll
          for (int k = 0; k < 33; ++k) { const int idx = k * 512 + tid_o, q = idx >> 5, f4 = idx & 31;
            u32x2 w; w.x = cvt_pk_bf16(v[k][0], v[k][1]); w.y = cvt_pk_bf16(v[k][2], v[k][3]); *(u32x2*)(X + ((q & 15) * 33 + (q >> 4)) * 136 + f4 * 4) = w; } }
        const float* pet = (const float*)(p.ws + WS_PET) + kv * 1024; float ptsum = 0.f;
#pragma unroll
        for (int s8 = 0; s8 < 8; ++s8) ptsum += pet[s8 * 128 + (tid & 127)];
        const int rt2 = wid & 1, et = (wid >> 1) & 1;
        bf16_t* W2s = (bf16_t*)(lds + 143616);
        { const u32x4 wa = *(const u32x4*)(W2T + tid * 16), wb = *(const u32x4*)(W2T + tid * 16 + 8); *(u32x4*)(W2s + tid * 16) = wa; *(u32x4*)(W2s + tid * 16 + 8) = wb; }
        __syncthreads();
        const int ct = wid & 3, kh = wid >> 2; const int nl0 = (r >> 1), g = r & 1;
        f32x16 acc0, acc1;
#pragma unroll
        for (int i = 0; i < 16; ++i) { acc0[i] = 0.f; acc1[i] = 0.f; }
        const bf16_t* bp = W1T + (size_t)(ct * 32 + r) * 2048 + (16 * kh) * 64 + 8 * hh;
#define CS_BATCH(L0, NL, ISSUE) do { bf16x8 bf[NL][4]; \
            _Pragma("unroll") for (int li = 0; li < NL; ++li) _Pragma("unroll") for (int ks = 0; ks < 4; ++ks) bf[li][ks] = *(const bf16x8*)(bp + ((L0) + li) * 64 + ks * 16); \
            if ((ISSUE) && more) cmp_sample_issue<0, CS_NPF>(p, un, v); \
            __builtin_amdgcn_sched_barrier(0); \
            _Pragma("unroll") for (int li = 0; li < NL; ++li) { const int l = 16 * kh + (L0) + li; const bf16_t* ap = X + ((l & 15) * 33 + nl0 + (l >> 4)) * 136 + g * 64 + 8 * hh; \
                _Pragma("unroll") for (int ks = 0; ks < 4; ++ks) { const bf16x8 a0 = *(const bf16x8*)(ap + ks * 16), a1 = *(const bf16x8*)(ap + 16 * 136 + ks * 16); \
                    acc0 = __builtin_amdgcn_mfma_f32_32x32x16_bf16(a0, bf[li][ks], acc0, 0, 0, 0); acc1 = __builtin_amdgcn_mfma_f32_32x32x16_bf16(a1, bf[li][ks], acc1, 0, 0, 0); } } \
            __builtin_amdgcn_sched_barrier(0); } while (0)
        if (PROBE_DUP == 35) { CS_BATCH(0, 4, false); CS_BATCH(4, 4, false); CS_BATCH(8, 4, false); CS_BATCH(12, 2, false); CS_BATCH(14, 2, false);
#pragma unroll
            for (int i = 0; i < 16; ++i) { acc0[i] = 0.f; acc1[i] = 0.f; } }
        CS_BATCH(0, 4, false); CS_BATCH(4, 4, false); CS_BATCH(8, 4, false); CS_BATCH(12, 2, false); CS_BATCH(14, 2, true);
#undef CS_BATCH
        for (int rep5 = 0; rep5 < (PROBE_DUP == 36 ? 2 : 1); ++rep5) {
        __syncthreads();
        float* red = (float*)lds;
#pragma unroll
        for (int i = 0; i < 16; ++i) { const int m = (i & 3) + 8 * (i >> 2) + 4 * hh; red[(((kh * 2 + 0) * 4 + ct) * 32 + m) * 32 + r] = acc0[i]; red[(((kh * 2 + 1) * 4 + ct) * 32 + m) * 32 + r] = acc1[i]; }
        __syncthreads();
        bf16_t* hid = (bf16_t*)(lds + 65536);
        for (int e = tid; e < 64 * 128; e += 512) { const int m = e >> 7, hc = e & 127; const int rt = m >> 5, mm = m & 31, c4 = hc >> 5, cc = hc & 31;
            const float vv = red[(((0 * 2 + rt) * 4 + c4) * 32 + mm) * 32 + cc] + red[(((1 * 2 + rt) * 4 + c4) * 32 + mm) * 32 + cc] + ptsum;
            hid[m * 136 + hc] = f2bf(gelu_tanh(vv)); }
        __syncthreads();
        if (wid < 4) {
            f32x16 o;
#pragma unroll
            for (int i = 0; i < 16; ++i) o[i] = 0.f;
#pragma unroll
            for (int ks = 0; ks < 8; ++ks) { const bf16x8 a = *(const bf16x8*)(hid + (rt2 * 32 + r) * 136 + ks * 16 + 8 * hh), wb = *(const bf16x8*)(W2s + (et * 32 + r) * 128 + ks * 16 + 8 * hh); o = __builtin_amdgcn_mfma_f32_32x32x16_bf16(a, wb, o, 0, 0, 0); }
            bf16_t* dst = (bf16_t*)(p.ws + WS_KCMPS) + ((size_t)b * 2 + kv) * 1024 * 128;
#pragma unroll
            for (int i = 0; i < 16; ++i) { const int m = rt2 * 32 + (i & 3) + 8 * (i >> 2) + 4 * hh; const int n = grp * 32 + (m >> 1), gg = m & 1;
                dst[((size_t)n * 2 + gg) * 64 + et * 32 + r] = (n < 1023) ? f2bf(o[i]) : (bf16_t)0; }
        }
        __syncthreads();
        }
        if (!more) break;
        u = un;
    }
}

__device__ __forceinline__ void softmax4(float* sc, int pitch, int nk) {
    const int tid = threadIdx.x, wid = tid >> 6, lane = tid & 63;
    if (wid < 4) { float* s = sc + wid * pitch; float mx = -1e30f;
        for (int k = lane; k < nk; k += 64) mx = fmaxf(mx, s[k]);
#pragma unroll
        for (int o = 32; o >= 1; o >>= 1) mx = fmaxf(mx, __shfl_xor(mx, o));
        float sum = 0.f;
        for (int k = lane; k < nk; k += 64) { const float e = __expf(s[k] - mx); s[k] = e; sum += e; }
        sum = wave_sum(sum); const float inv = 1.0f / sum;
        for (int k = lane; k < nk; k += 64) s[k] *= inv; }
}

__device__ __forceinline__ void nsa_sample_unit(const Params& p, unsigned char* lds, int b, int g) {
    int tid_op = threadIdx.x; asm volatile("" : "+v"(tid_op));
    const int tid = tid_op, wid = tid >> 6, lane = tid & 63;
    constexpr int PITCH = 1040;
    float* qv = (float*)lds;
    float* sc = qv + 256;
    float* osum = sc + 4 * PITCH;
    float* part = osum + 256;
    float* impv = part + 2048;
    int* sidx = (int*)(impv + 264);
    const float** kptr = (const float**)(lds + 32768);
    const float* zs = (const float*)(p.ws + WS_ZS) + (size_t)b * NZ; const float* bl = (const float*)(p.ws + WS_BIAS); const float* gts_dummy = nullptr; (void)gts_dummy;
    const int* pt = p.page_tab + b * 128;
    if (tid < 256) { qv[tid] = zs[ZC_QA + g * 256 + tid] * 0.125f; osum[tid] = 0.f; }
    __syncthreads();
    const int ph = tid >> 6 & 3, pd = tid & 63;
    const float gate_c = sigmoidf_(zs[ZC_GT + 0 + g * 4 + ph]), gate_s = sigmoidf_(zs[ZC_GT + 8 + g * 4 + ph]), gate_w = sigmoidf_(zs[ZC_GT + 16 + g * 4 + ph]);
    {
        const bf16_t* KC = (const bf16_t*)(p.ws + WS_KCMPS) + ((size_t)b * 2) * 1024 * 128; const bf16_t* VC = KC + (size_t)1024 * 128;
        for (int n = tid; n < 1023; n += 512) { const bf16_t* kr = KC + ((size_t)n * 2 + g) * 64; float a0 = 0.f, a1 = 0.f, a2 = 0.f, a3 = 0.f;
#pragma unroll 1
            for (int d8 = 0; d8 < 8; ++d8) { const bf16x8 kk = *(const bf16x8*)(kr + d8 * 8);
#pragma unroll
                for (int e = 0; e < 8; ++e) { const float kf = bf2f((bf16_t)kk[e]); const int d = d8 * 8 + e; a0 += qv[d] * kf; a1 += qv[64 + d] * kf; a2 += qv[128 + d] * kf; a3 += qv[192 + d] * kf; } }
            const int dc = PAST - (16 * n + 31); const int bi = dc < 1024 ? dc : 1024;
            sc[n] = a0 + bl[(g * 4 + 0) * 1032 + bi]; sc[PITCH + n] = a1 + bl[(g * 4 + 1) * 1032 + bi]; sc[2 * PITCH + n] = a2 + bl[(g * 4 + 2) * 1032 + bi]; sc[3 * PITCH + n] = a3 + bl[(g * 4 + 3) * 1032 + bi]; }
        __syncthreads();
        softmax4(sc, PITCH, 1023);
        __syncthreads();
        { float o0 = 0.f, o1 = 0.f, o2 = 0.f, o3 = 0.f;
          for (int k = wid; k < 1023; k += 64) { float v[8];
#pragma unroll
              for (int u = 0; u < 8; ++u) { const int kk = k + 8 * u; v[u] = (kk < 1023) ? bf2f(VC[((size_t)kk * 2 + g) * 64 + pd]) : 0.f; }
#pragma unroll
              for (int u = 0; u < 8; ++u) { const int kk = k + 8 * u; if (kk < 1023) { o0 += sc[kk] * v[u]; o1 += sc[PITCH + kk] * v[u]; o2 += sc[2 * PITCH + kk] * v[u]; o3 += sc[3 * PITCH + kk] * v[u]; } } }
          part[wid * 256 + pd] = o0; part[wid * 256 + 64 + pd] = o1; part[wid * 256 + 128 + pd] = o2; part[wid * 256 + 192 + pd] = o3; }
        for (int j = tid; j < 257; j += 512) { float sacc = 0.f;
            for (int n = 4 * j - 1; n <= 4 * j + 3; ++n) if (n >= 0 && n < 1023) sacc += sc[n] + sc[PITCH + n] + sc[2 * PITCH + n] + sc[3 * PITCH + n];
            impv[j] = sacc; }
        __syncthreads();
        if (tid < 256) { float a = 0.f;
#pragma unroll
            for (int w = 0; w < 8; ++w) a += part[w * 256 + tid];
            osum[tid] += gate_c * a; }
        if (wid == 0) { unsigned long long key[5];
#pragma unroll
            for (int k = 0; k < 5; ++k) { const int j = lane + 64 * k; const bool forced = (j == 0) || (j == 256) || (j == 255); const float v = (j < 257) ? (forced ? 1e4f : impv[j]) : 0.f;
                key[k] = (j < 257) ? (((unsigned long long)__float_as_uint(v) << 32) | (unsigned long long)(512 - j)) : 0ull; }
            for (int sel = 0; sel < 16; ++sel) { unsigned long long best = key[0];
#pragma unroll
                for (int k = 1; k < 5; ++k) best = best > key[k] ? best : key[k];
#pragma unroll
                for (int o = 32; o >= 1; o >>= 1) { const unsigned long long ot = __shfl_xor(best, o); best = best > ot ? best : ot; }
                if (lane == 0) sidx[sel] = 512 - (int)(best & 0x3ffull);
#pragma unroll
                for (int k = 0; k < 5; ++k) if (key[k] == best) key[k] = 0ull; } }
        __syncthreads();
    }
    for (int br = 0; br < 2; ++br) {
        int nk;
        if (br == 0) { nk = 1024;
            for (int k = tid; k < 1024; k += 512) { const int j = sidx[k >> 6], pos = 64 * j + (k & 63); const float* rp = nullptr;
                if (pos < PAST) rp = p.cache_s + (((size_t)pt[pos >> 7] * 128 + (pos & 127)) * 2) * 128 + g * 64; else if (pos == PAST) rp = zs + ZC_KVS + g * 64;
                kptr[k] = rp; ((int*)(lds + 32768 + 8192))[k] = PAST - pos; }
        } else { nk = 513;
            for (int k = tid; k < 513; k += 512) { kptr[k] = (k < 512) ? p.st_win + (((size_t)b * 512 + k) * 2) * 128 + g * 64 : zs + ZC_KVW + g * 64; ((int*)(lds + 32768 + 8192))[k] = 512 - k; } }
        __syncthreads();
        const int* dist = (const int*)(lds + 32768 + 8192);
        for (int k = tid; k < nk; k += 512) { const float* kr = kptr[k]; const int ds = dist[k];
            if (kr == nullptr || ds < 0) { sc[k] = -1e30f; sc[PITCH + k] = -1e30f; sc[2 * PITCH + k] = -1e30f; sc[3 * PITCH + k] = -1e30f; continue; }
            float a0 = 0.f, a1 = 0.f, a2 = 0.f, a3 = 0.f;
#pragma unroll 2
            for (int d4 = 0; d4 < 16; ++d4) { const f32x4 kk = *(const f32x4*)(kr + d4 * 4);
#pragma unroll
                for (int e = 0; e < 4; ++e) { const int d = d4 * 4 + e; a0 += qv[d] * kk[e]; a1 += qv[64 + d] * kk[e]; a2 += qv[128 + d] * kk[e]; a3 += qv[192 + d] * kk[e]; } }
            const int bi = ds < 1024 ? ds : 1024;
            sc[k] = a0 + bl[(g * 4 + 0) * 1032 + bi]; sc[PITCH + k] = a1 + bl[(g * 4 + 1) * 1032 + bi]; sc[2 * PITCH + k] = a2 + bl[(g * 4 + 2) * 1032 + bi]; sc[3 * PITCH + k] = a3 + bl[(g * 4 + 3) * 1032 + bi]; }
        __syncthreads();
        softmax4(sc, PITCH, nk);
        __syncthreads();
        { float o0 = 0.f, o1 = 0.f, o2 = 0.f, o3 = 0.f;
          for (int k = wid; k < nk; k += 64) { float v[8];
#pragma unroll
              for (int u = 0; u < 8; ++u) { const int kk = k + 8 * u; const float* kr = (kk < nk) ? kptr[kk] : nullptr; v[u] = (kr != nullptr) ? kr[128 + pd] : 0.f; }
#pragma unroll
              for (int u = 0; u < 8; ++u) { const int kk = k + 8 * u; if (kk < nk) { o0 += sc[kk] * v[u]; o1 += sc[PITCH + kk] * v[u]; o2 += sc[2 * PITCH + kk] * v[u]; o3 += sc[3 * PITCH + kk] * v[u]; } } }
          part[wid * 256 + pd] = o0; part[wid * 256 + 64 + pd] = o1; part[wid * 256 + 128 + pd] = o2; part[wid * 256 + 192 + pd] = o3; }
        __syncthreads();
        if (tid < 256) { float a = 0.f;
#pragma unroll
            for (int w = 0; w < 8; ++w) a += part[w * 256 + tid];
            osum[tid] += (br == 0 ? gate_s : gate_w) * a; }
        __syncthreads();
    }
    if (tid < 256) ((bf16_t*)(p.ws + WS_MIX))[(size_t)(SEQ + b) * 1024 + g * 256 + tid] = f2bf(osum[tid]);
    __syncthreads();
}

__device__ __forceinline__ void phase3(const Params& p, unsigned char* lds) {
    const int G = gridDim.x, bid = blockIdx.x;
    for (int rep = 0; rep < (PROBE_DUP == 31 ? 2 : 1); ++rep) for (int u = bid; u < 256; u += G) win_unit(p, lds, u & 1, u >> 1);
    for (int rep = 0; rep < (PROBE_DUP == 32 ? 2 : 1); ++rep) for (int u = bid; u < 1024; u += G) ret_uc_unit(p, lds, u >> 3, u & 7);
    for (int rep = 0; rep < (PROBE_DUP == 30 ? 2 : 1); ++rep) cmp_sample_stream(p, lds);
    for (int rep = 0; rep < (PROBE_DUP == 33 ? 2 : 1); ++rep) { for (int u = bid; u < 128; u += G) cmp_prompt_unit(p, lds, u & 1, (u >> 1) * 16);
    for (int u = G - 1 - bid; u < 256; u += G) vst_unit(p, lds, u * 64); }
}
__device__ __forceinline__ void phase4(const Params& p, unsigned char* lds) {
    const int G = gridDim.x, bid = blockIdx.x, tid = threadIdx.x, wid = tid >> 6, lane = tid & 63;
    for (int rep = 0; rep < (PROBE_DUP == 41 ? 2 : 1); ++rep) for (int u = bid; u < 512; u += G) nsa_unit(p, lds, u & 1, 255 - (u >> 1));
    for (int rep = 0; rep < (PROBE_DUP == 40 ? 2 : 1); ++rep) for (int u = G - 1 - bid; u < 64; u += G) nsa_sample_unit(p, lds, u >> 1, u & 1);
    for (int u = bid; u < 16; u += G) ret_scan(p, u * 512 + tid);
    for (int u = (G - 1 - bid) * 8 + wid; u < NB * 8; u += G * 8) ret_sample_wave(p, u >> 3, u & 7, lane);
}
__device__ __forceinline__ void phase5(const Params& p, unsigned char* lds) {
    const int G = gridDim.x, bid = blockIdx.x;
    for (int u = bid; u < 512; u += G) ret_out_unit(p, lds, u >> 2, u & 3);
}

struct EpiRes {
    static constexpr bool PERM = false, AFTER_DRAIN = false;
    const float* base; float* dst; const float* gate;
    __device__ __forceinline__ void operator()(const f32x4 (&acc)[2][2][4][2], const pg8::Unit& u, int wr, int wc, int fr, int fq) const {
        const int row0 = u.pm * 256 + wr * 64 + fr; const int cb = u.pn * 256 + wc * 32 + 4 * fq;
        f32x4 gv[2][2];
#pragma unroll
        for (int bj = 0; bj < 2; ++bj)
#pragma unroll
            for (int n = 0; n < 2; ++n) gv[bj][n] = *(const f32x4*)(gate + cb + bj * 128 + n * 16);
#pragma unroll
        for (int ai = 0; ai < 2; ++ai)
#pragma unroll
            for (int m = 0; m < 4; ++m) { const size_t ro = (size_t)(row0 + ai * 128 + m * 16) * 1024;
#pragma unroll
                for (int bj = 0; bj < 2; ++bj)
#pragma unroll
                    for (int n = 0; n < 2; ++n) { const int c = cb + bj * 128 + n * 16; const f32x4 b = *(const f32x4*)(base + ro + c);
                        *(f32x4*)(dst + ro + c) = b + gv[bj][n] * acc[ai][bj][m][n]; } }
    }
};
__device__ __forceinline__ void phase6(const Params& p, unsigned char* lds) {
    const int G = gridDim.x, bid = blockIdx.x;
    const bf16_t* MIX = (const bf16_t*)(p.ws + WS_MIX); const bf16_t* WoutT = (const bf16_t*)(p.ws + WS_WOUT_T);
    float* X1 = (float*)(p.ws + WS_X1); const float* mod = (const float*)(p.ws + WS_MOD);
    {
        pg8::Gemm g{MIX, WoutT, SEQ, 1024, 1024}; pg8::StaticOrder S; S.init(SEQ, 1024, G, bid);
        EpiRes E{p.x_p, X1, mod + 2048};
        pg8::gemm_phase<EpiRes, pg8::StaticOrder, true, true>((LAS unsigned char*)lds, g, S, E);
    }
    __syncthreads();
    for (int u = bid; u < 32; u += G)
        skinny32_unit(lds, MIX + (size_t)SEQ * 1024, WoutT, 1024, u * 32, [&](int m, int n, float v) {
            X1[(size_t)(SEQ + m) * 1024 + n] = p.x_s[(size_t)m * 1024 + n] + mod[(size_t)(1 + m) * 6144 + 2048 + n] * v; });
}
__device__ __forceinline__ void phase7(const Params& p, unsigned char* lds) {
    const int tid = threadIdx.x, wid = tid >> 6, lane = tid & 63, G = gridDim.x, bid = blockIdx.x;
    float* sA = (float*)lds; float* sB = sA + 1024;
    const float* X1 = (const float*)(p.ws + WS_X1); bf16_t* HN2 = (bf16_t*)(p.ws + WS_HN2); const float* mod = (const float*)(p.ws + WS_MOD);
    int cur = -1;
    for (int u = bid; u < 256 + NB; u += G) {
        const int mr = (u < 256) ? 0 : (1 + u - 256);
        if (mr != cur) { __syncthreads(); for (int c = tid; c < 1024; c += 512) { sA[c] = p.g_ffn[c] * (1.0f + mod[(size_t)mr * 6144 + 4096 + c]); sB[c] = mod[(size_t)mr * 6144 + 3072 + c]; } __syncthreads(); cur = mr; }
        if (u < 256) { for (int i = 0; i < 8; ++i) { const int row = u * 64 + wid * 8 + i; norm_row_store(X1 + (size_t)row * 1024, sA, sB, HN2 + (size_t)row * 1024, lane); } }
        else if (wid == 0) { const int row = SEQ + u - 256; norm_row_store(X1 + (size_t)row * 1024, sA, sB, HN2 + (size_t)row * 1024, lane); }
    }
}
struct EpiUp {
    static constexpr bool PERM = false, AFTER_DRAIN = false;
    unsigned char* ws; float* out;
    __device__ __forceinline__ void operator()(const f32x4 (&acc)[2][2][4][2], const pg8::Unit& u, int wr, int wc, int fr, int fq) const {
        const int pn = u.pn; const int row0 = u.pm * 256 + wr * 64 + fr; const int cb = wc * 32 + 4 * fq;
        bf16_t* bdst = (pn < 11) ? (bf16_t*)(ws + WS_AG) + pn * 256 : (bf16_t*)(ws + WS_AV) + (pn - 11) * 256;
#pragma unroll
        for (int ai = 0; ai < 2; ++ai)
#pragma unroll
            for (int m = 0; m < 4; ++m) { const int row = row0 + ai * 128 + m * 16;
#pragma unroll
                for (int bj = 0; bj < 2; ++bj)
#pragma unroll
                    for (int n = 0; n < 2; ++n) { const int c = cb + bj * 128 + n * 16; const f32x4 v = acc[ai][bj][m][n];
                        u32x2 w; w.x = cvt_pk_bf16(v[0], v[1]); w.y = cvt_pk_bf16(v[2], v[3]);
                        *(u32x2*)(bdst + (size_t)row * DFF + c) = w;
                        if (pn < 11 && row >= SEQ - 2) *(f32x4*)(out + O_CONV_P + (size_t)(row - (SEQ - 2)) * DFF + pn * 256 + c) = v; } }
    }
};
__device__ __forceinline__ void phase8(const Params& p, unsigned char* lds) {
    const int G = gridDim.x, bid = blockIdx.x;
    const bf16_t* HN2 = (const bf16_t*)(p.ws + WS_HN2); const bf16_t* WupT = (const bf16_t*)(p.ws + WS_WUP_T);
    {
        pg8::Gemm g{HN2, WupT, SEQ, 5632, 1024}; pg8::StaticOrder S; S.init(SEQ, 5632, G, bid);
        EpiUp E{p.ws, p.out};
        pg8::gemm_phase<EpiUp, pg8::StaticOrder, true, true>((LAS unsigned char*)lds, g, S, E);
    }
    __syncthreads();
    float* ags = (float*)(p.ws + WS_AGS); float* avs = (float*)(p.ws + WS_AVS); float* out = p.out;
    for (int u = G - 1 - bid; u < 176; u += G)
        skinny32_unit(lds, HN2 + (size_t)SEQ * 1024, WupT, 1024, u * 32, [&](int m, int n, float v) {
            if (n < DFF) { ags[(size_t)m * DFF + n] = v; out[O_CONV_S + ((size_t)m * 2 + 1) * DFF + n] = v; } else avs[(size_t)m * DFF + (n - DFF)] = v; });
    { int nr; const int rk = idle_rank((SEQ / 256) * (5632 / 256), G, bid, nr); if (rk >= 0) tr_stream(p, lds, 2, rk, nr); }
}
__device__ __forceinline__ void phase9(const Params& p, unsigned char* lds) {
    const int G = gridDim.x, bid = blockIdx.x, tid = threadIdx.x;
    const bf16_t* AG = (const bf16_t*)(p.ws + WS_AG); const bf16_t* AV = (const bf16_t*)(p.ws + WS_AV); bf16_t* H = (bf16_t*)(p.ws + WS_H);
    const int gt = bid * 512 + tid, GT = G * 512;
    for (int it = gt; it < 512 * 352; it += GT) {
        const int rb = it / 352, cg = it % 352; const int c0 = cg * 8, t0 = rb * 32;
        float w0[8], w1[8], w2[8], cb[8], p2[8], p1[8];
#pragma unroll
        for (int e = 0; e < 8; ++e) { w0[e] = p.conv_w[c0 + e]; w1[e] = p.conv_w[DFF + c0 + e]; w2[e] = p.conv_w[2 * DFF + c0 + e]; cb[e] = p.conv_b[c0 + e]; p2[e] = 0.f; p1[e] = 0.f; }
        if (t0 > 0) { const bf16x8 a = *(const bf16x8*)(AG + (size_t)(t0 - 2) * DFF + c0), b = *(const bf16x8*)(AG + (size_t)(t0 - 1) * DFF + c0);
#pragma unroll
            for (int e = 0; e < 8; ++e) { p2[e] = bf2f((bf16_t)a[e]); p1[e] = bf2f((bf16_t)b[e]); } }
        for (int tb = t0; tb < t0 + 32; tb += 8) {
            bf16x8 av8[8], vv8[8];
#pragma unroll
            for (int r8 = 0; r8 < 8; ++r8) { av8[r8] = *(const bf16x8*)(AG + (size_t)(tb + r8) * DFF + c0); vv8[r8] = *(const bf16x8*)(AV + (size_t)(tb + r8) * DFF + c0); }
            __builtin_amdgcn_sched_barrier(0);
#pragma unroll
            for (int r8 = 0; r8 < 8; ++r8) { float y[8];
#pragma unroll
                for (int e = 0; e < 8; ++e) { const float ag = bf2f((bf16_t)av8[r8][e]); const float cv = cb[e] + w0[e] * p2[e] + w1[e] * p1[e] + w2[e] * ag; y[e] = cv / (1.0f + __expf(-cv)) * bf2f((bf16_t)vv8[r8][e]); p2[e] = p1[e]; p1[e] = ag; }
                u32x4 w; w.x = cvt_pk_bf16(y[0], y[1]); w.y = cvt_pk_bf16(y[2], y[3]); w.z = cvt_pk_bf16(y[4], y[5]); w.w = cvt_pk_bf16(y[6], y[7]);
                *(u32x4*)(H + (size_t)(tb + r8) * DFF + c0) = w; }
        }
    }
    const float* ags = (const float*)(p.ws + WS_AGS); const float* avs = (const float*)(p.ws + WS_AVS); bf16_t* HS = (bf16_t*)(p.ws + WS_HS);
    for (int i = gt; i < NB * DFF; i += GT) { const int b = i / DFF, c = i % DFF;
        const float cv = p.conv_b[c] + p.conv_w[c] * p.st_conv[(size_t)b * 2 * DFF + c] + p.conv_w[DFF + c] * p.st_conv[(size_t)b * 2 * DFF + DFF + c] + p.conv_w[2 * DFF + c] * ags[i];
        HS[i] = f2bf(cv / (1.0f + __expf(-cv)) * avs[i]); }
}
__device__ __forceinline__ void phase10(const Params& p, unsigned char* lds) {
    const int G = gridDim.x, bid = blockIdx.x;
    const bf16_t* H = (const bf16_t*)(p.ws + WS_H); const bf16_t* WdnT = (const bf16_t*)(p.ws + WS_WDN_T);
    float* X1 = (float*)(p.ws + WS_X1); const float* mod = (const float*)(p.ws + WS_MOD);
    {
        pg8::Gemm g{H, WdnT, SEQ, 1024, DFF}; pg8::StaticOrder S; S.init(SEQ, 1024, G, bid);
        EpiRes E{X1, X1, mod + 5120};
        pg8::gemm_phase<EpiRes, pg8::StaticOrder, true, true>((LAS unsigned char*)lds, g, S, E);
    }
    __syncthreads();
    const bf16_t* HS = (const bf16_t*)(p.ws + WS_HS);
    for (int u = bid; u < 32; u += G)
        skinny32_unit(lds, HS, WdnT, DFF, u * 32, [&](int m, int n, float v) {
            float* x = X1 + (size_t)(SEQ + m) * 1024 + n; *x = *x + mod[(size_t)(1 + m) * 6144 + 5120 + n] * v; });
}
__device__ __forceinline__ void phase11(const Params& p, unsigned char* lds) {
    const int tid = threadIdx.x, wid = tid >> 6, lane = tid & 63, G = gridDim.x, bid = blockIdx.x;
    const float* X1 = (const float*)(p.ws + WS_X1);
    for (int r = bid * 8 + wid; r < SEQ + NB; r += G * 8) {
        const float* xr = X1 + (size_t)r * 1024; float* dst = (r < SEQ) ? p.out + O_YP + (size_t)r * 1024 : p.out + O_YS + (size_t)(r - SEQ) * 1024;
        f32x4 v[4]; float ss = 0.f;
#pragma unroll
        for (int j = 0; j < 4; ++j) { v[j] = *(const f32x4*)(xr + lane * 4 + 256 * j); ss += v[j][0] * v[j][0] + v[j][1] * v[j][1] + v[j][2] * v[j][2] + v[j][3] * v[j][3]; }
        ss = wave_sum(ss); const float rstd = rsqrtf(ss * (1.0f / 1024.0f) + 1e-6f);
#pragma unroll
        for (int j = 0; j < 4; ++j) { const int c = lane * 4 + 256 * j; const f32x4 g = *(const f32x4*)(p.g_fin + c); *(f32x4*)(dst + c) = v[j] * rstd * g; }
    }
}

constexpr int LDS_BYTES = 163840, LDS_CTL = LDS_BYTES - 64;
constexpr int N_PHASES = 12;
__global__ void __launch_bounds__(512, 2) fwd_kernel(Params p) {
    extern __shared__ __attribute__((aligned(16))) unsigned char lds[];
    const int lo = (int)p.ph_lo, hi = (int)p.ph_hi;
    if (threadIdx.x < 16) ((LAS unsigned*)((LAS unsigned char*)lds + LDS_CTL))[threadIdx.x] = 0u;
    __syncthreads();
    XcdBarrier bar; bar.bar = (unsigned*)(p.ws + WS_BAR); bar.x = 0; bar.st = nullptr;
    if (hi - lo > 1) bar = xcd_barrier_post((unsigned*)(p.ws + WS_BAR), (volatile LAS unsigned*)((LAS unsigned char*)lds + LDS_CTL));
#define IN(k) (lo <= (k) && (k) < hi)
#define SEAM(k) do { if (IN(k) && IN((k) + 1)) xcd_barrier(bar); } while (0)
    if (IN(0)) { phase0(p, lds); if (PROBE_DUP == 0) { xcd_barrier(bar); phase0(p, lds); } } SEAM(0);
    if (IN(1)) { phase1(p, lds); if (PROBE_DUP == 1) { xcd_barrier(bar); phase1(p, lds); } } SEAM(1);
    if (IN(2)) { phase2(p, lds); if (PROBE_DUP == 2) { xcd_barrier(bar); phase2(p, lds); } } SEAM(2);
    if (IN(3)) { phase3(p, lds); if (PROBE_DUP == 3) { xcd_barrier(bar); phase3(p, lds); } } SEAM(3);
    if (IN(4)) { phase4(p, lds); if (PROBE_DUP == 4) { xcd_barrier(bar); phase4(p, lds); } } SEAM(4);
    if (IN(5)) { phase5(p, lds); if (PROBE_DUP == 5) { xcd_barrier(bar); phase5(p, lds); } } SEAM(5);
    if (IN(6)) { phase6(p, lds); if (PROBE_DUP == 6) { xcd_barrier(bar); phase6(p, lds); } } SEAM(6);
    if (IN(7)) { phase7(p, lds); if (PROBE_DUP == 7) { xcd_barrier(bar); phase7(p, lds); } } SEAM(7);
    if (IN(8)) { phase8(p, lds); if (PROBE_DUP == 8) { xcd_barrier(bar); phase8(p, lds); } } SEAM(8);
    if (IN(9)) { phase9(p, lds); if (PROBE_DUP == 9) { xcd_barrier(bar); phase9(p, lds); } } SEAM(9);
    if (IN(10)) { phase10(p, lds); if (PROBE_DUP == 10) { xcd_barrier(bar); phase10(p, lds); } } SEAM(10);
    if (IN(11)) { phase11(p, lds); if (PROBE_DUP == 11) { xcd_barrier(bar); phase11(p, lds); } }
#undef IN
#undef SEAM
}

extern "C" void kernel_launch(void* const* d_in, const int* in_sizes, int n_in, void* d_out, int out_size, void* d_ws, size_t ws_size, hipStream_t stream) {
    static int grid = 0;
    if (grid == 0) {
        if (n_in != 29 || out_size != (int)O_END || ws_size < WS_END) { fprintf(stderr, "kernel_launch: unexpected sizes n_in %d out %d ws %zu (need %zu)\n", n_in, out_size, ws_size, (size_t)WS_END); grid = -1; return; }
        int dev = 0, cus = 0;
        if (hipGetDevice(&dev) != hipSuccess || hipDeviceGetAttribute(&cus, hipDeviceAttributeMultiprocessorCount, dev) != hipSuccess) { grid = -1; return; }
        if (hipFuncSetAttribute((const void*)fwd_kernel, hipFuncAttributeMaxDynamicSharedMemorySize, LDS_BYTES) != hipSuccess) { fprintf(stderr, "kernel_launch: hipFuncSetAttribute failed\n"); grid = -1; return; }
        int per_cu = 0;
        if (hipOccupancyMaxActiveBlocksPerMultiprocessor(&per_cu, (const void*)fwd_kernel, 512, LDS_BYTES) != hipSuccess || per_cu < 1) fprintf(stderr, "kernel_launch: occupancy query says %d\n", per_cu);
        (void)hipGetLastError();
        grid = cus;
    }
    if (grid < 0) return;
    (void)hipMemsetAsync((char*)d_ws + WS_BAR, 0, 16384, stream);
    Params p{};
    p.x_p = (const float*)d_in[0]; p.x_s = (const float*)d_in[1]; p.cache_c = (const float*)d_in[2]; p.cache_s = (const float*)d_in[3]; p.st_win = (const float*)d_in[4];
    p.st_ret = (const float*)d_in[5]; p.st_conv = (const float*)d_in[6]; p.page_tab = (const int*)d_in[7]; p.c_p = (const float*)d_in[8]; p.c_s = (const float*)d_in[9];
    p.w_ada = (const float*)d_in[10]; p.b_ada = (const float*)d_in[11]; p.g_mix = (const float*)d_in[12]; p.w_in = (const float*)d_in[13]; p.pe_k = (const float*)d_in[14]; p.pe_v = (const float*)d_in[15];
    p.w1_k = (const float*)d_in[16]; p.w1_v = (const float*)d_in[17]; p.w2_k = (const float*)d_in[18]; p.w2_v = (const float*)d_in[19]; p.table = (const float*)d_in[20]; p.gn_g = (const float*)d_in[21];
    p.w_out = (const float*)d_in[22]; p.g_ffn = (const float*)d_in[23]; p.w_up = (const float*)d_in[24]; p.conv_w = (const float*)d_in[25]; p.conv_b = (const float*)d_in[26]; p.w_down = (const float*)d_in[27]; p.g_fin = (const float*)d_in[28];
    p.out = (float*)d_out; p.ws = (unsigned char*)d_ws;
#if MK_ONE_LAUNCH
    p.ph_lo = 0; p.ph_hi = N_PHASES;
    hipLaunchKernelGGL(fwd_kernel, dim3(grid), dim3(512), LDS_BYTES, stream, p);
#else
    for (int ph = 0; ph < N_PHASES; ++ph) { if (DBG_SKIP_MIX && ph == 5) continue; p.ph_lo = ph; p.ph_hi = ph + 1; hipLaunchKernelGGL(fwd_kernel, dim3(grid), dim3(512), LDS_BYTES, stream, p); }
#endif
}
```

```cpp
#include <hip/hip_runtime.h>
#include <cstdio>
#include <cstdint>

#ifndef DBG_SKIP_MIX
#define DBG_SKIP_MIX 0
#endif
#ifndef DBG_NO_NSA
#define DBG_NO_NSA 0
#endif
#ifndef PROBE_DUP
#define PROBE_DUP -1
#endif
#ifndef MK_ONE_LAUNCH
#define MK_ONE_LAUNCH 1
#endif

#define LAS __attribute__((address_space(3)))
typedef unsigned short bf16_t;
typedef short bf16x8 __attribute__((ext_vector_type(8)));
typedef float f32x4 __attribute__((ext_vector_type(4)));
typedef float f32x2 __attribute__((ext_vector_type(2)));
typedef float f32x16 __attribute__((ext_vector_type(16)));
typedef unsigned u32x4 __attribute__((ext_vector_type(4)));
typedef unsigned u32x2 __attribute__((ext_vector_type(2)));

constexpr int SEQ = 16384, DM = 1024, NB = 32, DFF = 2816, NZ = 3584  , PAST = 16384;
constexpr int MROWS = SEQ + NB;
constexpr size_t O_YP = 0, O_YS = 16777216, O_CMP_P = 16809984, O_CMP_S = 21004288, O_SLC_P = 21012480, O_SLC_S = 25206784,
                 O_WIN_P = 25214976, O_WIN_S = 25346048, O_RET_P = 29540352, O_RET_S = 29573120, O_CONV_P = 30621696, O_CONV_S = 30627328, O_END = 30807552;
constexpr int ZC_QA = 0, ZC_KVC = 512, ZC_KVS = 768, ZC_KVW = 1024, ZC_QR = 1280, ZC_KR = 1792, ZC_VR = 2304, ZC_GR = 2816, ZC_GT = 3328;

constexpr size_t al256(size_t x) { return (x + 255) & ~(size_t)255; }
constexpr size_t WS_BAR = 0;
constexpr size_t WS_MODP = 16384;
constexpr size_t WS_MOD = WS_MODP + al256((size_t)8 * 33 * 6144 * 4);
constexpr size_t WS_ROPE = WS_MOD + al256((size_t)33 * 6144 * 4);
constexpr size_t WS_BIAS = WS_ROPE + al256((size_t)2 * 16385 * 32 * 4);
constexpr size_t WS_WIN_T = WS_BIAS + al256((size_t)8 * 1032 * 4);
constexpr size_t WS_WOUT_T = WS_WIN_T + (size_t)NZ * 1024 * 2;
constexpr size_t WS_WUP_T = WS_WOUT_T + (size_t)1024 * 1024 * 2;
constexpr size_t WS_WDN_T = WS_WUP_T + (size_t)5632 * 1024 * 2;
constexpr size_t WS_W1T = WS_WDN_T + (size_t)1024 * 2816 * 2;
constexpr size_t WS_W2T = WS_W1T + (size_t)2 * 128 * 2048 * 2;
constexpr size_t WS_PET = WS_W2T + (size_t)2 * 64 * 128 * 2;
constexpr size_t WS_HN = WS_PET + 8192;
constexpr size_t WS_QA = WS_HN + (size_t)(SEQ + 256) * 1024 * 2;
constexpr size_t WS_KVC = WS_QA + (size_t)SEQ * 512 * 2;
constexpr size_t WS_KVS = WS_KVC + (size_t)SEQ * 256 * 2;
constexpr size_t WS_KVW = WS_KVS + (size_t)SEQ * 256 * 2;
constexpr size_t WS_QR = WS_KVW + (size_t)SEQ * 256 * 2;
constexpr size_t WS_KR = WS_QR + (size_t)SEQ * 512 * 2;
constexpr size_t WS_VR = WS_KR + (size_t)SEQ * 512 * 2;
constexpr size_t WS_GR = WS_VR + (size_t)SEQ * 512 * 2;
constexpr size_t WS_GATES = WS_GR + (size_t)SEQ * 512 * 2;
constexpr size_t WS_ZS = WS_GATES + (size_t)SEQ * 24 * 4;
constexpr size_t WS_UC = WS_ZS + (size_t)NB * NZ * 4;
constexpr size_t WS_SC = WS_UC + (size_t)128 * 8 * 4096 * 4;
constexpr size_t WS_MIX = WS_SC + (size_t)128 * 8 * 4096 * 4;
constexpr size_t WS_X1 = WS_MIX + (size_t)(SEQ + 256) * 1024 * 2;
constexpr size_t WS_HN2 = WS_X1 + (size_t)(SEQ + 32) * 1024 * 4;
constexpr size_t WS_AG = WS_HN2 + (size_t)(SEQ + 256) * 1024 * 2;
constexpr size_t WS_AV = WS_AG + (size_t)SEQ * DFF * 2;
constexpr size_t WS_H = WS_AV + (size_t)SEQ * DFF * 2;
constexpr size_t WS_AGS = WS_H + (size_t)SEQ * DFF * 2;
constexpr size_t WS_AVS = WS_AGS + (size_t)NB * DFF * 4;
constexpr size_t WS_HS = WS_AVS + (size_t)NB * DFF * 4;
constexpr size_t WS_KCMP = WS_HS + (size_t)NB * DFF * 2;
constexpr size_t WS_VST = WS_KCMP + (size_t)2 * 1024 * 128 * 2;
constexpr size_t WS_OW = WS_VST + (size_t)2 * 64 * SEQ * 2;
constexpr size_t WS_KCMPS = WS_OW + (size_t)SEQ * 512 * 4;
constexpr size_t WS_KBM = WS_KCMPS + (size_t)NB * 2 * 1024 * 128 * 2;
constexpr size_t WS_KCM = WS_KBM + 2048;
constexpr size_t WS_OC = WS_KBM + 4096;
constexpr size_t WS_END = WS_OC + (size_t)SEQ * 512 * 4;

struct Params {
    const float *x_p, *x_s, *cache_c, *cache_s, *st_win, *st_ret, *st_conv; const int* page_tab;
    const float *c_p, *c_s, *w_ada, *b_ada, *g_mix, *w_in, *pe_k, *pe_v, *w1_k, *w1_v, *w2_k, *w2_v, *table, *gn_g, *w_out, *g_ffn, *w_up, *conv_w, *conv_b, *w_down, *g_fin;
    float* out; unsigned char* ws; long long ph_lo, ph_hi;
};

typedef __bf16 bf16v2_t __attribute__((ext_vector_type(2)));
__device__ __forceinline__ unsigned cvt_pk_bf16(float lo, float hi) { const f32x2 v = {lo, hi}; const bf16v2_t b = __builtin_convertvector(v, bf16v2_t); return __builtin_bit_cast(unsigned, b); }
__device__ __forceinline__ bf16_t f2bf(float f) { unsigned u = __float_as_uint(f); u += 0x7FFFu + ((u >> 16) & 1u); return (bf16_t)(u >> 16); }
__device__ __forceinline__ float bf2f(bf16_t b) { return __uint_as_float(((unsigned)b) << 16); }
__device__ __forceinline__ float wave_sum(float v) {
#pragma unroll
    for (int o = 32; o >= 1; o >>= 1) v += __shfl_xor(v, o);
    return v;
}
__device__ __forceinline__ float sigmoidf_(float x) { return 1.0f / (1.0f + __expf(-x)); }

#define XB_TMO      128
#define XB_XCNT(j)  (256  + 64 * (j))
#define XB_XSUB(j)  (1280 + 64 * (j))
#define XB_XGEN(j)  (2304 + 64 * (j))
#define XB_TOP      3328
#define XB_TOPGEN   3392
#define XCD_BAR_WORDS 3456
#define XB_SPIN_CAP (1u << 18)
__device__ __forceinline__ unsigned xb_ld(unsigned* p)              { return __hip_atomic_load(p, __ATOMIC_RELAXED, __HIP_MEMORY_SCOPE_AGENT); }
__device__ __forceinline__ unsigned xb_add(unsigned* p, unsigned v) { return __hip_atomic_fetch_add(p, v, __ATOMIC_RELAXED, __HIP_MEMORY_SCOPE_AGENT); }
__device__ __forceinline__ unsigned xb_xcc_id() { return (unsigned)__builtin_amdgcn_s_getreg((3 << 11) | 20) & 0xFu; }
#define XB_SPIN(cond, bar) do { unsigned _sp = 0; while (cond) { __builtin_amdgcn_s_sleep(1); \
    if ((++_sp & 255u) == 0u) { if (xb_ld(&(bar)[XB_TMO])) break; if (_sp > XB_SPIN_CAP) { atomicAdd(&(bar)[XB_TMO], 1u); break; } } } } while (0)
struct XcdBarrier { unsigned* bar; unsigned x; volatile LAS unsigned* st; };
__device__ __forceinline__ XcdBarrier xcd_barrier_post(unsigned* bar, volatile LAS unsigned* st) {
    XcdBarrier b; b.bar = bar; b.x = xb_xcc_id(); b.st = st;
    if (threadIdx.x == 0) (void)xb_add(&bar[XB_XCNT(b.x)], 1u);
    return b;
}
__device__ __forceinline__ void xcd_barrier_complete(unsigned* bar, unsigned x, unsigned& nloc, unsigned& nx) {
    const unsigned G = gridDim.x * gridDim.y * gridDim.z;
    unsigned sum, cnt, mine, sp = 0u;
    for (;;) {
        sum = 0u; cnt = 0u; mine = 0u;
#pragma unroll
        for (unsigned j = 0; j < 16; ++j) { const unsigned c = xb_ld(&bar[XB_XCNT(j)]); sum += c; cnt += (c > 0u) ? 1u : 0u; mine = (j == x) ? c : mine; }
        if (sum == G) break;
        __builtin_amdgcn_s_sleep(1);
        if ((++sp & 255u) == 0u) { if (xb_ld(&bar[XB_TMO])) break; if (sp > XB_SPIN_CAP) { atomicAdd(&bar[XB_TMO], 1u); break; } }
    }
    nloc = mine > 0u ? mine : 1u; nx = cnt > 0u ? cnt : 1u;
}
__device__ __forceinline__ void xcd_barrier(const XcdBarrier& b) {
    asm volatile("s_waitcnt vmcnt(0)" ::: "memory");
    __syncthreads();
    if (threadIdx.x == 0) {
        unsigned* bar = b.bar;
        __builtin_amdgcn_s_waitcnt(0);
        unsigned nloc = b.st[0], nx = b.st[1];
        if (nloc == 0u) { xcd_barrier_complete(bar, b.x, nloc, nx); b.st[0] = nloc; b.st[1] = nx; }
        const unsigned old = xb_add(&bar[XB_XSUB(b.x)], 1u);
        const unsigned gen = old / nloc;
        if (old + 1u == (gen + 1u) * nloc) {
            __builtin_amdgcn_fence(__ATOMIC_RELEASE, "agent");
            asm volatile("s_waitcnt vmcnt(0)" ::: "memory");
            const unsigned og = xb_add(&bar[XB_TOP], 1u);
            const unsigned tg = og / nx;
            if (og + 1u == (tg + 1u) * nx) xb_add(&bar[XB_TOPGEN], 1u);
            else XB_SPIN(xb_ld(&bar[XB_TOPGEN]) == tg, bar);
            __builtin_amdgcn_fence(__ATOMIC_ACQUIRE, "agent");
            xb_add(&bar[XB_XGEN(b.x)], 1u);
            asm volatile("s_waitcnt vmcnt(0)" ::: "memory");
        } else {
            XB_SPIN(xb_ld(&bar[XB_XGEN(b.x)]) == gen, bar);
            __builtin_amdgcn_fence(__ATOMIC_ACQUIRE, "agent");
            asm volatile("s_waitcnt vmcnt(0)" ::: "memory");
        }
    }
    __syncthreads();
}

namespace pg8 {
constexpr int BM = 256, BK = 64, HALF = 128, HTB = HALF * BK * 2, STAGE_BYTES = 8 * HTB, NXCD = 8, WGM = 8;
__host__ __device__ __forceinline__ int lds_byte(int r, int c) { const int st = (r >> 4) * 2 + (c >> 5), rr = r & 15, cc = c & 31, ob = rr * 64 + cc * 2; return st * 1024 + (ob ^ (((ob >> 9) & 1) << 5)); }
__host__ __device__ __forceinline__ void stage_rc(int b, int& R, int& C) { const int st = b / 1024, sb = b % 1024, swz = sb ^ (((sb >> 9) & 1) << 5); R = (st >> 1) * 16 + swz / 64; C = (st & 1) * 32 + (swz % 64) / 2; }
__host__ __device__ __forceinline__ int perm32(int rho) { const int n = rho >> 4, i = rho & 15; return 8 * (i >> 2) + 4 * n + (i & 3); }
struct Unit { int pm, pn; };
struct Gemm { const bf16_t* A; const bf16_t* Bt; int M, N, K; };
struct StaticOrder {
    int nM, nN, nwg, G, c;
    __host__ __device__ void init(int M, int N, int G_, int c_) { nM = M / BM; nN = N / BM; nwg = nM * nN; G = G_; c = c_; }
    __host__ __device__ bool next(int i, Unit& u) const {
        const long L = (long)i * G + c; if (L >= nwg) return false;
        int wgid = (int)L; { const int q = nwg / NXCD, r = nwg % NXCD, xcd = wgid % NXCD, off = wgid / NXCD; wgid = (xcd < r ? xcd * (q + 1) : r * (q + 1) + (xcd - r) * q) + off; }
        const int nig = WGM * nN, gid = wgid / nig, fm = gid * WGM, gsz = (nM - fm) < WGM ? (nM - fm) : WGM;
        u.pm = fm + ((wgid % nig) % gsz); u.pn = (wgid % nig) / gsz; return true;
    }
    __device__ __forceinline__ void a_ready(const Unit&) const {}
    __device__ __forceinline__ void done(const Unit&) const {}
};
template <class Epi, class Sched, bool ALIGN_EPI = false, bool SP2 = false, int AG = 64>
__device__ __forceinline__ void gemm_phase(LAS unsigned char* lds, const Gemm g, const Sched& S, const Epi& E) {
    const int tid = threadIdx.x, wid = __builtin_amdgcn_readfirstlane(tid >> 6), lane = tid & 63, wr = wid >> 2, wc = wid & 3, fr = lane & 15, fq = lane >> 4;
    const int K = g.K, nt = K / BK;
    unsigned voffA[2], voffB[2];
#pragma unroll
    for (int i = 0; i < 2; ++i) { int R, C; stage_rc(tid * 16 + i * 8192, R, C); const int Rb = Epi::PERM ? ((R & ~31) + perm32(R & 31)) : R;
        voffA[i] = (unsigned)(((R >> 6) * AG + (R & 63)) * K + C) * 2u; voffB[i] = (unsigned)(Rb * K + C) * 2u; }
    const size_t kstep = (size_t)(BK * 2);
    const size_t hstep = (size_t)HALF * K * 2;
    const size_t tstep = 2 * hstep;
    const size_t hstepA = (size_t)2 * AG * K * 2, tstepA = 2 * hstepA;
    const unsigned ldsw = (unsigned)wid * 1024u;
    const int aoff = lds_byte(wr * 64 + fr, fq * 8), boff = lds_byte(wc * 32 + fr, fq * 8);
#define PG8_SA(b, h) (((b) * 2 + (h)) * HTB)
#define PG8_SB(b, h) ((4 + (b) * 2 + (h)) * HTB)
#define PG8_STAGE(bufoff, gbase, voff) do { _Pragma("unroll") for (int _i = 0; _i < 2; ++_i) \
        __builtin_amdgcn_global_load_lds((const unsigned*)((const char*)(gbase) + (voff)[_i]), (LAS unsigned*)(lds + (bufoff) + ldsw + _i * 8192), 16, 0, 0); } while (0)
#define PG8_LDA(dst, b, h) do { _Pragma("unroll") for (int m = 0; m < 4; ++m) _Pragma("unroll") for (int k = 0; k < 2; ++k) dst[m][k] = *(const LAS bf16x8*)(lds + PG8_SA(b, h) + aoff + m * 2048 + k * 1024); } while (0)
#define PG8_LDB(dst, b, h) do { _Pragma("unroll") for (int n = 0; n < 2; ++n) _Pragma("unroll") for (int k = 0; k < 2; ++k) dst[n][k] = *(const LAS bf16x8*)(lds + PG8_SB(b, h) + boff + n * 2048 + k * 1024); } while (0)
#define PG8_MMA(ai, bj, At, Bt) do { __builtin_amdgcn_s_setprio(1); _Pragma("unroll") for (int m = 0; m < 4; ++m) _Pragma("unroll") for (int n = 0; n < 2; ++n) _Pragma("unroll") for (int k = 0; k < 2; ++k) \
        acc[ai][bj][m][n] = __builtin_amdgcn_mfma_f32_16x16x32_bf16(Bt[n][k], At[m][k], acc[ai][bj][m][n], 0, 0, 0); __builtin_amdgcn_s_setprio(0); } while (0)
#define PG8_WAIT_V(n) asm volatile("s_waitcnt vmcnt(" #n ")" ::: "memory")
#define PG8_WAIT_L(n) asm volatile("s_waitcnt lgkmcnt(" #n ")" ::: "memory")
#define PG8_BAR __builtin_amdgcn_s_barrier()
#define PG8_SCHED __builtin_amdgcn_sched_barrier(0)
    Unit cur, nxt; int ui = 0;
    if (!S.next(0, cur)) return;
    f32x4 acc[2][2][4][2];
#pragma unroll
    for (int a = 0; a < 2; ++a)
#pragma unroll
        for (int b = 0; b < 2; ++b)
#pragma unroll
            for (int m = 0; m < 4; ++m)
#pragma unroll
                for (int n = 0; n < 2; ++n) acc[a][b][m][n] = (f32x4){0.f, 0.f, 0.f, 0.f};
    bf16x8 At[4][2], B0[2][2], B1[2][2];
    const char* cA = (const char*)g.A + (size_t)cur.pm * tstepA; const char* cB = (const char*)g.Bt + (size_t)cur.pn * tstep;
    S.a_ready(cur);
    if constexpr (SP2) {
        PG8_STAGE(PG8_SB(0, 0), cB, voffB); PG8_STAGE(PG8_SB(0, 1), cB + hstep, voffB); PG8_STAGE(PG8_SA(0, 0), cA, voffA); PG8_STAGE(PG8_SA(0, 1), cA + hstepA, voffA);
        if (wr == 1) PG8_BAR;
        PG8_WAIT_V(2); PG8_BAR;
        PG8_STAGE(PG8_SB(1, 0), cB + kstep, voffB); PG8_STAGE(PG8_SA(1, 0), cA + kstep, voffA); PG8_STAGE(PG8_SB(1, 1), cB + hstep + kstep, voffB);
        PG8_WAIT_V(6); PG8_BAR;
    } else {
        PG8_STAGE(PG8_SB(0, 0), cB, voffB); PG8_STAGE(PG8_SA(0, 0), cA, voffA); PG8_STAGE(PG8_SB(0, 1), cB + hstep, voffB); PG8_STAGE(PG8_SA(0, 1), cA + hstepA, voffA);
        if (wr == 1) PG8_BAR;
        PG8_WAIT_V(4); PG8_BAR;
        PG8_STAGE(PG8_SB(1, 0), cB + kstep, voffB); PG8_STAGE(PG8_SA(1, 0), cA + kstep, voffA); PG8_STAGE(PG8_SB(1, 1), cB + hstep + kstep, voffB);
        PG8_WAIT_V(6); PG8_BAR;
    }
    for (;;) {
        const bool has_next = S.next(ui + 1, nxt);
        const char* nA = has_next ? (const char*)g.A + (size_t)nxt.pm * tstepA : cA; const char* nB = has_next ? (const char*)g.Bt + (size_t)nxt.pn * tstep : cB;
        for (int t = 0; t < nt; t += 2) {
            const bool last = (t == nt - 2);
            const char* a1 = cA + (size_t)(t + 1) * kstep;
            const char* a2 = last ? nA : cA + (size_t)(t + 2) * kstep; const char* b2 = last ? nB : cB + (size_t)(t + 2) * kstep;
            const char* a3 = a2 + kstep; const char* b3 = b2 + kstep;
            if (last && has_next) S.a_ready(nxt);
            if constexpr (SP2) {
            PG8_LDB(B0, 0, 0); PG8_LDB(B1, 0, 1); PG8_SCHED; PG8_LDA(At, 0, 0); PG8_STAGE(PG8_SA(1, 1), a1 + hstepA, voffA);
            PG8_WAIT_V(8); PG8_WAIT_L(0); PG8_BAR; PG8_MMA(0, 0, At, B0); PG8_MMA(0, 1, At, B1); PG8_BAR; PG8_SCHED;
            PG8_LDA(At, 0, 1); PG8_STAGE(PG8_SB(0, 0), b2, voffB); PG8_STAGE(PG8_SB(0, 1), b2 + hstep, voffB); PG8_STAGE(PG8_SA(0, 0), a2, voffA);
            PG8_WAIT_V(8); PG8_WAIT_L(0); PG8_BAR; PG8_MMA(1, 0, At, B0); PG8_MMA(1, 1, At, B1); PG8_BAR; PG8_SCHED;
            PG8_LDB(B0, 1, 0); PG8_LDB(B1, 1, 1); PG8_SCHED; PG8_LDA(At, 1, 0); PG8_STAGE(PG8_SA(0, 1), a2 + hstepA, voffA);
            PG8_WAIT_V(8); PG8_WAIT_L(0); PG8_BAR; PG8_MMA(0, 0, At, B0); PG8_MMA(0, 1, At, B1); PG8_BAR; PG8_SCHED;
            PG8_LDA(At, 1, 1); PG8_STAGE(PG8_SB(1, 0), b3, voffB); PG8_STAGE(PG8_SB(1, 1), b3 + hstep, voffB); PG8_STAGE(PG8_SA(1, 0), a3, voffA);
            PG8_WAIT_V(8); PG8_WAIT_L(0); PG8_BAR; PG8_MMA(1, 0, At, B0); PG8_MMA(1, 1, At, B1); PG8_BAR; PG8_SCHED;
            } else {
            PG8_LDB(B0, 0, 0); PG8_SCHED; PG8_LDA(At, 0, 0); PG8_STAGE(PG8_SA(1, 1), a1 + hstepA, voffA);
            PG8_WAIT_L(8); PG8_BAR; PG8_WAIT_L(0); PG8_MMA(0, 0, At, B0); PG8_BAR; PG8_SCHED;
            PG8_LDB(B1, 0, 1); PG8_STAGE(PG8_SB(0, 0), b2, voffB);
            PG8_BAR; PG8_WAIT_L(0); PG8_MMA(0, 1, At, B1); PG8_BAR;
            PG8_LDA(At, 0, 1); PG8_STAGE(PG8_SA(0, 0), a2, voffA);
            PG8_BAR; PG8_WAIT_L(0); PG8_MMA(1, 0, At, B0); PG8_BAR; PG8_SCHED;
            PG8_STAGE(PG8_SB(0, 1), b2 + hstep, voffB);
            PG8_WAIT_V(6); PG8_BAR; PG8_MMA(1, 1, At, B1); PG8_BAR;
            PG8_LDB(B0, 1, 0); PG8_SCHED; PG8_LDA(At, 1, 0); PG8_STAGE(PG8_SA(0, 1), a2 + hstepA, voffA);
            PG8_WAIT_L(8); PG8_BAR; PG8_WAIT_L(0); PG8_MMA(0, 0, At, B0); PG8_BAR; PG8_SCHED;
            PG8_LDB(B1, 1, 1); PG8_STAGE(PG8_SB(1, 0), b3, voffB);
            PG8_BAR; PG8_WAIT_L(0); PG8_MMA(0, 1, At, B1); PG8_BAR;
            PG8_LDA(At, 1, 1); PG8_STAGE(PG8_SA(1, 0), a3, voffA);
            PG8_BAR; PG8_WAIT_L(0); PG8_MMA(1, 0, At, B0); PG8_BAR; PG8_SCHED;
            PG8_STAGE(PG8_SB(1, 1), b3 + hstep, voffB);
            PG8_WAIT_V(6); PG8_BAR; PG8_MMA(1, 1, At, B1); PG8_BAR;
            }
        }
        if constexpr (ALIGN_EPI) { if (wr == 0) PG8_BAR; }
        if constexpr (!Epi::AFTER_DRAIN) { E(acc, cur, wr, wc, fr, fq); S.done(cur); }
        if (!has_next) break;
#pragma unroll
        for (int a = 0; a < 2; ++a)
#pragma unroll
            for (int b = 0; b < 2; ++b)
#pragma unroll
                for (int m = 0; m < 4; ++m)
#pragma unroll
                    for (int n = 0; n < 2; ++n) acc[a][b][m][n] = (f32x4){0.f, 0.f, 0.f, 0.f};
        cur = nxt; cA = nA; cB = nB; ++ui;
        if constexpr (ALIGN_EPI) { if (wr == 1) PG8_BAR; }
    }
    PG8_WAIT_V(0);
    if constexpr (!ALIGN_EPI) { if (wr == 0) PG8_BAR; }
    PG8_BAR;
    if constexpr (Epi::AFTER_DRAIN) { E.fused(acc, cur, wr, wc, fr, fq, lds, wid, lane); S.done(cur); }
#undef PG8_SA
#undef PG8_SB
#undef PG8_STAGE
#undef PG8_LDA
#undef PG8_LDB
#undef PG8_MMA
#undef PG8_WAIT_V
#undef PG8_WAIT_L
#undef PG8_BAR
#undef PG8_SCHED
}
}

template <class F>
__device__ __forceinline__ void skinny32_unit(unsigned char* lds, const bf16_t* A, const bf16_t* Bt, int K, int n0, F&& f) {
    const int tid = threadIdx.x, wid = tid >> 6, lane = tid & 63, r = lane & 31, h = lane >> 5;
    const int kw = K >> 3, k0 = wid * kw;
    f32x16 acc;
#pragma unroll
    for (int i = 0; i < 16; ++i) acc[i] = 0.f;
    const bf16_t* ap = A + (size_t)r * K + k0 + 8 * h; const bf16_t* bp = Bt + (size_t)(n0 + r) * K + k0 + 8 * h;
    int ks = 0;
    for (; ks + 128 <= kw; ks += 128) {
        bf16x8 af[8], bf[8];
#pragma unroll
        for (int i = 0; i < 8; ++i) { af[i] = *(const bf16x8*)(ap + ks + 16 * i); bf[i] = *(const bf16x8*)(bp + ks + 16 * i); }
        __builtin_amdgcn_sched_barrier(0);
#pragma unroll
        for (int i = 0; i < 8; ++i) acc = __builtin_amdgcn_mfma_f32_32x32x16_bf16(af[i], bf[i], acc, 0, 0, 0);
    }
    if (ks < kw) {
        bf16x8 af[6], bf[6];
#pragma unroll
        for (int i = 0; i < 6; ++i) { const int kk = (ks + 16 * i < kw) ? ks + 16 * i : ks; af[i] = *(const bf16x8*)(ap + kk); bf[i] = *(const bf16x8*)(bp + kk); }
        __builtin_amdgcn_sched_barrier(0);
#pragma unroll
        for (int i = 0; i < 6; ++i) if (ks + 16 * i < kw) acc = __builtin_amdgcn_mfma_f32_32x32x16_bf16(af[i], bf[i], acc, 0, 0, 0);
    }
    float* red = (float*)lds;
#pragma unroll
    for (int i = 0; i < 16; ++i) { const int m = (i & 3) + 8 * (i >> 2) + 4 * h; red[wid * 1024 + m * 32 + r] = acc[i]; }
    __syncthreads();
    for (int e = tid; e < 1024; e += 512) { float s = 0.f;
#pragma unroll
        for (int w = 0; w < 8; ++w) s += red[w * 1024 + e];
        f(e >> 5, n0 + (e & 31), s); }
    __syncthreads();
}

__device__ __forceinline__ int map_wup(int n) { const int pn = n >> 8, w = n & 255; return w < 128 ? 128 * pn + w : DFF + 128 * pn + (w - 128); }
__device__ __forceinline__ int map_win(int n) { return n < 1280 ? n : (n < 3328 ? n + 24 : (n < 3352 ? n - 2048 : -1)); }
struct TrDesc { const float* src; bf16_t* dst; int ldsrc, K, n0, k0, mode; };
__device__ __forceinline__ void tr_load(const TrDesc& d, float (&v)[8]) {
    const int tid = threadIdx.x, nn = tid & 63, kk0 = tid >> 6; const int n = d.n0 + nn; const int sc = (d.mode == 1) ? map_win(n) : (d.mode == 2 ? map_wup(n) : n);
#pragma unroll
    for (int i = 0; i < 8; ++i) { const int kk = kk0 + 8 * i; v[i] = (sc >= 0) ? d.src[(size_t)(d.k0 + kk) * d.ldsrc + sc] : 0.f; }
}
__device__ __forceinline__ void tr_store(float* t, const TrDesc& d, const float (&v)[8]) {
    const int tid = threadIdx.x, nn = tid & 63, kk0 = tid >> 6;
#pragma unroll
    for (int i = 0; i < 8; ++i) t[nn * 65 + kk0 + 8 * i] = v[i];
    __syncthreads();
    const int r = tid >> 3, ks = (tid & 7) * 8; const float* row = t + r * 65 + ks;
    u32x4 w; w.x = cvt_pk_bf16(row[0], row[1]); w.y = cvt_pk_bf16(row[2], row[3]); w.z = cvt_pk_bf16(row[4], row[5]); w.w = cvt_pk_bf16(row[6], row[7]);
    *(u32x4*)(d.dst + (size_t)(d.n0 + r) * d.K + d.k0 + ks) = w;
    __syncthreads();
}
__device__ __forceinline__ void tr_unit(float* t, const float* src, int ldsrc, bf16_t* dst, int K, int n0, int k0, int mode) {
    const int tid = threadIdx.x, nn = tid & 63, kk0 = tid >> 6;
    const int n = n0 + nn; const int sc = (mode == 1) ? map_win(n) : n;
#pragma unroll
    for (int i = 0; i < 8; ++i) { const int kk = kk0 + 8 * i; t[nn * 65 + kk] = (sc >= 0) ? src[(size_t)(k0 + kk) * ldsrc + sc] : 0.f; }
    __syncthreads();
    const int r = tid >> 3, ks = (tid & 7) * 8; const float* row = t + r * 65 + ks;
    u32x4 w; w.x = cvt_pk_bf16(row[0], row[1]); w.y = cvt_pk_bf16(row[2], row[3]); w.z = cvt_pk_bf16(row[4], row[5]); w.w = cvt_pk_bf16(row[6], row[7]);
    *(u32x4*)(dst + (size_t)(n0 + r) * K + k0 + ks) = w;
    __syncthreads();
}

__device__ __forceinline__ TrDesc tr_desc(const Params& p, int list, int v) {
    unsigned char* ws = p.ws;
    bf16_t* WinT = (bf16_t*)(ws + WS_WIN_T); bf16_t* WoutT = (bf16_t*)(ws + WS_WOUT_T); bf16_t* WupT = (bf16_t*)(ws + WS_WUP_T); bf16_t* WdnT = (bf16_t*)(ws + WS_WDN_T);
    bf16_t* W1T = (bf16_t*)(ws + WS_W1T); bf16_t* W2T = (bf16_t*)(ws + WS_W2T);
    if (list == 0) {
        if (v < 896) return TrDesc{p.w_in, WinT, 3352, 1024, (v % 56) * 64, (v / 56) * 64, 1};
        if (v < 1024) { const int x = v - 896; const int kv = x >> 6, w = x & 63; return TrDesc{kv ? p.w1_v : p.w1_k, W1T + (size_t)kv * 128 * 2048, 128, 2048, (w & 1) * 64, (w >> 1) * 64, 0}; }
        const int x = v - 1024; const int kv = x >> 1, w = x & 1; return TrDesc{kv ? p.w2_v : p.w2_k, W2T + (size_t)kv * 64 * 128, 64, 128, 0, w * 64, 0};
    }
    if (list == 1) {
        if (v < 256) return TrDesc{p.w_out, WoutT, 1024, 1024, (v % 16) * 64, (v / 16) * 64, 0};
        const int x = v - 256; return TrDesc{p.w_up, WupT, 5632, 1024, (x % 88) * 64, (x / 88) * 64, 2};
    }
    return TrDesc{p.w_down, WdnT, 1024, 2816, (v % 16) * 64, (v / 16) * 64, 0};
}
__device__ __forceinline__ void tr_stream(const Params& p, unsigned char* lds, int list, int rank, int nranks) {
    const int n = (list == 0) ? 1028 : (list == 1 ? 1664 : 704);
    float* t = (float*)lds; int u = rank; float cur[8], nxt[8];
    if (u < n) { TrDesc dc = tr_desc(p, list, u); tr_load(dc, cur);
        for (;;) { const int un = u + nranks; const bool more = un < n; TrDesc dn = dc; if (more) { dn = tr_desc(p, list, un); tr_load(dn, nxt); }
            tr_store(t, dc, cur);
            if (!more) break;
#pragma unroll
            for (int i = 0; i < 8; ++i) cur[i] = nxt[i];
            dc = dn; u = un; } }
}
__device__ __forceinline__ int idle_rank(int nwg, int G, int bid, int& nranks) { const int R = nwg % G; if (R == 0) { nranks = G; return bid; } nranks = G - R; return bid >= R ? bid - R : -1; }
__device__ __forceinline__ void phase0(const Params& p, unsigned char* lds) {
    const int tid = threadIdx.x, G = gridDim.x, bid = blockIdx.x;
    unsigned char* ws = p.ws;
    bf16_t* WinT = (bf16_t*)(ws + WS_WIN_T); bf16_t* WoutT = (bf16_t*)(ws + WS_WOUT_T); bf16_t* WupT = (bf16_t*)(ws + WS_WUP_T); bf16_t* WdnT = (bf16_t*)(ws + WS_WDN_T);
    bf16_t* W1T = (bf16_t*)(ws + WS_W1T); bf16_t* W2T = (bf16_t*)(ws + WS_W2T);
    float* t = (float*)lds;
    constexpr int U_ADA = 96, U_WIN = 16 * 56, U_WOUT = 16 * 16, U_WUP = 16 * 88, U_WDN = 44 * 16, U_W1 = 2 * 32 * 2, U_W2 = 2 * 2, U_PE = 16;
    constexpr int B_ADA = 0, B_WIN = B_ADA + U_ADA, B_WOUT = B_WIN + U_WIN, B_WUP = B_WOUT + U_WOUT, B_WDN = B_WUP + U_WUP, B_W1 = B_WDN + U_WDN, B_W2 = B_W1 + U_W1, B_PE = B_W2 + U_W2, B_END = B_PE + U_PE;
    tr_stream(p, lds, 0, bid, G);
    for (int u = bid; u < B_END; u += G) {
        if (u >= B_WIN && u < B_PE) continue;
        if (u < B_WIN) {
            const int ks = u / 12, cc = u % 12; float* st = t;
            for (int i = tid; i < 33 * 128; i += 512) { const int row = i >> 7, k = i & 127; const float c = (row == 0) ? p.c_p[ks * 128 + k] : p.c_s[(size_t)(row - 1) * 1024 + ks * 128 + k]; st[i] = c / (1.0f + __expf(-c)); }
            __syncthreads();
            const int col = cc * 512 + tid; float acc[33];
#pragma unroll
            for (int r = 0; r < 33; ++r) acc[r] = 0.f;
            const float* wp = p.w_ada + (size_t)(ks * 128) * 6144 + col;
            for (int k0 = 0; k0 < 128; k0 += 8) { float wv[8];
#pragma unroll
                for (int u8 = 0; u8 < 8; ++u8) wv[u8] = wp[(size_t)(k0 + u8) * 6144];
                __builtin_amdgcn_sched_barrier(0);
#pragma unroll
                for (int u8 = 0; u8 < 8; ++u8)
#pragma unroll
                    for (int r = 0; r < 33; ++r) acc[r] += st[r * 128 + k0 + u8] * wv[u8]; }
            float* mp = (float*)(ws + WS_MODP) + (size_t)ks * 33 * 6144 + col;
#pragma unroll
            for (int r = 0; r < 33; ++r) mp[(size_t)r * 6144] = acc[r];
            __syncthreads();
        } else if (u < B_WOUT) { const int v = u - B_WIN; tr_unit(t, p.w_in, 3352, WinT, 1024, (v % 56) * 64, (v / 56) * 64, 1); }
        else if (u < B_WUP) { const int v = u - B_WOUT; tr_unit(t, p.w_out, 1024, WoutT, 1024, (v % 16) * 64, (v / 16) * 64, 0); }
        else if (u < B_WDN) { const int v = u - B_WUP; tr_unit(t, p.w_up, 5632, WupT, 1024, (v % 88) * 64, (v / 88) * 64, 0); }
        else if (u < B_W1) { const int v = u - B_WDN; tr_unit(t, p.w_down, 1024, WdnT, 2816, (v % 16) * 64, (v / 16) * 64, 0); }
        else if (u < B_W2) { const int v = u - B_W1; const int kv = v >> 6, w = v & 63; tr_unit(t, kv ? p.w1_v : p.w1_k, 128, W1T + (size_t)kv * 128 * 2048, 2048, (w & 1) * 64, (w >> 1) * 64, 0); }
        else if (u < B_PE) { const int v = u - B_W2; const int kv = v >> 1, w = v & 1; tr_unit(t, kv ? p.w2_v : p.w2_k, 64, W2T + (size_t)kv * 64 * 128, 128, 0, w * 64, 0); }
        else {
            const int kv = (u - B_PE) >> 3, sl = (u - B_PE) & 7; const float* pe = kv ? p.pe_v : p.pe_k; const float* w1 = kv ? p.w1_v : p.w1_k;
            const int hh = tid & 127, q = tid >> 7; float s = 0.f; const int kb = sl * 256 + q * 64;
            for (int k0 = kb; k0 < kb + 64; k0 += 16) { float wv[16], pv[16];
#pragma unroll
                for (int i = 0; i < 16; ++i) { wv[i] = w1[(size_t)(k0 + i) * 128 + hh]; pv[i] = pe[k0 + i]; }
#pragma unroll
                for (int i = 0; i < 16; ++i) s += pv[i] * wv[i]; }
            t[tid] = s; __syncthreads();
            if (tid < 128) ((float*)(ws + WS_PET))[(kv * 8 + sl) * 128 + tid] = t[tid] + t[tid + 128] + t[tid + 256] + t[tid + 384];
            __syncthreads();
        }
    }
    const int gt = bid * 512 + tid, GT = G * 512;
    if (gt < 2) ((unsigned*)(ws + WS_KCM))[gt] = 0u;
    {
        float* rc = (float*)(ws + WS_ROPE); float* rs = rc + (size_t)16385 * 32;
        for (int i = gt; i < 16385 * 32; i += GT) { const int pos = i >> 5, j = i & 31;
            const float inv = powf(10000.0f, -(float)j / 32.0f); const float ang = (float)pos * inv;
            const double a = (double)ang; const double k = rint(a * 0.15915494309189535); const double rr = a - k * 6.283185307179586;
            const float r = (float)rr; rc[i] = cosf(r); rs[i] = sinf(r); }
    }
    {
        float* bl = (float*)(ws + WS_BIAS);
        for (int i = gt; i < 8 * 1025; i += GT) { const int hh = i / 1025, n = i % 1025; int b;
            if (n < 16) b = n; else { const float v = logf((float)n / 16.0f) / 4.1588830833596715f * 16.0f; b = 16 + (int)v; if (b > 31) b = 31; }
            bl[hh * 1032 + n] = p.table[b * 8 + hh]; }
        if (gt < 8) { float m = -1e30f; for (int b = 0; b < 32; ++b) m = fmaxf(m, p.table[b * 8 + gt]); bl[gt * 1032 + 1025] = m; }
    }
    {
        bf16_t* mix = (bf16_t*)(ws + WS_MIX);
#if DBG_SKIP_MIX
        for (int i = gt; i < SEQ * 128; i += GT) { const int row = i >> 7, c8 = i & 127; unsigned hsh = (unsigned)(row * 2654435761u) ^ (unsigned)(c8 * 40503u); hsh ^= hsh >> 13; hsh *= 0x5bd1e995u; hsh ^= hsh >> 15; const unsigned v = 0x3e803e80u + (hsh & 0xffu) * 0x00010001u + ((hsh & 0x100u) << 7) + ((hsh & 0x200u) << 22); *(u32x4*)(mix + (size_t)row * 1024 + c8 * 8) = (u32x4){v, v ^ 0x80000000u, v + 0x00100010u, v ^ 0x00008000u}; }
#endif
        if (DBG_NO_NSA) for (int i = gt; i < (SEQ + NB) * 64; i += GT) { const int row = i >> 6, c8 = i & 63; *(u32x4*)(mix + (size_t)row * 1024 + c8 * 8) = (u32x4){0u, 0u, 0u, 0u}; }
    }
    {
        for (int i = gt; i < NB * DFF; i += GT) { const int b = i / DFF, c = i % DFF; p.out[O_CONV_S + (size_t)b * 2 * DFF + c] = p.st_conv[(size_t)b * 2 * DFF + DFF + c]; }
    }
    {
        const f32x4* src = (const f32x4*)p.st_win; f32x4* dst = (f32x4*)(p.out + O_WIN_S);
        for (int i = gt; i < NB * 511 * 64; i += GT) { const int b = i / (511 * 64), rem = i % (511 * 64); dst[(size_t)b * 512 * 64 + rem] = src[(size_t)b * 512 * 64 + 64 + rem]; }
    }
}

__device__ __forceinline__ void norm_row_store(const float* xr, const float* sA, const float* sB, bf16_t* dst, int lane) {
    f32x4 v[4]; float ss = 0.f;
#pragma unroll
    for (int j = 0; j < 4; ++j) { v[j] = *(const f32x4*)(xr + lane * 4 + 256 * j); ss += v[j][0] * v[j][0] + v[j][1] * v[j][1] + v[j][2] * v[j][2] + v[j][3] * v[j][3]; }
    ss = wave_sum(ss); const float rstd = rsqrtf(ss * (1.0f / 1024.0f) + 1e-6f);
#pragma unroll
    for (int j = 0; j < 4; ++j) { const int c = lane * 4 + 256 * j; const f32x4 a = *(const f32x4*)(sA + c), b = *(const f32x4*)(sB + c);
        u32x2 w; w.x = cvt_pk_bf16(v[j][0] * rstd * a[0] + b[0], v[j][1] * rstd * a[1] + b[1]); w.y = cvt_pk_bf16(v[j][2] * rstd * a[2] + b[2], v[j][3] * rstd * a[3] + b[3]);
        *(u32x2*)(dst + c) = w; }
}
__device__ __forceinline__ void build_mod_partial(const Params& p, float* sA, float* sB, int modrow, const float* gvec) {
    const float* mp = (const float*)(p.ws + WS_MODP);
    for (int c = threadIdx.x; c < 1024; c += 512) { float sc = p.b_ada[1024 + c], sh = p.b_ada[c];
#pragma unroll
        for (int ks = 0; ks < 8; ++ks) { const float* q = mp + ((size_t)ks * 33 + modrow) * 6144; sc += q[1024 + c]; sh += q[c]; }
        sA[c] = gvec[c] * (1.0f + sc); sB[c] = sh; }
}
__device__ __forceinline__ void phase1(const Params& p, unsigned char* lds) {
    const int tid = threadIdx.x, wid = tid >> 6, lane = tid & 63, G = gridDim.x, bid = blockIdx.x;
    float* sA = (float*)lds; float* sB = sA + 1024;
    bf16_t* HN = (bf16_t*)(p.ws + WS_HN);
    bool built = false;
    for (int u = bid; u < 256 + NB; u += G) {
        if (u < 256) {
            if (!built) { build_mod_partial(p, sA, sB, 0, p.g_mix); __syncthreads(); built = true; }
            for (int i = 0; i < 8; ++i) { const int row = u * 64 + wid * 8 + i; norm_row_store(p.x_p + (size_t)row * 1024, sA, sB, HN + (size_t)row * 1024, lane); }
        } else {
            __syncthreads(); const int b = u - 256; build_mod_partial(p, sA, sB, 1 + b, p.g_mix); __syncthreads(); built = false;
            if (wid == 0) norm_row_store(p.x_s + (size_t)b * 1024, sA, sB, HN + (size_t)(SEQ + b) * 1024, lane);
            __syncthreads();
        }
    }
    const float* mp = (const float*)(p.ws + WS_MODP); float* mod = (float*)(p.ws + WS_MOD);
    for (int i = bid * 512 + tid; i < 33 * 6144; i += G * 512) { float s = p.b_ada[i % 6144];
#pragma unroll
        for (int ks = 0; ks < 8; ++ks) s += mp[(size_t)ks * 33 * 6144 + i];
        mod[i] = s; }
}

struct EpiWin {
    static constexpr bool PERM = false, AFTER_DRAIN = false;
    unsigned char* ws; float* out;
    __device__ __forceinline__ void operator()(const f32x4 (&acc)[2][2][4][2], const pg8::Unit& u, int wr, int wc, int fr, int fq) const {
        const int pn = u.pn; const int row0 = u.pm * 256 + wr * 64 + fr; const int cb = wc * 32 + 4 * fq;
        if (pn == 13) {
            if (wc == 0) { float* gts = (float*)(ws + WS_GATES);
#pragma unroll
                for (int ai = 0; ai < 2; ++ai)
#pragma unroll
                    for (int m = 0; m < 4; ++m) { const int row = row0 + ai * 128 + m * 16;
#pragma unroll
                        for (int n = 0; n < 2; ++n) { const int c = n * 16 + 4 * fq; if (c < 24) { const f32x4 v = acc[ai][0][m][n];
                            *(f32x4*)(gts + (size_t)row * 24 + c) = (f32x4){sigmoidf_(v[0]), sigmoidf_(v[1]), sigmoidf_(v[2]), sigmoidf_(v[3])}; } } } }
            return;
        }
        bf16_t* bdst; int ld; float sc = 1.f; float* fdst = nullptr; int rmin = 0;
        if (pn < 2) { bdst = (bf16_t*)(ws + WS_QA) + pn * 256; ld = 512; sc = 0.125f; }
        else if (pn == 2) { bdst = (bf16_t*)(ws + WS_KVC); ld = 256; fdst = out + O_CMP_P; }
        else if (pn == 3) { bdst = (bf16_t*)(ws + WS_KVS); ld = 256; fdst = out + O_SLC_P; }
        else if (pn == 4) { bdst = (bf16_t*)(ws + WS_KVW); ld = 256; fdst = out + O_WIN_P - (size_t)15872 * 256; rmin = 15872; }
        else if (pn < 7) { bdst = (bf16_t*)(ws + WS_QR) + (pn - 5) * 256; ld = 512; }
        else if (pn < 9) { bdst = (bf16_t*)(ws + WS_KR) + (pn - 7) * 256; ld = 512; }
        else if (pn < 11) { bdst = (bf16_t*)(ws + WS_VR) + (pn - 9) * 256; ld = 512; }
        else { bdst = (bf16_t*)(ws + WS_GR) + (pn - 11) * 256; ld = 512; }
#pragma unroll
        for (int ai = 0; ai < 2; ++ai)
#pragma unroll
            for (int m = 0; m < 4; ++m) { const int row = row0 + ai * 128 + m * 16;
#pragma unroll
                for (int bj = 0; bj < 2; ++bj)
#pragma unroll
                    for (int n = 0; n < 2; ++n) { const int c = cb + bj * 128 + n * 16; const f32x4 v = acc[ai][bj][m][n];
                        u32x2 w; w.x = cvt_pk_bf16(v[0] * sc, v[1] * sc); w.y = cvt_pk_bf16(v[2] * sc, v[3] * sc);
                        *(u32x2*)(bdst + (size_t)row * ld + c) = w;
                        if (fdst != nullptr && row >= rmin) *(f32x4*)(fdst + (size_t)row * 256 + c) = v; } }
    }
};
__device__ __forceinline__ void phase2(const Params& p, unsigned char* lds) {
    const int G = gridDim.x, bid = blockIdx.x;
    const bf16_t* HN = (const bf16_t*)(p.ws + WS_HN); const bf16_t* WinT = (const bf16_t*)(p.ws + WS_WIN_T);
    {
        pg8::Gemm g{HN, WinT, SEQ, NZ, 1024}; pg8::StaticOrder S; S.init(SEQ, NZ, G, bid);
        EpiWin E{p.ws, p.out};
        pg8::gemm_phase<EpiWin, pg8::StaticOrder, true, true>((LAS unsigned char*)lds, g, S, E);
    }
    __syncthreads();
    float* zs = (float*)(p.ws + WS_ZS); float* out = p.out;
    for (int u = G - 1 - bid; u < NZ / 32; u += G) {
        skinny32_unit(lds, HN + (size_t)SEQ * 1024, WinT, 1024, u * 32, [&](int m, int n, float v) {
            zs[(size_t)m * NZ + n] = v;
            if (n >= ZC_KVC && n < ZC_KVS) out[O_CMP_S + (size_t)m * 256 + (n - ZC_KVC)] = v;
            else if (n >= ZC_KVS && n < ZC_KVW) out[O_SLC_S + (size_t)m * 256 + (n - ZC_KVS)] = v;
            else if (n >= ZC_KVW && n < ZC_QR) out[O_WIN_S + ((size_t)m * 512 + 511) * 256 + (n - ZC_KVW)] = v;
        });
    }
    { int nr; const int rk = idle_rank((SEQ / 256) * (NZ / 256), G, bid, nr); if (rk >= 0) tr_stream(p, lds, 1, rk, nr); }
}


__device__ __forceinline__ float log2_gamma(int h) { return log1pf(-exp2f(-5.0f - (float)h)) * 1.4426950408889634f; }

__device__ __forceinline__ void ret_uc_unit(const Params& p, unsigned char* lds, int c, int h) {
    int tid_op = threadIdx.x; asm volatile("" : "+v"(tid_op));
    const int tid = tid_op, wid = tid >> 6, lane = tid & 63;
    bf16_t* KT = (bf16_t*)lds;
    bf16_t* VT = KT + 64 * 136;
    const bf16_t* KR = (const bf16_t*)(p.ws + WS_KR); const bf16_t* VR = (const bf16_t*)(p.ws + WS_VR);
    const float* rc = (const float*)(p.ws + WS_ROPE); const float* rs = rc + (size_t)16385 * 32;
    const float l2g = log2_gamma(h);
    {
        const int m = tid & 127, jq = tid >> 7; const int tok = c * 128 + m;
        const bf16x8 x1 = *(const bf16x8*)(KR + (size_t)tok * 512 + h * 64 + jq * 8), x2 = *(const bf16x8*)(KR + (size_t)tok * 512 + h * 64 + 32 + jq * 8);
        const float sc = 0.125f * exp2f(-(float)m * l2g);
#pragma unroll
        for (int e = 0; e < 8; ++e) { const int j = jq * 8 + e; const float cs = rc[(size_t)tok * 32 + j], sn = rs[(size_t)tok * 32 + j];
            const float a = bf2f((bf16_t)x1[e]), b = bf2f((bf16_t)x2[e]);
            KT[j * 136 + m] = f2bf((a * cs - b * sn) * sc); KT[(j + 32) * 136 + m] = f2bf((a * sn + b * cs) * sc); }
        const bf16x8 v0 = *(const bf16x8*)(VR + (size_t)tok * 512 + h * 64 + jq * 16), v1 = *(const bf16x8*)(VR + (size_t)tok * 512 + h * 64 + jq * 16 + 8);
#pragma unroll
        for (int e = 0; e < 8; ++e) { VT[(jq * 16 + e) * 136 + m] = (bf16_t)v0[e]; VT[(jq * 16 + 8 + e) * 136 + m] = (bf16_t)v1[e]; }
    }
    __syncthreads();
    if (wid < 4) {
        const int r = lane & 31, hh = lane >> 5, dk0 = (wid >> 1) * 32, dv0 = (wid & 1) * 32;
        f32x16 acc;
#pragma unroll
        for (int i = 0; i < 16; ++i) acc[i] = 0.f;
#pragma unroll
        for (int ks = 0; ks < 8; ++ks) { const bf16x8 a = *(const bf16x8*)(KT + (dk0 + r) * 136 + ks * 16 + 8 * hh), b = *(const bf16x8*)(VT + (dv0 + r) * 136 + ks * 16 + 8 * hh);
            acc = __builtin_amdgcn_mfma_f32_32x32x16_bf16(a, b, acc, 0, 0, 0); }
        const float g127 = exp2f(127.0f * l2g);
        float* uc = (float*)(p.ws + WS_UC) + ((size_t)c * 8 + h) * 4096;
#pragma unroll
        for (int i = 0; i < 16; ++i) { const int dk = dk0 + (i & 3) + 8 * (i >> 2) + 4 * hh; uc[dk * 64 + dv0 + r] = acc[i] * g127; }
    }
    __syncthreads();
}

__device__ __forceinline__ void ret_scan(const Params& p, int item  ) {
    const int h = item >> 10; const float dc = exp2f(128.0f * log2_gamma(h));
    const f32x4* uc = (const f32x4*)(p.ws + WS_UC) + item; f32x4* sc = (f32x4*)(p.ws + WS_SC) + item;
    f32x4 s = (f32x4){0.f, 0.f, 0.f, 0.f};
    for (int c0 = 0; c0 < 128; c0 += 8) { f32x4 u[8];
#pragma unroll
        for (int i = 0; i < 8; ++i) u[i] = uc[(size_t)(c0 + i) * 8192];
#pragma unroll
        for (int i = 0; i < 8; ++i) { sc[(size_t)(c0 + i) * 8192] = s; s = s * dc + u[i]; } }
    ((f32x4*)(p.out + O_RET_P))[item] = s;
}

__device__ __forceinline__ void ret_sample_wave(const Params& p, int b, int h, int lane) {
    const float* zs = (const float*)(p.ws + WS_ZS) + (size_t)b * NZ;
    const float* rc = (const float*)(p.ws + WS_ROPE) + (size_t)16384 * 32; const float* rs = rc + (size_t)16385 * 32;
    const float gam = exp2f(log2_gamma(h));
    const int j = lane & 31; const float cs = rc[j], sn = rs[j];
    const float q1 = zs[ZC_QR + h * 64 + j], q2 = zs[ZC_QR + h * 64 + 32 + j], k1 = zs[ZC_KR + h * 64 + j], k2 = zs[ZC_KR + h * 64 + 32 + j];
    const float qd = (lane < 32) ? (q1 * cs - q2 * sn) : (q1 * sn + q2 * cs);
    const float kd = ((lane < 32) ? (k1 * cs - k2 * sn) : (k1 * sn + k2 * cs)) * 0.125f;
    const float v = zs[ZC_VR + h * 64 + lane];
    const float* s0 = p.st_ret + ((size_t)b * 8 + h) * 4096; float* so = p.out + O_RET_S + ((size_t)b * 8 + h) * 4096;
    float o = 0.f;
    for (int dk = 0; dk < 64; ++dk) { const float kk = __shfl(kd, dk), qq = __shfl(qd, dk); const float s = gam * s0[dk * 64 + lane] + kk * v; so[dk * 64 + lane] = s; o += qq * s; }
    const float mu = wave_sum(o) * (1.0f / 64.0f); const float d = o - mu; const float var = wave_sum(d * d) * (1.0f / 64.0f);
    const float g = zs[ZC_GR + h * 64 + lane]; const float y = d * rsqrtf(var + 1e-5f) * p.gn_g[h * 64 + lane] * (g / (1.0f + __expf(-g)));
    ((bf16_t*)(p.ws + WS_MIX))[(size_t)(SEQ + b) * 1024 + 512 + h * 64 + lane] = f2bf(y);
}

__device__ __forceinline__ void ret_out_unit(const Params& p, unsigned char* lds, int c, int hp) {
    int tid_op = threadIdx.x; asm volatile("" : "+v"(tid_op));
    const int tid = tid_op, wid = tid >> 6, lane = tid & 63;
    constexpr int HB = 63488;
    const bf16_t* QR = (const bf16_t*)(p.ws + WS_QR); const bf16_t* KR = (const bf16_t*)(p.ws + WS_KR); const bf16_t* VR = (const bf16_t*)(p.ws + WS_VR);
    const float* rc = (const float*)(p.ws + WS_ROPE); const float* rs = rc + (size_t)16385 * 32;
    for (int hl = 0; hl < 2; ++hl) {
        const int h = hp * 2 + hl; const float l2g = log2_gamma(h);
        bf16_t* Qs = (bf16_t*)(lds + hl * HB); bf16_t* Ks = Qs + 128 * 72; bf16_t* VT = Ks + 128 * 72; bf16_t* ST = VT + 64 * 136;
        const int m = tid & 127, jq = tid >> 7; const int tok = c * 128 + m;
        const float qs = exp2f((float)m * l2g), ks_ = 0.125f * exp2f(-(float)m * l2g);
        float cs[8], sn[8];
#pragma unroll
        for (int e = 0; e < 8; ++e) { cs[e] = rc[(size_t)tok * 32 + jq * 8 + e]; sn[e] = rs[(size_t)tok * 32 + jq * 8 + e]; }
        {
            const bf16x8 x1 = *(const bf16x8*)(QR + (size_t)tok * 512 + h * 64 + jq * 8), x2 = *(const bf16x8*)(QR + (size_t)tok * 512 + h * 64 + 32 + jq * 8);
            u32x4 w1, w2; float o1[8], o2[8];
#pragma unroll
            for (int e = 0; e < 8; ++e) { const float a = bf2f((bf16_t)x1[e]), b = bf2f((bf16_t)x2[e]); o1[e] = (a * cs[e] - b * sn[e]) * qs; o2[e] = (a * sn[e] + b * cs[e]) * qs; }
            w1.x = cvt_pk_bf16(o1[0], o1[1]); w1.y = cvt_pk_bf16(o1[2], o1[3]); w1.z = cvt_pk_bf16(o1[4], o1[5]); w1.w = cvt_pk_bf16(o1[6], o1[7]);
            w2.x = cvt_pk_bf16(o2[0], o2[1]); w2.y = cvt_pk_bf16(o2[2], o2[3]); w2.z = cvt_pk_bf16(o2[4], o2[5]); w2.w = cvt_pk_bf16(o2[6], o2[7]);
            *(u32x4*)(Qs + m * 72 + jq * 8) = w1; *(u32x4*)(Qs + m * 72 + 32 + jq * 8) = w2;
        }
        {
            const bf16x8 x1 = *(const bf16x8*)(KR + (size_t)tok * 512 + h * 64 + jq * 8), x2 = *(const bf16x8*)(KR + (size_t)tok * 512 + h * 64 + 32 + jq * 8);
            u32x4 w1, w2; float o1[8], o2[8];
#pragma unroll
            for (int e = 0; e < 8; ++e) { const float a = bf2f((bf16_t)x1[e]), b = bf2f((bf16_t)x2[e]); o1[e] = (a * cs[e] - b * sn[e]) * ks_; o2[e] = (a * sn[e] + b * cs[e]) * ks_; }
            w1.x = cvt_pk_bf16(o1[0], o1[1]); w1.y = cvt_pk_bf16(o1[2], o1[3]); w1.z = cvt_pk_bf16(o1[4], o1[5]); w1.w = cvt_pk_bf16(o1[6], o1[7]);
            w2.x = cvt_pk_bf16(o2[0], o2[1]); w2.y = cvt_pk_bf16(o2[2], o2[3]); w2.z = cvt_pk_bf16(o2[4], o2[5]); w2.w = cvt_pk_bf16(o2[6], o2[7]);
            *(u32x4*)(Ks + m * 72 + jq * 8) = w1; *(u32x4*)(Ks + m * 72 + 32 + jq * 8) = w2;
        }
        {
            const bf16x8 v0 = *(const bf16x8*)(VR + (size_t)tok * 512 + h * 64 + jq * 16), v1 = *(const bf16x8*)(VR + (size_t)tok * 512 + h * 64 + jq * 16 + 8);
#pragma unroll
            for (int e = 0; e < 8; ++e) { VT[(jq * 16 + e) * 136 + m] = (bf16_t)v0[e]; VT[(jq * 16 + 8 + e) * 136 + m] = (bf16_t)v1[e]; }
        }
        {
            const float gam = exp2f(l2g); const float* sc = (const float*)(p.ws + WS_SC) + ((size_t)c * 8 + h) * 4096;
            const int dk = tid >> 3, dvq = tid & 7; const f32x4 a = *(const f32x4*)(sc + dk * 64 + dvq * 8), b = *(const f32x4*)(sc + dk * 64 + dvq * 8 + 4);
#pragma unroll
            for (int e = 0; e < 4; ++e) { ST[(dvq * 8 + e) * 72 + dk] = f2bf(a[e] * gam); ST[(dvq * 8 + 4 + e) * 72 + dk] = f2bf(b[e] * gam); }
        }
    }
    __syncthreads();
    {
        const int hl = wid >> 2, nt = wid & 3, h = hp * 2 + hl, r = lane & 31, hh = lane >> 5;
        const bf16_t* Qs = (const bf16_t*)(lds + hl * HB); const bf16_t* Ks = Qs + 128 * 72; const bf16_t* VT = Ks + 128 * 72; const bf16_t* ST = VT + 64 * 136;
        bf16x8 qf[4];
#pragma unroll
        for (int ks = 0; ks < 4; ++ks) qf[ks] = *(const bf16x8*)(Qs + (nt * 32 + r) * 72 + ks * 16 + 8 * hh);
        f32x16 o0, o1;
#pragma unroll
        for (int i = 0; i < 16; ++i) { o0[i] = 0.f; o1[i] = 0.f; }
#pragma unroll
        for (int ks = 0; ks < 4; ++ks) { const bf16x8 a0 = *(const bf16x8*)(ST + r * 72 + ks * 16 + 8 * hh), a1 = *(const bf16x8*)(ST + (32 + r) * 72 + ks * 16 + 8 * hh);
            o0 = __builtin_amdgcn_mfma_f32_32x32x16_bf16(a0, qf[ks], o0, 0, 0, 0); o1 = __builtin_amdgcn_mfma_f32_32x32x16_bf16(a1, qf[ks], o1, 0, 0, 0); }
        for (int mt = 0; mt <= nt; ++mt) {
            f32x16 at;
#pragma unroll
            for (int i = 0; i < 16; ++i) at[i] = 0.f;
#pragma unroll
            for (int ks = 0; ks < 4; ++ks) { const bf16x8 a = *(const bf16x8*)(Ks + (mt * 32 + r) * 72 + ks * 16 + 8 * hh); at = __builtin_amdgcn_mfma_f32_32x32x16_bf16(a, qf[ks], at, 0, 0, 0); }
            if (mt == nt) {
#pragma unroll
                for (int i = 0; i < 16; ++i) { const int mrow = (i & 3) + 8 * (i >> 2) + 4 * hh; if (mrow > r) at[i] = 0.f; }
            }
#pragma unroll
            for (int s = 0; s < 2; ++s) {
                bf16x8 pb; u32x4 pw;
                pw.x = cvt_pk_bf16(at[8 * s + 0], at[8 * s + 1]); pw.y = cvt_pk_bf16(at[8 * s + 2], at[8 * s + 3]); pw.z = cvt_pk_bf16(at[8 * s + 4], at[8 * s + 5]); pw.w = cvt_pk_bf16(at[8 * s + 6], at[8 * s + 7]);
                pb = __builtin_bit_cast(bf16x8, pw);
                const int mb = mt * 32 + 16 * s + 4 * hh;
                u32x2 l0 = *(const u32x2*)(VT + r * 136 + mb), l1 = *(const u32x2*)(VT + r * 136 + mb + 8), h0 = *(const u32x2*)(VT + (32 + r) * 136 + mb), h1 = *(const u32x2*)(VT + (32 + r) * 136 + mb + 8);
                const bf16x8 a0 = __builtin_bit_cast(bf16x8, (u32x4){l0.x, l0.y, l1.x, l1.y}), a1 = __builtin_bit_cast(bf16x8, (u32x4){h0.x, h0.y, h1.x, h1.y});
                o0 = __builtin_amdgcn_mfma_f32_32x32x16_bf16(a0, pb, o0, 0, 0, 0); o1 = __builtin_amdgcn_mfma_f32_32x32x16_bf16(a1, pb, o1, 0, 0, 0);
            }
        }
        float s = 0.f;
#pragma unroll
        for (int i = 0; i < 16; ++i) s += o0[i] + o1[i];
        s += __shfl_xor(s, 32); const float mu = s * (1.0f / 64.0f);
        float q = 0.f;
#pragma unroll
        for (int i = 0; i < 16; ++i) { const float d0 = o0[i] - mu, d1 = o1[i] - mu; q += d0 * d0 + d1 * d1; }
        q += __shfl_xor(q, 32); const float rstd = rsqrtf(q * (1.0f / 64.0f) + 1e-5f);
        const int tok = c * 128 + nt * 32 + r;
        const bf16_t* GR = (const bf16_t*)(p.ws + WS_GR) + (size_t)tok * 512 + h * 64; bf16_t* mix = (bf16_t*)(p.ws + WS_MIX) + (size_t)tok * 1024 + 512 + h * 64;
#pragma unroll
        for (int t2 = 0; t2 < 2; ++t2)
#pragma unroll
            for (int gq = 0; gq < 4; ++gq) { const int dv = t2 * 32 + 8 * gq + 4 * hh; const u32x2 gw = *(const u32x2*)(GR + dv); const f32x4 gn = *(const f32x4*)(p.gn_g + h * 64 + dv);
                float y[4];
#pragma unroll
                for (int e = 0; e < 4; ++e) { const float ov = t2 ? o1[gq * 4 + e] : o0[gq * 4 + e]; const unsigned gb = (e < 2) ? gw.x : gw.y; const float g = __uint_as_float((e & 1) ? (gb & 0xffff0000u) : (gb << 16));
                    y[e] = (ov - mu) * rstd * gn[e] * (g / (1.0f + __expf(-g))); }
                u32x2 w; w.x = cvt_pk_bf16(y[0], y[1]); w.y = cvt_pk_bf16(y[2], y[3]); *(u32x2*)(mix + dv) = w; }
    }
    __syncthreads();
}


__device__ __forceinline__ float gelu_tanh(float x) { const float u = 0.7978845608028654f * (x + 0.044715f * x * x * x); const float e = __expf(2.0f * u); const float th = 1.0f - 2.0f / (e + 1.0f); return 0.5f * x * (1.0f + th); }

__device__ __forceinline__ void cmp_prompt_unit(const Params& p, unsigned char* lds, int kv, int n0) {
    int tid_op = threadIdx.x; asm volatile("" : "+v"(tid_op));
    const int tid = tid_op, wid = tid >> 6, lane = tid & 63, r = lane & 31, hh = lane >> 5;
    const bf16_t* KVC = (const bf16_t*)(p.ws + WS_KVC); const bf16_t* W1T = (const bf16_t*)(p.ws + WS_W1T) + (size_t)kv * 128 * 2048; const bf16_t* W2T = (const bf16_t*)(p.ws + WS_W2T) + (size_t)kv * 64 * 128;
    float* red = (float*)lds;
    bf16_t* hid = (bf16_t*)(lds + 32768);
    const int ht = wid & 3, kh = wid >> 2;
    const int n = n0 + (r >> 1), g = r & 1;
    const int nn = n < 1023 ? n : 1022;
    f32x16 acc;
#pragma unroll
    for (int i = 0; i < 16; ++i) acc[i] = 0.f;
    const bf16_t* ap = KVC + (size_t)(16 * nn + 16 * kh) * 256 + kv * 128 + g * 64 + 8 * hh;
    const bf16_t* bp = W1T + (size_t)(ht * 32 + r) * 2048 + (16 * kh) * 64 + 8 * hh;
    for (int l0 = 0; l0 < 16; l0 += 4) {
        bf16x8 af[4][4], bfr[4][4];
#pragma unroll
        for (int li = 0; li < 4; ++li)
#pragma unroll
            for (int ks = 0; ks < 4; ++ks) { af[li][ks] = *(const bf16x8*)(ap + (size_t)(l0 + li) * 256 + ks * 16); bfr[li][ks] = *(const bf16x8*)(bp + (l0 + li) * 64 + ks * 16); }
        __builtin_amdgcn_sched_barrier(0);
#pragma unroll
        for (int li = 0; li < 4; ++li)
#pragma unroll
            for (int ks = 0; ks < 4; ++ks) acc = __builtin_amdgcn_mfma_f32_32x32x16_bf16(af[li][ks], bfr[li][ks], acc, 0, 0, 0);
    }
#pragma unroll
    for (int i = 0; i < 16; ++i) { const int m = (i & 3) + 8 * (i >> 2) + 4 * hh; red[wid * 1024 + m * 32 + r] = acc[i]; }
    __syncthreads();
    const float* pet = (const float*)(p.ws + WS_PET) + kv * 1024;
    float ptsum = 0.f;
#pragma unroll
    for (int s8 = 0; s8 < 8; ++s8) ptsum += pet[s8 * 128 + (tid & 127)];
    for (int e = tid; e < 4096; e += 512) { const int m = e >> 7, hc = e & 127; const int t4 = hc >> 5, c = hc & 31;
        const float v = red[t4 * 1024 + m * 32 + c] + red[(4 + t4) * 1024 + m * 32 + c] + ptsum; hid[m * 136 + hc] = f2bf(gelu_tanh(v)); }
    __syncthreads();
    if (wid < 2) {
        f32x16 o;
#pragma unroll
        for (int i = 0; i < 16; ++i) o[i] = 0.f;
        bf16x8 w2f[8];
#pragma unroll
        for (int ks = 0; ks < 8; ++ks) w2f[ks] = *(const bf16x8*)(W2T + (size_t)(wid * 32 + r) * 128 + ks * 16 + 8 * hh);
#pragma unroll
        for (int ks = 0; ks < 8; ++ks) { const bf16x8 a = *(const bf16x8*)(hid + r * 136 + ks * 16 + 8 * hh); o = __builtin_amdgcn_mfma_f32_32x32x16_bf16(a, w2f[ks], o, 0, 0, 0); }
        bf16_t* dst = (bf16_t*)(p.ws + WS_KCMP) + (size_t)kv * 1024 * 128;
#pragma unroll
        for (int i = 0; i < 16; ++i) { const int m = (i & 3) + 8 * (i >> 2) + 4 * hh; const int nb = n0 + (m >> 1), gg = m & 1;
            dst[((size_t)nb * 2 + gg) * 64 + wid * 32 + r] = (nb < 1023) ? f2bf(o[i]) : (bf16_t)0; }
    }
    __syncthreads();
    if (kv == 0 && tid < 32) {
        const int nb = n0 + (tid >> 1), gg = tid & 1; const bf16_t* row = (const bf16_t*)(p.ws + WS_KCMP) + ((size_t)nb * 2 + gg) * 64; float ss = 0.f;
#pragma unroll
        for (int d8 = 0; d8 < 8; ++d8) { const bf16x8 v = *(const volatile bf16x8*)(row + d8 * 8);
#pragma unroll
            for (int e = 0; e < 8; ++e) { const float f = bf2f((bf16_t)v[e]); ss += f * f; } }
        atomicMax((unsigned*)(p.ws + WS_KCM) + gg, __float_as_uint(sqrtf(ss))); }
    __syncthreads();
}

__device__ __forceinline__ void vst_unit(const Params& p, unsigned char* lds, int s0) {
    int tid_op = threadIdx.x; asm volatile("" : "+v"(tid_op));
    const int tid = tid_op; bf16_t* t = (bf16_t*)lds;
    const bf16_t* KVS = (const bf16_t*)(p.ws + WS_KVS); bf16_t* VST = (bf16_t*)(p.ws + WS_VST);
    for (int i = tid; i < 64 * 16; i += 512) { const int s = i >> 4, c8 = i & 15; const bf16x8 v = *(const bf16x8*)(KVS + (size_t)(s0 + s) * 256 + 128 + c8 * 8);
#pragma unroll
        for (int e = 0; e < 8; ++e) t[(c8 * 8 + e) * 72 + s] = (bf16_t)v[e]; }
    __syncthreads();
    for (int i = tid; i < 128 * 8; i += 512) { const int c = i >> 3, s8 = i & 7; *(u32x4*)(VST + (size_t)c * SEQ + s0 + s8 * 8) = *(const u32x4*)(t + c * 72 + s8 * 8); }
    float* nrm = (float*)(lds + 32768);
    if (tid < 128) { const int key = tid & 63, gg = tid >> 6; float ss = 0.f;
#pragma unroll
        for (int d8 = 0; d8 < 8; ++d8) { const bf16x8 v = *(const bf16x8*)(KVS + (size_t)(s0 + key) * 256 + gg * 64 + d8 * 8);
#pragma unroll
            for (int e = 0; e < 8; ++e) { const float f = bf2f((bf16_t)v[e]); ss += f * f; } }
        nrm[tid] = sqrtf(ss); }
    __syncthreads();
    if (tid < 2) { float m = 0.f; for (int k = 0; k < 64; ++k) m = fmaxf(m, nrm[tid * 64 + k]); ((float*)(p.ws + WS_KBM))[tid * 256 + (s0 >> 6)] = m; }
    __syncthreads();
}

__device__ __forceinline__ void win_unit(const Params& p, unsigned char* lds, int g, int qt) {
    int tid_op = threadIdx.x; asm volatile("" : "+v"(tid_op));
    const int tid = tid_op, wid = tid >> 6, lane = tid & 63, r = lane & 31, hh = lane >> 5;
    bf16_t* Ks = (bf16_t*)lds;
    bf16_t* VT = Ks + 128 * 72;
    float* lut = (float*)(lds + 36864);
    const bf16_t* QA = (const bf16_t*)(p.ws + WS_QA); const bf16_t* KVW = (const bf16_t*)(p.ws + WS_KVW);
    const float* bl = (const float*)(p.ws + WS_BIAS);
    const int t0 = qt * 128, hr = wid & 3, head = g * 4 + hr, q0 = t0 + (wid >> 2) * 64;
    for (int i = tid; i < 4 * 768; i += 512) { const int hd = i / 768, d = (i % 768) - 127; lut[i] = (d < 0 || d > 512) ? -1e30f : bl[(g * 4 + hd) * 1032 + d]; }
    bf16x8 qf[2][4];
#pragma unroll
    for (int cb = 0; cb < 2; ++cb)
#pragma unroll
        for (int ks = 0; ks < 4; ++ks) qf[cb][ks] = *(const bf16x8*)(QA + (size_t)(q0 + cb * 32 + r) * 512 + head * 64 + ks * 16 + 8 * hh);
    f32x16 o[2][2]; float mrun[2], lrun[2];
#pragma unroll
    for (int cb = 0; cb < 2; ++cb) { mrun[cb] = -1e30f; lrun[cb] = 0.f;
#pragma unroll
        for (int dt = 0; dt < 2; ++dt)
#pragma unroll
            for (int i = 0; i < 16; ++i) o[cb][dt][i] = 0.f; }
    const float* mylut = lut + hr * 768 + 127;
    const int kstart = (t0 >= 512) ? t0 - 512 : 0;
    for (int kt = kstart; kt < t0 + 128; kt += 128) {
        __syncthreads();
        { const int key = tid >> 2, seg = tid & 3; const bf16_t* src = KVW + (size_t)(kt + key) * 256 + g * 64 + seg * 16;
          *(u32x4*)(Ks + key * 72 + seg * 16) = *(const u32x4*)src; *(u32x4*)(Ks + key * 72 + seg * 16 + 8) = *(const u32x4*)(src + 8); }
        { const int key = tid & 127, dq = tid >> 7; const bf16_t* src = KVW + (size_t)(kt + key) * 256 + 128 + g * 64 + dq * 16; const bf16x8 v0 = *(const bf16x8*)src, v1 = *(const bf16x8*)(src + 8);
#pragma unroll
          for (int e = 0; e < 8; ++e) { VT[(dq * 16 + e) * 136 + key] = (bf16_t)v0[e]; VT[(dq * 16 + 8 + e) * 136 + key] = (bf16_t)v1[e]; } }
        __syncthreads();
        for (int sub = 0; sub < 4; ++sub) {
            const int k0 = kt + sub * 32;
            if (k0 > q0 + 63 || k0 + 31 < q0 - 512) continue;
            bf16x8 kf[4];
#pragma unroll
            for (int ks = 0; ks < 4; ++ks) kf[ks] = *(const bf16x8*)(Ks + (sub * 32 + r) * 72 + ks * 16 + 8 * hh);
#pragma unroll
            for (int cb = 0; cb < 2; ++cb) {
                f32x16 sc;
#pragma unroll
                for (int i = 0; i < 16; ++i) sc[i] = 0.f;
#pragma unroll
                for (int ks = 0; ks < 4; ++ks) sc = __builtin_amdgcn_mfma_f32_32x32x16_bf16(kf[ks], qf[cb][ks], sc, 0, 0, 0);
                const int tq = q0 + cb * 32 + r; float mx = -1e30f;
#pragma unroll
                for (int i = 0; i < 16; ++i) { const int s = k0 + (i & 3) + 8 * (i >> 2) + 4 * hh; sc[i] += mylut[tq - s]; mx = fmaxf(mx, sc[i]); }
                mx = fmaxf(mx, __shfl_xor(mx, 32));
                const float mnew = fmaxf(mrun[cb], mx), alpha = __expf(mrun[cb] - mnew); mrun[cb] = mnew;
                float ps = 0.f;
#pragma unroll
                for (int i = 0; i < 16; ++i) { sc[i] = __expf(sc[i] - mnew); ps += sc[i]; }
                ps += __shfl_xor(ps, 32); lrun[cb] = lrun[cb] * alpha + ps;
#pragma unroll
                for (int dt = 0; dt < 2; ++dt)
#pragma unroll
                    for (int i = 0; i < 16; ++i) o[cb][dt][i] *= alpha;
#pragma unroll
                for (int s2 = 0; s2 < 2; ++s2) {
                    u32x4 pw; pw.x = cvt_pk_bf16(sc[8 * s2 + 0], sc[8 * s2 + 1]); pw.y = cvt_pk_bf16(sc[8 * s2 + 2], sc[8 * s2 + 3]); pw.z = cvt_pk_bf16(sc[8 * s2 + 4], sc[8 * s2 + 5]); pw.w = cvt_pk_bf16(sc[8 * s2 + 6], sc[8 * s2 + 7]);
                    const bf16x8 pb = __builtin_bit_cast(bf16x8, pw); const int mb = sub * 32 + 16 * s2 + 4 * hh;
#pragma unroll
                    for (int dt = 0; dt < 2; ++dt) { const u32x2 l0 = *(const u32x2*)(VT + (dt * 32 + r) * 136 + mb), l1 = *(const u32x2*)(VT + (dt * 32 + r) * 136 + mb + 8);
                        const bf16x8 a = __builtin_bit_cast(bf16x8, (u32x4){l0.x, l0.y, l1.x, l1.y});
                        o[cb][dt] = __builtin_amdgcn_mfma_f32_32x32x16_bf16(a, pb, o[cb][dt], 0, 0, 0); }
                }
            }
        }
    }
    float* OW = (float*)(p.ws + WS_OW); const float* gts = (const float*)(p.ws + WS_GATES);
#pragma unroll
    for (int cb = 0; cb < 2; ++cb) { const int tq = q0 + cb * 32 + r; const float sc = gts[(size_t)tq * 24 + 16 + head] / lrun[cb];
#pragma unroll
        for (int dt = 0; dt < 2; ++dt)
#pragma unroll
            for (int gq = 0; gq < 4; ++gq) { const int d = dt * 32 + 8 * gq + 4 * hh;
                *(f32x4*)(OW + (size_t)tq * 512 + head * 64 + d) = (f32x4){o[cb][dt][gq * 4 + 0] * sc, o[cb][dt][gq * 4 + 1] * sc, o[cb][dt][gq * 4 + 2] * sc, o[cb][dt][gq * 4 + 3] * sc}; } }
    __syncthreads();
}


__device__ __forceinline__ float dpp_quad_xor1(float x) { const int v = __builtin_bit_cast(int, x); return __builtin_bit_cast(float, __builtin_amdgcn_update_dpp(v, v, 0xB1, 0xf, 0xf, false)); }
__device__ __forceinline__ float dpp_quad_xor2(float x) { const int v = __builtin_bit_cast(int, x); return __builtin_bit_cast(float, __builtin_amdgcn_update_dpp(v, v, 0x4E, 0xf, 0xf, false)); }
__device__ __forceinline__ unsigned wave_max_u32(unsigned x) {
    unsigned y;
    y = (unsigned)__builtin_amdgcn_update_dpp((int)x, (int)x, 0x111, 0xf, 0xf, false); x = x > y ? x : y;
    y = (unsigned)__builtin_amdgcn_update_dpp((int)x, (int)x, 0x112, 0xf, 0xf, false); x = x > y ? x : y;
    y = (unsigned)__builtin_amdgcn_update_dpp((int)x, (int)x, 0x114, 0xf, 0xf, false); x = x > y ? x : y;
    y = (unsigned)__builtin_amdgcn_update_dpp((int)x, (int)x, 0x118, 0xf, 0xf, false); x = x > y ? x : y;
    const unsigned a = (unsigned)__builtin_amdgcn_readlane((int)x, 15), b = (unsigned)__builtin_amdgcn_readlane((int)x, 31), c = (unsigned)__builtin_amdgcn_readlane((int)x, 47), d = (unsigned)__builtin_amdgcn_readlane((int)x, 63);
    const unsigned ab = a > b ? a : b, cd = c > d ? c : d; return ab > cd ? ab : cd;
}
__device__ __forceinline__ void nsa_unit(const Params& p, unsigned char* lds, int g, int tt) {
    int tid_op = threadIdx.x; asm volatile("" : "+v"(tid_op));
    const int tid = tid_op, wid = tid >> 6, lane = tid & 63, r = lane & 31, hh = lane >> 5;
    float* imp = (float*)lds;
    bf16_t* Ks = (bf16_t*)(lds + 65536);
    bf16_t* VT = (bf16_t*)(lds + 65536 + 18432);
    float* lut = (float*)(lds + 131072);
    int* idxs = (int*)(lds + 147584) + wid * 128;
    unsigned long long* masks = (unsigned long long*)(lds + 151680);
    unsigned short* act = (unsigned short*)(lds + 153728);
    int* nact_p = (int*)(lds + 154240);
    const bf16_t* QA = (const bf16_t*)(p.ws + WS_QA); const bf16_t* KCMP = (const bf16_t*)(p.ws + WS_KCMP);
    const bf16_t* KVS = (const bf16_t*)(p.ws + WS_KVS); const bf16_t* VST = (const bf16_t*)(p.ws + WS_VST) + (size_t)g * 64 * SEQ;
    const float* bl = (const float*)(p.ws + WS_BIAS); const float* gts = (const float*)(p.ws + WS_GATES);
    const int t0 = tt * 64, tw0 = t0 + wid * 8;
    const int hr = r & 3, ti = r >> 2, tq = tw0 + ti, head = g * 4 + hr;
    for (int i = tid; i < 64 * 256; i += 512) imp[i] = 0.f;
    for (int i = tid; i < 4 * 1025; i += 512) { const int hd = i / 1025, n = i % 1025; lut[hd * 1032 + n] = bl[(g * 4 + hd) * 1032 + n]; }
    bf16x8 qf[4];
#pragma unroll
    for (int ks = 0; ks < 4; ++ks) qf[ks] = *(const bf16x8*)(QA + (size_t)tq * 512 + head * 64 + ks * 16 + 8 * hh);
    const int nkeys = (t0 + 63 >= 31) ? ((t0 + 63 - 31) >> 4) + 1 : 0;
    const float* mylut = lut + hr * 1032;
    float mshc;
    { float ss = 0.f;
#pragma unroll
      for (int ks = 0; ks < 4; ++ks)
#pragma unroll
          for (int e = 0; e < 8; ++e) { const float f = bf2f((bf16_t)qf[ks][e]); ss += f * f; }
      ss += __shfl_xor(ss, 32);
      const float kcm = __uint_as_float(((const unsigned*)(p.ws + WS_KCM))[g]);
      mshc = sqrtf(ss) * kcm * 1.0001f + 1e-3f; }
    __syncthreads();
    mshc += bl[(g * 4 + hr) * 1032 + 1025];
    const float bfar = mylut[1024] - mshc;
    float lrun = 0.f;
    for (int rep1 = 0; rep1 < (PROBE_DUP == 42 ? 2 : 1); ++rep1) { lrun = 0.f;
    for (int kt = 0; kt < nkeys; kt += 128) {
        __syncthreads();
        { const int key = tid >> 2, seg = tid & 3; const bf16_t* src = KCMP + ((size_t)(kt + key) * 2 + g) * 64 + seg * 16;
          *(u32x4*)(Ks + key * 72 + seg * 16) = *(const u32x4*)src; *(u32x4*)(Ks + key * 72 + seg * 16 + 8) = *(const u32x4*)(src + 8); }
        __syncthreads();
        for (int sub = 0; sub < 4; ++sub) {
            const int nb = kt + sub * 32; if (nb >= nkeys) break;
            f32x16 sc;
#pragma unroll
            for (int i = 0; i < 16; ++i) sc[i] = 0.f;
#pragma unroll
            for (int ks = 0; ks < 4; ++ks) { const bf16x8 kf = *(const bf16x8*)(Ks + (sub * 32 + r) * 72 + ks * 16 + 8 * hh); sc = __builtin_amdgcn_mfma_f32_32x32x16_bf16(kf, qf[ks], sc, 0, 0, 0); }
            float ps = 0.f;
            if (tw0 - (16 * (nb + 31) + 31) >= 1024) {
#pragma unroll
                for (int i = 0; i < 16; ++i) ps += __expf(fmaxf(sc[i] + bfar, -80.f));
            } else {
#pragma unroll
                for (int i = 0; i < 16; ++i) { const int n = nb + (i & 3) + 8 * (i >> 2) + 4 * hh; const int dc = tq - (16 * n + 31); const int di = dc < 0 ? 0 : (dc < 1024 ? dc : 1024);
                    const float pe = __expf(fmaxf(sc[i] + mylut[di] - mshc, -80.f)); ps += (dc >= 0) ? pe : 0.f; }
            }
            lrun += ps;
        }
    }
    }
    lrun += __shfl_xor(lrun, 32);
    const float inv_l = (tq >= 31) ? 1.0f / lrun : 0.f;
    f32x16 oc0, oc1;
#pragma unroll
    for (int i = 0; i < 16; ++i) { oc0[i] = 0.f; oc1[i] = 0.f; }
    float carry = 0.f;
    for (int kt = 0; kt < nkeys; kt += 128) {
        __syncthreads();
        { const int key = tid >> 2, seg = tid & 3; const bf16_t* src = KCMP + ((size_t)(kt + key) * 2 + g) * 64 + seg * 16;
          *(u32x4*)(Ks + key * 72 + seg * 16) = *(const u32x4*)src; *(u32x4*)(Ks + key * 72 + seg * 16 + 8) = *(const u32x4*)(src + 8); }
        { const int key = tid & 127, dq = tid >> 7; const bf16_t* src = KCMP + (size_t)1024 * 128 + ((size_t)(kt + key) * 2 + g) * 64 + dq * 16; const bf16x8 v0 = *(const bf16x8*)src, v1 = *(const bf16x8*)(src + 8);
#pragma unroll
          for (int e = 0; e < 8; ++e) { VT[(dq * 16 + e) * 136 + key] = (bf16_t)v0[e]; VT[(dq * 16 + 8 + e) * 136 + key] = (bf16_t)v1[e]; } }
        __syncthreads();
        for (int sub = 0; sub < 4; ++sub) {
            const int nb = kt + sub * 32; if (nb >= nkeys) break;
            f32x16 sc;
#pragma unroll
            for (int i = 0; i < 16; ++i) sc[i] = 0.f;
#pragma unroll
            for (int ks = 0; ks < 4; ++ks) { const bf16x8 kf = *(const bf16x8*)(Ks + (sub * 32 + r) * 72 + ks * 16 + 8 * hh); sc = __builtin_amdgcn_mfma_f32_32x32x16_bf16(kf, qf[ks], sc, 0, 0, 0); }
            if (tw0 - (16 * (nb + 31) + 31) >= 1024) {
#pragma unroll
                for (int i = 0; i < 16; ++i) sc[i] = __expf(fmaxf(sc[i] + bfar, -80.f)) * inv_l;
            } else {
#pragma unroll
                for (int i = 0; i < 16; ++i) { const int n = nb + (i & 3) + 8 * (i >> 2) + 4 * hh; const int dc = tq - (16 * n + 31); const int di = dc < 0 ? 0 : (dc < 1024 ? dc : 1024);
                    const float pe = __expf(fmaxf(sc[i] + mylut[di] - mshc, -80.f)) * inv_l; sc[i] = (dc >= 0) ? pe : 0.f; }
            }
#pragma unroll
            for (int s2 = 0; s2 < 2; ++s2) {
                u32x4 pw; pw.x = cvt_pk_bf16(sc[8 * s2 + 0], sc[8 * s2 + 1]); pw.y = cvt_pk_bf16(sc[8 * s2 + 2], sc[8 * s2 + 3]); pw.z = cvt_pk_bf16(sc[8 * s2 + 4], sc[8 * s2 + 5]); pw.w = cvt_pk_bf16(sc[8 * s2 + 6], sc[8 * s2 + 7]);
                const bf16x8 pb = __builtin_bit_cast(bf16x8, pw); const int mb = sub * 32 + 16 * s2 + 4 * hh;
                { const u32x2 l0 = *(const u32x2*)(VT + r * 136 + mb), l1 = *(const u32x2*)(VT + r * 136 + mb + 8); const bf16x8 a = __builtin_bit_cast(bf16x8, (u32x4){l0.x, l0.y, l1.x, l1.y}); oc0 = __builtin_amdgcn_mfma_f32_32x32x16_bf16(a, pb, oc0, 0, 0, 0); }
                { const u32x2 l0 = *(const u32x2*)(VT + (32 + r) * 136 + mb), l1 = *(const u32x2*)(VT + (32 + r) * 136 + mb + 8); const bf16x8 a = __builtin_bit_cast(bf16x8, (u32x4){l0.x, l0.y, l1.x, l1.y}); oc1 = __builtin_amdgcn_mfma_f32_32x32x16_bf16(a, pb, oc1, 0, 0, 0); }
            }
            float gs[4], ls[4], px[4];
#pragma unroll
            for (int q = 0; q < 4; ++q) { gs[q] = (sc[4 * q] + sc[4 * q + 1]) + (sc[4 * q + 2] + sc[4 * q + 3]); ls[q] = sc[4 * q + 3];
                gs[q] += dpp_quad_xor1(gs[q]); gs[q] += dpp_quad_xor2(gs[q]); ls[q] += dpp_quad_xor1(ls[q]); ls[q] += dpp_quad_xor2(ls[q]); px[q] = __shfl_xor(ls[q], 32); }
            if (hr == 0) {
#pragma unroll
                for (int q = 0; q < 4; ++q) { const float prev = hh ? px[q] : (q > 0 ? px[q > 0 ? q - 1 : 0] : carry); const int j = (nb >> 2) + 2 * q + hh;
                    imp[(wid * 8 + ti) * 256 + j] = gs[q] + prev; }
            }
            carry = px[3];
        }
    }
    {
        const int nsub = (nkeys + 31) >> 5, jn = nsub * 8;
        if (hr == 0 && hh == 0 && jn < 256 && nkeys > 0) imp[(wid * 8 + ti) * 256 + jn] = carry;
    }
    {
        float* ocb = (float*)(p.ws + WS_OC) + (size_t)tq * 512 + head * 64; const float gc = gts[(size_t)tq * 24 + head];
#pragma unroll
        for (int i = 0; i < 16; ++i) { const int d = (i & 3) + 8 * (i >> 2) + 4 * hh; ocb[d] = gc * oc0[i]; ocb[32 + d] = gc * oc1[i]; }
    }
    __builtin_amdgcn_wave_barrier(); asm volatile("s_waitcnt lgkmcnt(0)" ::: "memory");
    for (int rep2 = 0; rep2 < (PROBE_DUP == 43 ? 2 : 1); ++rep2)
    for (int i0 = 0; i0 < 8; i0 += 4) {
        const int cur = t0 >> 6;
        const int nf = 1 + (cur >= 1 ? 1 : 0) + (cur >= 2 ? 1 : 0);
        unsigned key[4][4]; int myidx[4];
#pragma unroll
        for (int t = 0; t < 4; ++t) { myidx[t] = (lane == 0) ? 0 : ((lane == 1 && cur >= 1) ? cur : ((lane == 2 && cur >= 2) ? cur - 1 : -1));
#pragma unroll
            for (int k = 0; k < 4; ++k) { const int j = lane + 64 * k; const bool forced = (j == 0) || (j == cur) || (j == cur - 1);
                const float scv = imp[(wid * 8 + i0 + t) * 256 + j];
                key[t][k] = (j <= cur && !forced) ? __float_as_uint(scv) + 1u : 0u; } }
        for (int sel = nf; sel < 16; ++sel) {
#pragma unroll
            for (int t = 0; t < 4; ++t) {
                unsigned best = key[t][0] > key[t][1] ? key[t][0] : key[t][1]; const unsigned b2 = key[t][2] > key[t][3] ? key[t][2] : key[t][3]; best = best > b2 ? best : b2;
                best = wave_max_u32(best);
                const unsigned long long m0 = __ballot(key[t][0] == best), m1 = __ballot(key[t][1] == best), m2 = __ballot(key[t][2] == best), m3 = __ballot(key[t][3] == best);
                const int f0 = __ffsll((long long)m0) - 1, f1 = 64 + __ffsll((long long)m1) - 1, f2 = 128 + __ffsll((long long)m2) - 1, f3 = 192 + __ffsll((long long)m3) - 1;
                int jsel = m0 ? f0 : (m1 ? f1 : (m2 ? f2 : f3));
                jsel = best ? jsel : -1;
                const int kl = jsel >> 6, ll = jsel & 63;
#pragma unroll
                for (int k = 0; k < 4; ++k) key[t][k] = (k == kl && lane == ll) ? 0u : key[t][k];
                myidx[t] = (lane == sel) ? jsel : myidx[t];
            }
        }
        if (lane < 16) {
#pragma unroll
            for (int t = 0; t < 4; ++t) idxs[(i0 + t) * 16 + lane] = myidx[t]; }
    }
    __builtin_amdgcn_wave_barrier(); asm volatile("s_waitcnt lgkmcnt(0)" ::: "memory");
    float* Mst = (float*)(lds + 155392);
    const int c16 = lane & 15, quad = lane >> 4;
    f32x4 osA[4], osB[4]; float laccA = 0.f, laccB = 0.f;
    for (int rep3 = 0; rep3 < (PROBE_DUP == 44 ? 2 : 1); ++rep3) {
    {
        const float* kbm = (const float*)(p.ws + WS_KBM) + g * 256;
        for (int i = 0; i < 8; ++i) { const int tk = tw0 + i;
            const int jj = (lane < 16) ? idxs[i * 16 + lane] : -1; float km = (jj >= 0) ? kbm[jj] : 0.f;
#pragma unroll
            for (int o = 8; o >= 1; o >>= 1) km = fmaxf(km, __shfl_xor(km, o));
            km = __shfl(km, 0);
            const bf16_t* qp = QA + tk * 512 + g * 256 + lane * 4; const u32x2 qw = *(const u32x2*)qp;
            const float q0 = __uint_as_float(qw.x << 16), q1 = __uint_as_float(qw.x & 0xffff0000u), q2 = __uint_as_float(qw.y << 16), q3 = __uint_as_float(qw.y & 0xffff0000u);
            float ss = q0 * q0 + q1 * q1 + q2 * q2 + q3 * q3;
#pragma unroll
            for (int o = 8; o >= 1; o >>= 1) ss += __shfl_xor(ss, o);
            if ((lane & 15) == 0) Mst[(wid * 8 + i) * 4 + (lane >> 4)] = sqrtf(ss) * km * 1.0001f + 1e-3f; }
    }
    __syncthreads();
    for (int i = tid; i < 256; i += 512) masks[i] = 0ull;
    if (tid < 256) { float bm = -1e30f; const int hd = tid >> 6; for (int n = tid & 63; n <= 1024; n += 64) bm = fmaxf(bm, lut[hd * 1032 + n]);
#pragma unroll
        for (int o = 32; o >= 1; o >>= 1) bm = fmaxf(bm, __shfl_xor(bm, o));
        if ((tid & 63) == 0) ((float*)(lds + 154240 + 64))[hd] = bm; }
    __syncthreads();
    { const int* ia = (const int*)(lds + 147584); const float* bmh = (const float*)(lds + 154240 + 64);
      for (int e = tid; e < 1024; e += 512) { const int j = ia[e]; if (j >= 0) atomicOr(&masks[j], 1ull << (e >> 4)); }
      if (tid < 256) Mst[tid] += bmh[tid & 3]; }
    __syncthreads();
    if (wid == 0) { int run = 0;
        for (int base = 0; base < 256; base += 64) { const int j = base + lane; const bool nz = masks[j] != 0ull; const unsigned long long bal = __ballot(nz);
            const int pos = run + __popcll(bal & ((1ull << lane) - 1ull)); if (nz) act[pos] = (unsigned short)j; run += __popcll(bal); }
        if (lane == 0) *nact_p = run; }
    __syncthreads();
    {
        const int nact = *nact_p;
        const int slot = c16 >> 2, hsl = c16 & 3, swz = c16 & 7;
        const float* slut = lut + hsl * 1032;
        bf16x8 qA[2], qB[2];
        { const int qo = (g * 4 + hsl) * 64 + quad * 8;
          qA[0] = *(const bf16x8*)(QA + (tw0 + slot) * 512 + qo); qA[1] = *(const bf16x8*)(QA + (tw0 + slot) * 512 + qo + 32);
          qB[0] = *(const bf16x8*)(QA + (tw0 + 4 + slot) * 512 + qo); qB[1] = *(const bf16x8*)(QA + (tw0 + 4 + slot) * 512 + qo + 32); }
        const float mshA = Mst[(wid * 8 + slot) * 4 + hsl], mshB = Mst[(wid * 8 + 4 + slot) * 4 + hsl];
        laccA = 0.f; laccB = 0.f;
#pragma unroll
        for (int dt = 0; dt < 4; ++dt) { osA[dt] = (f32x4){0.f, 0.f, 0.f, 0.f}; osB[dt] = (f32x4){0.f, 0.f, 0.f, 0.f}; }
        const int drow = tid >> 3, dseg = (tid & 7) ^ (drow & 7);
#define SEL_DMA(set, pi) do { _Pragma("unroll") for (int _b = 0; _b < 2; ++_b) { const int _a = 2 * (pi) + _b; const int _j = act[_a < nact ? _a : nact - 1]; \
            LAS unsigned char* _k = (LAS unsigned char*)lds + ((set) * 2 + _b) * 16384 + __builtin_amdgcn_readfirstlane(wid) * 1024; \
            __builtin_amdgcn_global_load_lds((const unsigned*)(KVS + (64 * _j + drow) * 256 + g * 64 + dseg * 8), (LAS unsigned*)_k, 16, 0, 0); \
            __builtin_amdgcn_global_load_lds((const unsigned*)(VST + drow * SEQ + 64 * _j + dseg * 8), (LAS unsigned*)(_k + 8192), 16, 0, 0); } } while (0)
#define SEL_VISIT(QF, MSH, LACC, OS, TB, NIB) do { \
            const bool cval = ((NIB) >> slot) & 1; const int tkl = (TB) + slot; \
            bf16x8 kf[4][2]; u32x2 vv[2][4][2]; \
            _Pragma("unroll") for (int mt = 0; mt < 4; ++mt) { const unsigned char* kr = Kb + (mt * 16 + c16) * 128; kf[mt][0] = *(const bf16x8*)(kr + ((quad ^ swz) * 16)); kf[mt][1] = *(const bf16x8*)(kr + (((4 + quad) ^ swz) * 16)); } \
            __builtin_amdgcn_sched_barrier(0); \
            f32x4 sv[4]; \
            _Pragma("unroll") for (int mt = 0; mt < 4; ++mt) { sv[mt] = __builtin_amdgcn_mfma_f32_16x16x32_bf16(kf[mt][0], QF[0], (f32x4){0.f, 0.f, 0.f, 0.f}, 0, 0, 0); \
                sv[mt] = __builtin_amdgcn_mfma_f32_16x16x32_bf16(kf[mt][1], QF[1], sv[mt], 0, 0, 0); } \
            __builtin_amdgcn_sched_barrier(0); \
            _Pragma("unroll") for (int kk = 0; kk < 2; ++kk) _Pragma("unroll") for (int dt = 0; dt < 4; ++dt) { const unsigned char* vr = Vb + (dt * 16 + c16) * 128; \
                vv[kk][dt][0] = *(const u32x2*)(vr + (((4 * kk + (quad >> 1)) ^ swz) * 16) + 8 * (quad & 1)); vv[kk][dt][1] = *(const u32x2*)(vr + (((4 * kk + 2 + (quad >> 1)) ^ swz) * 16) + 8 * (quad & 1)); } \
            __builtin_amdgcn_sched_barrier(0); \
            float ps = 0.f; \
            if ((TB) - 64 * j - 63 >= 1024) { const float bc = slut[1024] - (MSH); \
                _Pragma("unroll") for (int mt = 0; mt < 4; ++mt) _Pragma("unroll") for (int e = 0; e < 4; ++e) { const float pe = __expf(fmaxf(sv[mt][e] + bc, -80.f)); sv[mt][e] = cval ? pe : 0.f; ps += sv[mt][e]; } \
            } else { const int dbase = tkl - 64 * j - 4 * quad; \
                _Pragma("unroll") for (int mt = 0; mt < 4; ++mt) { float bb[4]; \
                    _Pragma("unroll") for (int e = 0; e < 4; ++e) { int ds = dbase - mt * 16 - e; ds = ds < 0 ? 0 : (ds > 1024 ? 1024 : ds); bb[e] = slut[ds]; } \
                    _Pragma("unroll") for (int e = 0; e < 4; ++e) { const int ds = dbase - mt * 16 - e; const float pe = __expf(fmaxf(sv[mt][e] + bb[e] - (MSH), -80.f)); sv[mt][e] = (cval && ds >= 0) ? pe : 0.f; ps += sv[mt][e]; } } } \
            LACC += ps; \
            _Pragma("unroll") for (int kk = 0; kk < 2; ++kk) { \
                u32x4 pw; pw.x = cvt_pk_bf16(sv[2 * kk][0], sv[2 * kk][1]); pw.y = cvt_pk_bf16(sv[2 * kk][2], sv[2 * kk][3]); pw.z = cvt_pk_bf16(sv[2 * kk + 1][0], sv[2 * kk + 1][1]); pw.w = cvt_pk_bf16(sv[2 * kk + 1][2], sv[2 * kk + 1][3]); \
                const bf16x8 pa = __builtin_bit_cast(bf16x8, pw); \
                _Pragma("unroll") for (int dt = 0; dt < 4; ++dt) { const u32x2 l0 = vv[kk][dt][0], l1 = vv[kk][dt][1]; const bf16x8 vb = __builtin_bit_cast(bf16x8, (u32x4){l0.x, l0.y, l1.x, l1.y}); \
                    OS[dt] = __builtin_amdgcn_mfma_f32_16x16x32_bf16(pa, vb, OS[dt], 0, 0, 0); } } \
        } while (0)
        const int npair = (nact + 1) >> 1;
        unsigned short* vlA = (unsigned short*)(lds + 147584) + wid * 256;
        unsigned short* vlJ = (unsigned short*)(lds + 156416) + wid * 256;
        int nv = 0;
        for (int base = 0; base < nact; base += 64) { const int a = base + lane; unsigned nib = 0u; int jj = 0;
            if (a < nact) { jj = act[a]; nib = (unsigned)(masks[jj] >> (wid * 8)) & 0xffu; }
            const bool has = nib != 0u; const unsigned long long bal = __ballot(has); const int pos = nv + __popcll(bal & ((1ull << lane) - 1ull));
            if (has) { vlA[pos] = (unsigned short)(a | (nib << 8)); vlJ[pos] = (unsigned short)jj; }
            nv += __popcll(bal); }
        __builtin_amdgcn_wave_barrier(); asm volatile("s_waitcnt lgkmcnt(0)" ::: "memory");
        int vptr = 0; unsigned ve = (nv > 0) ? (unsigned)vlA[0] : 0xffffu; int vj = (nv > 0) ? (int)vlJ[0] : 0;
        SEL_DMA(0, 0); if (npair > 1) SEL_DMA(1, 1); if (npair > 2) SEL_DMA(2, 2); if (npair > 3) SEL_DMA(3, 3);
        for (int it = 0; it < npair; it += 2) {
            { const int younger = (it == 0) ? npair - 2 : 0; if (younger >= 2) asm volatile("s_waitcnt vmcnt(8)" ::: "memory"); else if (younger == 1) asm volatile("s_waitcnt vmcnt(4)" ::: "memory"); else asm volatile("s_waitcnt vmcnt(0)" ::: "memory"); }
            asm volatile("" ::: "memory"); __builtin_amdgcn_s_barrier(); asm volatile("" ::: "memory");
            if (it >= 2) { if (it + 2 < npair) SEL_DMA((it + 2) & 3, it + 2); if (it + 3 < npair) SEL_DMA((it + 3) & 3, it + 3); }
            const int alim = 2 * it + 4;
            for (;;) {
                const unsigned e = (unsigned)__builtin_amdgcn_readfirstlane((int)ve); const int a = (int)(e & 0xffu);
                if (vptr >= nv || a >= alim) break;
                const int j = __builtin_amdgcn_readfirstlane(vj); const unsigned nib8 = e >> 8;
                ++vptr; if (vptr < nv) { ve = vlA[vptr]; vj = vlJ[vptr]; }
                const unsigned char* Kb = lds + ((((a >> 1) & 3) * 2) + (a & 1)) * 16384; const unsigned char* Vb = Kb + 8192;
                if (nib8 & 0xfu) SEL_VISIT(qA, mshA, laccA, osA, tw0, nib8 & 0xfu);
                if (nib8 >> 4) SEL_VISIT(qB, mshB, laccB, osB, tw0 + 4, nib8 >> 4);
            }
        }
#undef SEL_DMA
#undef SEL_VISIT
    }
    }
    __syncthreads();
    {
        float* fin = imp + wid * 8 * 256;
        laccA += __shfl_xor(laccA, 16); laccA += __shfl_xor(laccA, 32); laccB += __shfl_xor(laccB, 16); laccB += __shfl_xor(laccB, 32);
        float wA[4], wB[4];
#pragma unroll
        for (int hq = 0; hq < 4; ++hq) { const float la = __shfl(laccA, quad * 4 + hq), lb = __shfl(laccB, quad * 4 + hq);
            wA[hq] = gts[(size_t)(tw0 + quad) * 24 + 8 + g * 4 + hq] / la; wB[hq] = gts[(size_t)(tw0 + 4 + quad) * 24 + 8 + g * 4 + hq] / lb; }
#pragma unroll
        for (int dt = 0; dt < 4; ++dt)
#pragma unroll
            for (int hq = 0; hq < 4; ++hq) { fin[quad * 256 + hq * 64 + dt * 16 + c16] = wA[hq] * osA[dt][hq]; fin[(4 + quad) * 256 + hq * 64 + dt * 16 + c16] = wB[hq] * osB[dt][hq]; }
    }
    float* oc = imp + wid * 8 * 256;
    __builtin_amdgcn_wave_barrier(); asm volatile("s_waitcnt lgkmcnt(0)" ::: "memory");
    {
        const float* OW = (const float*)(p.ws + WS_OW); bf16_t* mix = (bf16_t*)(p.ws + WS_MIX);
        const float* OCb = (const float*)(p.ws + WS_OC);
        for (int i = 0; i < 8; ++i) { const int tk = tw0 + i; const f32x4 a = *(const f32x4*)(oc + i * 256 + lane * 4), b = *(const f32x4*)(OW + (size_t)tk * 512 + g * 256 + lane * 4) + *(const f32x4*)(OCb + (size_t)tk * 512 + g * 256 + lane * 4);
            u32x2 w; w.x = cvt_pk_bf16(a[0] + b[0], a[1] + b[1]); w.y = cvt_pk_bf16(a[2] + b[2], a[3] + b[3]); *(u32x2*)(mix + (size_t)tk * 1024 + g * 256 + lane * 4) = w; }
    }
    __syncthreads();
}


template <int K0, int K1> __device__ __forceinline__ void cmp_sample_issue(const Params& p, int u, f32x4 (&v)[33]) {
    int tid = threadIdx.x; asm volatile("" : "+v"(tid)); const int b = u >> 6, kv = (u >> 5) & 1, grp = u & 31; const int p0 = grp * 512;
    const int* pt = p.page_tab + b * 128 + (p0 >> 7);
    int pg[5];
#pragma unroll
    for (int i = 0; i < 5; ++i) pg[i] = pt[(p0 >> 7) + i < 128 ? i : 0];
#pragma unroll
    for (int k = K0; k < K1; ++k) { const int idx = k * 512 + tid, q = idx >> 5, f4 = idx & 31, pos = p0 + q; const int pi = q >> 7;
        const int page = pi == 0 ? pg[0] : (pi == 1 ? pg[1] : (pi == 2 ? pg[2] : (pi == 3 ? pg[3] : pg[4])));
        if (pos < PAST) v[k] = __builtin_nontemporal_load((const f32x4*)(p.cache_c + (((size_t)page * 128 + (pos & 127)) * 2 + kv) * 128 + f4 * 4));
        else v[k] = (f32x4){0.f, 0.f, 0.f, 0.f}; }
}
constexpr int CS_NPF = 26;
__device__ __forceinline__ void cmp_sample_stream(const Params& p, unsigned char* lds) {
    int tid_op = threadIdx.x; asm volatile("" : "+v"(tid_op));
    const int tid = tid_op, wid = tid >> 6, lane = tid & 63, r = lane & 31, hh = lane >> 5, G = gridDim.x;
    bf16_t* X = (bf16_t*)lds;
    int u = blockIdx.x; if (u >= 2048) return;
    f32x4 v[33];
    cmp_sample_issue<0, CS_NPF>(p, u, v);
    for (;;) {
        const int b = u >> 6, kv = (u >> 5) & 1, grp = u & 31; const int un = u + G; const bool more = un < 2048;
        const bf16_t* W1T = (const bf16_t*)(p.ws + WS_W1T) + (size_t)kv * 128 * 2048; const bf16_t* W2T = (const bf16_t*)(p.ws + WS_W2T) + (size_t)kv * 64 * 128;
        cmp_sample_issue<CS_NPF, 33>(p, u, v);
        { int tid_o = tid; asm volatile("" : "+v"(tid_o));
#pragma unroll
          for (int k = 0; k < 33; ++k) { const int idx = k * 512 + tid_o, q = idx >> 5, f4 = idx & 31;
            u32x2 w; w.x = cvt_pk_bf16(v[k][0], v[k][1]); w.y = cvt_pk_bf16(v[k][2], v[k][3]); *(u32x2*)(X + ((q & 15) * 33 + (q >> 4)) * 136 + f4 * 4) = w; } }
        const float* pet = (const float*)(p.ws + WS_PET) + kv * 1024; float ptsum = 0.f;
#pragma unroll
        for (int s8 = 0; s8 < 8; ++s8) ptsum += pet[s8 * 128 + (tid & 127)];
        const int rt2 = wid & 1, et = (wid >> 1) & 1;
        bf16_t* W2s = (bf16_t*)(lds + 143616);
        { const u32x4 wa = *(const u32x4*)(W2T + tid * 16), wb = *(const u32x4*)(W2T + tid * 16 + 8); *(u32x4*)(W2s + tid * 16) = wa; *(u32x4*)(W2s + tid * 16 + 8) = wb; }
        __syncthreads();
        const int ct = wid & 3, kh = wid >> 2; const int nl0 = (r >> 1), g = r & 1;
        f32x16 acc0, acc1;
#pragma unroll
        for (int i = 0; i < 16; ++i) { acc0[i] = 0.f; acc1[i] = 0.f; }
        const bf16_t* bp = W1T + (size_t)(ct * 32 + r) * 2048 + (16 * kh) * 64 + 8 * hh;
#define CS_BATCH(L0, NL, ISSUE) do { bf16x8 bf[NL][4]; \
            _Pragma("unroll") for (int li = 0; li < NL; ++li) _Pragma("unroll") for (int ks = 0; ks < 4; ++ks) bf[li][ks] = *(const bf16x8*)(bp + ((L0) + li) * 64 + ks * 16); \
            if ((ISSUE) && more) cmp_sample_issue<0, CS_NPF>(p, un, v); \
            __builtin_amdgcn_sched_barrier(0); \
            _Pragma("unroll") for (int li = 0; li < NL; ++li) { const int l = 16 * kh + (L0) + li; const bf16_t* ap = X + ((l & 15) * 33 + nl0 + (l >> 4)) * 136 + g * 64 + 8 * hh; \
                _Pragma("unroll") for (int ks = 0; ks < 4; ++ks) { const bf16x8 a0 = *(const bf16x8*)(ap + ks * 16), a1 = *(const bf16x8*)(ap + 16 * 136 + ks * 16); \
                    acc0 = __builtin_amdgcn_mfma_f32_32x32x16_bf16(a0, bf[li][ks], acc0, 0, 0, 0); acc1 = __builtin_amdgcn_mfma_f32_32x32x16_bf16(a1, bf[li][ks], acc1, 0, 0, 0); } } \
            __builtin_amdgcn_sched_barrier(0); } while (0)
        if (PROBE_DUP == 35) { CS_BATCH(0, 4, false); CS_BATCH(4, 4, false); CS_BATCH(8, 4, false); CS_BATCH(12, 2, false); CS_BATCH(14, 2, false);
#pragma unroll
            for (int i = 0; i < 16; ++i) { acc0[i] = 0.f; acc1[i] = 0.f; } }
        CS_BATCH(0, 4, false); CS_BATCH(4, 4, false); CS_BATCH(8, 4, false); CS_BATCH(12, 2, false); CS_BATCH(14, 2, true);
#undef CS_BATCH
        for (int rep5 = 0; rep5 < (PROBE_DUP == 36 ? 2 : 1); ++rep5) {
        __syncthreads();
        float* red = (float*)lds;
#pragma unroll
        for (int i = 0; i < 16; ++i) { const int m = (i & 3) + 8 * (i >> 2) + 4 * hh; red[(((kh * 2 + 0) * 4 + ct) * 32 + m) * 32 + r] = acc0[i]; red[(((kh * 2 + 1) * 4 + ct) * 32 + m) * 32 + r] = acc1[i]; }
        __syncthreads();
        bf16_t* hid = (bf16_t*)(lds + 65536);
        for (int e = tid; e < 64 * 128; e += 512) { const int m = e >> 7, hc = e & 127; const int rt = m >> 5, mm = m & 31, c4 = hc >> 5, cc = hc & 31;
            const float vv = red[(((0 * 2 + rt) * 4 + c4) * 32 + mm) * 32 + cc] + red[(((1 * 2 + rt) * 4 + c4) * 32 + mm) * 32 + cc] + ptsum;
            hid[m * 136 + hc] = f2bf(gelu_tanh(vv)); }
        __syncthreads();
        if (wid < 4) {
            f32x16 o;
#pragma unroll
            for (int i = 0; i < 16; ++i) o[i] = 0.f;
#pragma unroll
            for (int ks = 0; ks < 8; ++ks) { const bf16x8 a = *(const bf16x8*)(hid + (rt2 * 32 + r) * 136 + ks * 16 + 8 * hh), wb = *(const bf16x8*)(W2s + (et * 32 + r) * 128 + ks * 16 + 8 * hh); o = __builtin_amdgcn_mfma_f32_32x32x16_bf16(a, wb, o, 0, 0, 0); }
            bf16_t* dst = (bf16_t*)(p.ws + WS_KCMPS) + ((size_t)b * 2 + kv) * 1024 * 128;
#pragma unroll
            for (int i = 0; i < 16; ++i) { const int m = rt2 * 32 + (i & 3) + 8 * (i >> 2) + 4 * hh; const int n = grp * 32 + (m >> 1), gg = m & 1;
                dst[((size_t)n * 2 + gg) * 64 + et * 32 + r] = (n < 1023) ? f2bf(o[i]) : (bf16_t)0; }
        }
        __syncthreads();
        }
        if (!more) break;
        u = un;
    }
}

__device__ __forceinline__ void softmax4(float* sc, int pitch, int nk) {
    const int tid = threadIdx.x, wid = tid >> 6, lane = tid & 63;
    if (wid < 4) { float* s = sc + wid * pitch; float mx = -1e30f;
        for (int k = lane; k < nk; k += 64) mx = fmaxf(mx, s[k]);
#pragma unroll
        for (int o = 32; o >= 1; o >>= 1) mx = fmaxf(mx, __shfl_xor(mx, o));
        float sum = 0.f;
        for (int k = lane; k < nk; k += 64) { const float e = __expf(s[k] - mx); s[k] = e; sum += e; }
        sum = wave_sum(sum); const float inv = 1.0f / sum;
        for (int k = lane; k < nk; k += 64) s[k] *= inv; }
}

__device__ __forceinline__ void nsa_sample_unit(const Params& p, unsigned char* lds, int b, int g) {
    int tid_op = threadIdx.x; asm volatile("" : "+v"(tid_op));
    const int tid = tid_op, wid = tid >> 6, lane = tid & 63;
    constexpr int PITCH = 1040;
    float* qv = (float*)lds;
    float* sc = qv + 256;
    float* osum = sc + 4 * PITCH;
    float* part = osum + 256;
    float* impv = part + 2048;
    int* sidx = (int*)(impv + 264);
    const float** kptr = (const float**)(lds + 32768);
    const float* zs = (const float*)(p.ws + WS_ZS) + (size_t)b * NZ; const float* bl = (const float*)(p.ws + WS_BIAS); const float* gts_dummy = nullptr; (void)gts_dummy;
    const int* pt = p.page_tab + b * 128;
    if (tid < 256) { qv[tid] = zs[ZC_QA + g * 256 + tid] * 0.125f; osum[tid] = 0.f; }
    __syncthreads();
    const int ph = tid >> 6 & 3, pd = tid & 63;
    const float gate_c = sigmoidf_(zs[ZC_GT + 0 + g * 4 + ph]), gate_s = sigmoidf_(zs[ZC_GT + 8 + g * 4 + ph]), gate_w = sigmoidf_(zs[ZC_GT + 16 + g * 4 + ph]);
    {
        const bf16_t* KC = (const bf16_t*)(p.ws + WS_KCMPS) + ((size_t)b * 2) * 1024 * 128; const bf16_t* VC = KC + (size_t)1024 * 128;
        for (int n = tid; n < 1023; n += 512) { const bf16_t* kr = KC + ((size_t)n * 2 + g) * 64; float a0 = 0.f, a1 = 0.f, a2 = 0.f, a3 = 0.f;
#pragma unroll 1
            for (int d8 = 0; d8 < 8; ++d8) { const bf16x8 kk = *(const bf16x8*)(kr + d8 * 8);
#pragma unroll
                for (int e = 0; e < 8; ++e) { const float kf = bf2f((bf16_t)kk[e]); const int d = d8 * 8 + e; a0 += qv[d] * kf; a1 += qv[64 + d] * kf; a2 += qv[128 + d] * kf; a3 += qv[192 + d] * kf; } }
            const int dc = PAST - (16 * n + 31); const int bi = dc < 1024 ? dc : 1024;
            sc[n] = a0 + bl[(g * 4 + 0) * 1032 + bi]; sc[PITCH + n] = a1 + bl[(g * 4 + 1) * 1032 + bi]; sc[2 * PITCH + n] = a2 + bl[(g * 4 + 2) * 1032 + bi]; sc[3 * PITCH + n] = a3 + bl[(g * 4 + 3) * 1032 + bi]; }
        __syncthreads();
        softmax4(sc, PITCH, 1023);
        __syncthreads();
        { float o0 = 0.f, o1 = 0.f, o2 = 0.f, o3 = 0.f;
          for (int k = wid; k < 1023; k += 64) { float v[8];
#pragma unroll
              for (int u = 0; u < 8; ++u) { const int kk = k + 8 * u; v[u] = (kk < 1023) ? bf2f(VC[((size_t)kk * 2 + g) * 64 + pd]) : 0.f; }
#pragma unroll
              for (int u = 0; u < 8; ++u) { const int kk = k + 8 * u; if (kk < 1023) { o0 += sc[kk] * v[u]; o1 += sc[PITCH + kk] * v[u]; o2 += sc[2 * PITCH + kk] * v[u]; o3 += sc[3 * PITCH + kk] * v[u]; } } }
          part[wid * 256 + pd] = o0; part[wid * 256 + 64 + pd] = o1; part[wid * 256 + 128 + pd] = o2; part[wid * 256 + 192 + pd] = o3; }
        for (int j = tid; j < 257; j += 512) { float sacc = 0.f;
            for (int n = 4 * j - 1; n <= 4 * j + 3; ++n) if (n >= 0 && n < 1023) sacc += sc[n] + sc[PITCH + n] + sc[2 * PITCH + n] + sc[3 * PITCH + n];
            impv[j] = sacc; }
        __syncthreads();
        if (tid < 256) { float a = 0.f;
#pragma unroll
            for (int w = 0; w < 8; ++w) a += part[w * 256 + tid];
            osum[tid] += gate_c * a; }
        if (wid == 0) { unsigned long long key[5];
#pragma unroll
            for (int k = 0; k < 5; ++k) { const int j = lane + 64 * k; const bool forced = (j == 0) || (j == 256) || (j == 255); const float v = (j < 257) ? (forced ? 1e4f : impv[j]) : 0.f;
                key[k] = (j < 257) ? (((unsigned long long)__float_as_uint(v) << 32) | (unsigned long long)(512 - j)) : 0ull; }
            for (int sel = 0; sel < 16; ++sel) { unsigned long long best = key[0];
#pragma unroll
                for (int k = 1; k < 5; ++k) best = best > key[k] ? best : key[k];
#pragma unroll
                for (int o = 32; o >= 1; o >>= 1) { const unsigned long long ot = __shfl_xor(best, o); best = best > ot ? best : ot; }
                if (lane == 0) sidx[sel] = 512 - (int)(best & 0x3ffull);
#pragma unroll
                for (int k = 0; k < 5; ++k) if (key[k] == best) key[k] = 0ull; } }
        __syncthreads();
    }
    for (int br = 0; br < 2; ++br) {
        int nk;
        if (br == 0) { nk = 1024;
            for (int k = tid; k < 1024; k += 512) { const int j = sidx[k >> 6], pos = 64 * j + (k & 63); const float* rp = nullptr;
                if (pos < PAST) rp = p.cache_s + (((size_t)pt[pos >> 7] * 128 + (pos & 127)) * 2) * 128 + g * 64; else if (pos == PAST) rp = zs + ZC_KVS + g * 64;
                kptr[k] = rp; ((int*)(lds + 32768 + 8192))[k] = PAST - pos; }
        } else { nk = 513;
            for (int k = tid; k < 513; k += 512) { kptr[k] = (k < 512) ? p.st_win + (((size_t)b * 512 + k) * 2) * 128 + g * 64 : zs + ZC_KVW + g * 64; ((int*)(lds + 32768 + 8192))[k] = 512 - k; } }
        __syncthreads();
        const int* dist = (const int*)(lds + 32768 + 8192);
        for (int k = tid; k < nk; k += 512) { const float* kr = kptr[k]; const int ds = dist[k];
            if (kr == nullptr || ds < 0) { sc[k] = -1e30f; sc[PITCH + k] = -1e30f; sc[2 * PITCH + k] = -1e30f; sc[3 * PITCH + k] = -1e30f; continue; }
            float a0 = 0.f, a1 = 0.f, a2 = 0.f, a3 = 0.f;
#pragma unroll 2
            for (int d4 = 0; d4 < 16; ++d4) { const f32x4 kk = *(const f32x4*)(kr + d4 * 4);
#pragma unroll
                for (int e = 0; e < 4; ++e) { const int d = d4 * 4 + e; a0 += qv[d] * kk[e]; a1 += qv[64 + d] * kk[e]; a2 += qv[128 + d] * kk[e]; a3 += qv[192 + d] * kk[e]; } }
            const int bi = ds < 1024 ? ds : 1024;
            sc[k] = a0 + bl[(g * 4 + 0) * 1032 + bi]; sc[PITCH + k] = a1 + bl[(g * 4 + 1) * 1032 + bi]; sc[2 * PITCH + k] = a2 + bl[(g * 4 + 2) * 1032 + bi]; sc[3 * PITCH + k] = a3 + bl[(g * 4 + 3) * 1032 + bi]; }
        __syncthreads();
        softmax4(sc, PITCH, nk);
        __syncthreads();
        { float o0 = 0.f, o1 = 0.f, o2 = 0.f, o3 = 0.f;
          for (int k = wid; k < nk; k += 64) { float v[8];
#pragma unroll
              for (int u = 0; u < 8; ++u) { const int kk = k + 8 * u; const float* kr = (kk < nk) ? kptr[kk] : nullptr; v[u] = (kr != nullptr) ? kr[128 + pd] : 0.f; }
#pragma unroll
              for (int u = 0; u < 8; ++u) { const int kk = k + 8 * u; if (kk < nk) { o0 += sc[kk] * v[u]; o1 += sc[PITCH + kk] * v[u]; o2 += sc[2 * PITCH + kk] * v[u]; o3 += sc[3 * PITCH + kk] * v[u]; } } }
          part[wid * 256 + pd] = o0; part[wid * 256 + 64 + pd] = o1; part[wid * 256 + 128 + pd] = o2; part[wid * 256 + 192 + pd] = o3; }
        __syncthreads();
        if (tid < 256) { float a = 0.f;
#pragma unroll
            for (int w = 0; w < 8; ++w) a += part[w * 256 + tid];
            osum[tid] += (br == 0 ? gate_s : gate_w) * a; }
        __syncthreads();
    }
    if (tid < 256) ((bf16_t*)(p.ws + WS_MIX))[(size_t)(SEQ + b) * 1024 + g * 256 + tid] = f2bf(osum[tid]);
    __syncthreads();
}

__device__ __forceinline__ void phase3(const Params& p, unsigned char* lds) {
    const int G = gridDim.x, bid = blockIdx.x;
    for (int rep = 0; rep < (PROBE_DUP == 31 ? 2 : 1); ++rep) for (int u = bid; u < 256; u += G) win_unit(p, lds, u & 1, u >> 1);
    for (int rep = 0; rep < (PROBE_DUP == 32 ? 2 : 1); ++rep) for (int u = bid; u < 1024; u += G) ret_uc_unit(p, lds, u >> 3, u & 7);
    for (int rep = 0; rep < (PROBE_DUP == 30 ? 2 : 1); ++rep) cmp_sample_stream(p, lds);
    for (int rep = 0; rep < (PROBE_DUP == 33 ? 2 : 1); ++rep) { for (int u = bid; u < 128; u += G) cmp_prompt_unit(p, lds, u & 1, (u >> 1) * 16);
    for (int u = G - 1 - bid; u < 256; u += G) vst_unit(p, lds, u * 64); }
}
__device__ __forceinline__ void phase4(const Params& p, unsigned char* lds) {
    const int G = gridDim.x, bid = blockIdx.x, tid = threadIdx.x, wid = tid >> 6, lane = tid & 63;
    for (int rep = 0; rep < (PROBE_DUP == 41 ? 2 : 1); ++rep) for (int u = bid; u < 512; u += G) nsa_unit(p, lds, u & 1, 255 - (u >> 1));
    for (int rep = 0; rep < (PROBE_DUP == 40 ? 2 : 1); ++rep) for (int u = G - 1 - bid; u < 64; u += G) nsa_sample_unit(p, lds, u >> 1, u & 1);
    for (int u = bid; u < 16; u += G) ret_scan(p, u * 512 + tid);
    for (int u = (G - 1 - bid) * 8 + wid; u < NB * 8; u += G * 8) ret_sample_wave(p, u >> 3, u & 7, lane);
}
__device__ __forceinline__ void phase5(const Params& p, unsigned char* lds) {
    const int G = gridDim.x, bid = blockIdx.x;
    for (int u = bid; u < 512; u += G) ret_out_unit(p, lds, u >> 2, u & 3);
}

struct EpiRes {
    static constexpr bool PERM = false, AFTER_DRAIN = false;
    const float* base; float* dst; const float* gate;
    __device__ __forceinline__ void operator()(const f32x4 (&acc)[2][2][4][2], const pg8::Unit& u, int wr, int wc, int fr, int fq) const {
        const int row0 = u.pm * 256 + wr * 64 + fr; const int cb = u.pn * 256 + wc * 32 + 4 * fq;
        f32x4 gv[2][2];
#pragma unroll
        for (int bj = 0; bj < 2; ++bj)
#pragma unroll
            for (int n = 0; n < 2; ++n) gv[bj][n] = *(const f32x4*)(gate + cb + bj * 128 + n * 16);
#pragma unroll
        for (int ai = 0; ai < 2; ++ai)
#pragma unroll
            for (int m = 0; m < 4; ++m) { const size_t ro = (size_t)(row0 + ai * 128 + m * 16) * 1024;
#pragma unroll
                for (int bj = 0; bj < 2; ++bj)
#pragma unroll
                    for (int n = 0; n < 2; ++n) { const int c = cb + bj * 128 + n * 16; const f32x4 b = *(const f32x4*)(base + ro + c);
                        *(f32x4*)(dst + ro + c) = b + gv[bj][n] * acc[ai][bj][m][n]; } }
    }
};
__device__ __forceinline__ void phase6(const Params& p, unsigned char* lds) {
    const int G = gridDim.x, bid = blockIdx.x;
    const bf16_t* MIX = (const bf16_t*)(p.ws + WS_MIX); const bf16_t* WoutT = (const bf16_t*)(p.ws + WS_WOUT_T);
    float* X1 = (float*)(p.ws + WS_X1); const float* mod = (const float*)(p.ws + WS_MOD);
    {
        pg8::Gemm g{MIX, WoutT, SEQ, 1024, 1024}; pg8::StaticOrder S; S.init(SEQ, 1024, G, bid);
        EpiRes E{p.x_p, X1, mod + 2048};
        pg8::gemm_phase<EpiRes, pg8::StaticOrder, true, true>((LAS unsigned char*)lds, g, S, E);
    }
    __syncthreads();
    for (int u = bid; u < 32; u += G)
        skinny32_unit(lds, MIX + (size_t)SEQ * 1024, WoutT, 1024, u * 32, [&](int m, int n, float v) {
            X1[(size_t)(SEQ + m) * 1024 + n] = p.x_s[(size_t)m * 1024 + n] + mod[(size_t)(1 + m) * 6144 + 2048 + n] * v; });
}
__device__ __forceinline__ void phase7(const Params& p, unsigned char* lds) {
    const int tid = threadIdx.x, wid = tid >> 6, lane = tid & 63, G = gridDim.x, bid = blockIdx.x;
    float* sA = (float*)lds; float* sB = sA + 1024;
    const float* X1 = (const float*)(p.ws + WS_X1); bf16_t* HN2 = (bf16_t*)(p.ws + WS_HN2 + 4096); const float* mod = (const float*)(p.ws + WS_MOD);
    if (bid == 0) for (int i = tid; i < 256; i += 512) ((u32x4*)(p.ws + WS_HN2))[i] = (u32x4){0u, 0u, 0u, 0u};
    int cur = -1;
    for (int u = bid; u < 256 + NB; u += G) {
        const int mr = (u < 256) ? 0 : (1 + u - 256);
        if (mr != cur) { __syncthreads(); for (int c = tid; c < 1024; c += 512) { sA[c] = p.g_ffn[c] * (1.0f + mod[(size_t)mr * 6144 + 4096 + c]); sB[c] = mod[(size_t)mr * 6144 + 3072 + c]; } __syncthreads(); cur = mr; }
        if (u < 256) { for (int i = 0; i < 8; ++i) { const int row = u * 64 + wid * 8 + i; norm_row_store(X1 + (size_t)row * 1024, sA, sB, HN2 + (size_t)row * 1024, lane); } }
        else if (wid == 0) { const int row = SEQ + u - 256; norm_row_store(X1 + (size_t)row * 1024, sA, sB, HN2 + (size_t)row * 1024, lane); }
    }
}
__device__ __forceinline__ f32x4 dpp_row_ror1(const f32x4 x) {
    f32x4 r; const int lane = threadIdx.x & 63, src = (lane & 48) | ((lane - 1) & 15);
#pragma unroll
    for (int e = 0; e < 4; ++e) r[e] = __shfl(x[e], src);
    return r;
}
__device__ __forceinline__ f32x4 dpp_row_ror2(const f32x4 x) {
    f32x4 r; const int lane = threadIdx.x & 63, src = (lane & 48) | ((lane - 2) & 15);
#pragma unroll
    for (int e = 0; e < 4; ++e) r[e] = __shfl(x[e], src);
    return r;
}
struct EpiUpConv {
    static constexpr bool PERM = false, AFTER_DRAIN = false;
    unsigned char* ws; float* out; const float* conv_w; const float* conv_b;
    __device__ __forceinline__ void operator()(const f32x4 (&acc)[2][2][4][2], const pg8::Unit& u, int wr, int wc, int fr, int fq) const {
        bf16_t* H = (bf16_t*)(ws + WS_H);
#pragma unroll
        for (int n = 0; n < 2; ++n) {
            const int c = u.pn * 128 + wc * 32 + n * 16 + 4 * fq;
            const f32x4 w0 = *(const f32x4*)(conv_w + c), w1 = *(const f32x4*)(conv_w + DFF + c), w2 = *(const f32x4*)(conv_w + 2 * DFF + c), cb = *(const f32x4*)(conv_b + c);
#pragma unroll
            for (int ai = 0; ai < 2; ++ai) {
                const int tbase = u.pm * 248 + (ai * 2 + wr) * 62 - 2;
                f32x4 r1p = (f32x4){0.f, 0.f, 0.f, 0.f}, r2p = r1p;
#pragma unroll
                for (int m = 0; m < 4; ++m) {
                    const f32x4 ag = acc[ai][0][m][n], av = acc[ai][1][m][n];
                    const f32x4 r1 = dpp_row_ror1(ag), r2 = dpp_row_ror2(ag);
                    const f32x4 p1 = (fr == 0) ? r1p : r1, p2 = (fr < 2) ? r2p : r2;
                    const int lr = m * 16 + fr, t = tbase + lr;
                    float y[4];
#pragma unroll
                    for (int e = 0; e < 4; ++e) { const float cv = cb[e] + w0[e] * p2[e] + w1[e] * p1[e] + w2[e] * ag[e]; y[e] = cv / (1.0f + __expf(-cv)) * av[e]; }
                    if (lr >= 2 && t < SEQ) { u32x2 w; w.x = cvt_pk_bf16(y[0], y[1]); w.y = cvt_pk_bf16(y[2], y[3]); *(u32x2*)(H + (size_t)t * DFF + c) = w;
                        if (t >= SEQ - 2) *(f32x4*)(out + O_CONV_P + (size_t)(t - (SEQ - 2)) * DFF + c) = ag; }
                    r1p = r1; r2p = r2;
                }
            }
        }
    }
};
__device__ __forceinline__ void phase8(const Params& p, unsigned char* lds) {
    const int G = gridDim.x, bid = blockIdx.x;
    const bf16_t* HN2 = (const bf16_t*)(p.ws + WS_HN2 + 4096); const bf16_t* WupT = (const bf16_t*)(p.ws + WS_WUP_T);
    constexpr int NMT = (SEQ + 247) / 248;
    {
        pg8::Gemm g{(const bf16_t*)(p.ws + WS_HN2), WupT, NMT * 256, 5632, 1024}; pg8::StaticOrder S; S.init(NMT * 256, 5632, G, bid);
        EpiUpConv E{p.ws, p.out, p.conv_w, p.conv_b};
        pg8::gemm_phase<EpiUpConv, pg8::StaticOrder, true, true, 62>((LAS unsigned char*)lds, g, S, E);
    }
    __syncthreads();
    float* ags = (float*)(p.ws + WS_AGS); float* avs = (float*)(p.ws + WS_AVS); float* out = p.out;
    for (int u = G - 1 - bid; u < 176; u += G)
        skinny32_unit(lds, HN2 + (size_t)SEQ * 1024, WupT, 1024, u * 32, [&](int m, int n, float v) {
            const int col = 128 * (n >> 8) + (n & 127);
            if ((n & 255) < 128) { ags[(size_t)m * DFF + col] = v; out[O_CONV_S + ((size_t)m * 2 + 1) * DFF + col] = v; } else avs[(size_t)m * DFF + col] = v; });
    { int nr; const int rk = idle_rank(NMT * (5632 / 256), G, bid, nr); if (rk >= 0) tr_stream(p, lds, 2, rk, nr); }
}
__device__ __forceinline__ void phase9(const Params& p, unsigned char* lds) {
    const int G = gridDim.x, bid = blockIdx.x, tid = threadIdx.x;
    const int gt = bid * 512 + tid, GT = G * 512;
    const float* ags = (const float*)(p.ws + WS_AGS); const float* avs = (const float*)(p.ws + WS_AVS); bf16_t* HS = (bf16_t*)(p.ws + WS_HS);
    for (int i = gt; i < NB * DFF; i += GT) { const int b = i / DFF, c = i % DFF;
        const float cv = p.conv_b[c] + p.conv_w[c] * p.st_conv[(size_t)b * 2 * DFF + c] + p.conv_w[DFF + c] * p.st_conv[(size_t)b * 2 * DFF + DFF + c] + p.conv_w[2 * DFF + c] * ags[i];
        HS[i] = f2bf(cv / (1.0f + __expf(-cv)) * avs[i]); }
}
__device__ __forceinline__ void phase10(const Params& p, unsigned char* lds) {
    const int G = gridDim.x, bid = blockIdx.x;
    const bf16_t* H = (const bf16_t*)(p.ws + WS_H); const bf16_t* WdnT = (const bf16_t*)(p.ws + WS_WDN_T);
    float* X1 = (float*)(p.ws + WS_X1); const float* mod = (const float*)(p.ws + WS_MOD);
    {
        pg8::Gemm g{H, WdnT, SEQ, 1024, DFF}; pg8::StaticOrder S; S.init(SEQ, 1024, G, bid);
        EpiRes E{X1, X1, mod + 5120};
        pg8::gemm_phase<EpiRes, pg8::StaticOrder, true, true>((LAS unsigned char*)lds, g, S, E);
    }
    __syncthreads();
    const bf16_t* HS = (const bf16_t*)(p.ws + WS_HS);
    for (int u = bid; u < 32; u += G)
        skinny32_unit(lds, HS, WdnT, DFF, u * 32, [&](int m, int n, float v) {
            float* x = X1 + (size_t)(SEQ + m) * 1024 + n; *x = *x + mod[(size_t)(1 + m) * 6144 + 5120 + n] * v; });
}
__device__ __forceinline__ void phase11(const Params& p, unsigned char* lds) {
    const int tid = threadIdx.x, wid = tid >> 6, lane = tid & 63, G = gridDim.x, bid = blockIdx.x;
    const float* X1 = (const float*)(p.ws + WS_X1);
    for (int r = bid * 8 + wid; r < SEQ + NB; r += G * 8) {
        const float* xr = X1 + (size_t)r * 1024; float* dst = (r < SEQ) ? p.out + O_YP + (size_t)r * 1024 : p.out + O_YS + (size_t)(r - SEQ) * 1024;
        f32x4 v[4]; float ss = 0.f;
#pragma unroll
        for (int j = 0; j < 4; ++j) { v[j] = *(const f32x4*)(xr + lane * 4 + 256 * j); ss += v[j][0] * v[j][0] + v[j][1] * v[j][1] + v[j][2] * v[j][2] + v[j][3] * v[j][3]; }
        ss = wave_sum(ss); const float rstd = rsqrtf(ss * (1.0f / 1024.0f) + 1e-6f);
#pragma unroll
        for (int j = 0; j < 4; ++j) { const int c = lane * 4 + 256 * j; const f32x4 g = *(const f32x4*)(p.g_fin + c); *(f32x4*)(dst + c) = v[j] * rstd * g; }
    }
}

constexpr int LDS_BYTES = 163840, LDS_CTL = LDS_BYTES - 64;
constexpr int N_PHASES = 12;
__global__ void __launch_bounds__(512, 2) fwd_kernel(Params p) {
    extern __shared__ __attribute__((aligned(16))) unsigned char lds[];
    const int lo = (int)p.ph_lo, hi = (int)p.ph_hi;
    if (threadIdx.x < 16) ((LAS unsigned*)((LAS unsigned char*)lds + LDS_CTL))[threadIdx.x] = 0u;
    __syncthreads();
    XcdBarrier bar; bar.bar = (unsigned*)(p.ws + WS_BAR); bar.x = 0; bar.st = nullptr;
    if (hi - lo > 1) bar = xcd_barrier_post((unsigned*)(p.ws + WS_BAR), (volatile LAS unsigned*)((LAS unsigned char*)lds + LDS_CTL));
#define IN(k) (lo <= (k) && (k) < hi)
#define SEAM(k) do { if (IN(k) && IN((k) + 1)) xcd_barrier(bar); } while (0)
    if (IN(0)) { phase0(p, lds); if (PROBE_DUP == 0) { xcd_barrier(bar); phase0(p, lds); } } SEAM(0);
    if (IN(1)) { phase1(p, lds); if (PROBE_DUP == 1) { xcd_barrier(bar); phase1(p, lds); } } SEAM(1);
    if (IN(2)) { phase2(p, lds); if (PROBE_DUP == 2) { xcd_barrier(bar); phase2(p, lds); } } SEAM(2);
    if (IN(3)) { phase3(p, lds); if (PROBE_DUP == 3) { xcd_barrier(bar); phase3(p, lds); } } SEAM(3);
    if (IN(4)) { phase4(p, lds); if (PROBE_DUP == 4) { xcd_barrier(bar); phase4(p, lds); } } SEAM(4);
    if (IN(5)) { phase5(p, lds); if (PROBE_DUP == 5) { xcd_barrier(bar); phase5(p, lds); } } SEAM(5);
    if (IN(6)) { phase6(p, lds); if (PROBE_DUP == 6) { xcd_barrier(bar); phase6(p, lds); } } SEAM(6);
    if (IN(7)) { phase7(p, lds); if (PROBE_DUP == 7) { xcd_barrier(bar); phase7(p, lds); } } SEAM(7);
    if (IN(8)) { phase8(p, lds); if (PROBE_DUP == 8) { xcd_barrier(bar); phase8(p, lds); } } SEAM(8);
    if (IN(9)) { phase9(p, lds); if (PROBE_DUP == 9) { xcd_barrier(bar); phase9(p, lds); } } SEAM(9);
    if (IN(10)) { phase10(p, lds); if (PROBE_DUP == 10) { xcd_barrier(bar); phase10(p, lds); } } SEAM(10);
    if (IN(11)) { phase11(p, lds); if (PROBE_DUP == 11) { xcd_barrier(bar); phase11(p, lds); } }
#undef IN
#undef SEAM
}

extern "C" void kernel_launch(void* const* d_in, const int* in_sizes, int n_in, void* d_out, int out_size, void* d_ws, size_t ws_size, hipStream_t stream) {
    static int grid = 0;
    if (grid == 0) {
        if (n_in != 29 || out_size != (int)O_END || ws_size < WS_END) { fprintf(stderr, "kernel_launch: unexpected sizes n_in %d out %d ws %zu (need %zu)\n", n_in, out_size, ws_size, (size_t)WS_END); grid = -1; return; }
        int dev = 0, cus = 0;
        if (hipGetDevice(&dev) != hipSuccess || hipDeviceGetAttribute(&cus, hipDeviceAttributeMultiprocessorCount, dev) != hipSuccess) { grid = -1; return; }
        if (hipFuncSetAttribute((const void*)fwd_kernel, hipFuncAttributeMaxDynamicSharedMemorySize, LDS_BYTES) != hipSuccess) { fprintf(stderr, "kernel_launch: hipFuncSetAttribute failed\n"); grid = -1; return; }
        int per_cu = 0;
        if (hipOccupancyMaxActiveBlocksPerMultiprocessor(&per_cu, (const void*)fwd_kernel, 512, LDS_BYTES) != hipSuccess || per_cu < 1) fprintf(stderr, "kernel_launch: occupancy query says %d\n", per_cu);
        (void)hipGetLastError();
        grid = cus;
    }
    if (grid < 0) return;
    (void)hipMemsetAsync((char*)d_ws + WS_BAR, 0, 16384, stream);
    Params p{};
    p.x_p = (const float*)d_in[0]; p.x_s = (const float*)d_in[1]; p.cache_c = (const float*)d_in[2]; p.cache_s = (const float*)d_in[3]; p.st_win = (const float*)d_in[4];
    p.st_ret = (const float*)d_in[5]; p.st_conv = (const float*)d_in[6]; p.page_tab = (const int*)d_in[7]; p.c_p = (const float*)d_in[8]; p.c_s = (const float*)d_in[9];
    p.w_ada = (const float*)d_in[10]; p.b_ada = (const float*)d_in[11]; p.g_mix = (const float*)d_in[12]; p.w_in = (const float*)d_in[13]; p.pe_k = (const float*)d_in[14]; p.pe_v = (const float*)d_in[15];
    p.w1_k = (const float*)d_in[16]; p.w1_v = (const float*)d_in[17]; p.w2_k = (const float*)d_in[18]; p.w2_v = (const float*)d_in[19]; p.table = (const float*)d_in[20]; p.gn_g = (const float*)d_in[21];
    p.w_out = (const float*)d_in[22]; p.g_ffn = (const float*)d_in[23]; p.w_up = (const float*)d_in[24]; p.conv_w = (const float*)d_in[25]; p.conv_b = (const float*)d_in[26]; p.w_down = (const float*)d_in[27]; p.g_fin = (const float*)d_in[28];
    p.out = (float*)d_out; p.ws = (unsigned char*)d_ws;
#if MK_ONE_LAUNCH
    p.ph_lo = 0; p.ph_hi = N_PHASES;
    hipLaunchKernelGGL(fwd_kernel, dim3(grid), dim3(512), LDS_BYTES, stream, p);
#else
    for (int ph = 0; ph < N_PHASES; ++ph) { if (DBG_SKIP_MIX && ph == 5) continue; p.ph_lo = ph; p.ph_hi = ph + 1; hipLaunchKernelGGL(fwd_kernel, dim3(grid), dim3(512), LDS_BYTES, stream, p); }
#endif
}
```
